# Optimizing an MI355X kernel written in HIP

```python
import math
import jax, jax.numpy as jnp
from jax import lax
import numpy as np

D_MODEL = 1024
BATCH = 16
SEQ = 2048
DEPTH = 1

MEM_LEN = 256
EPS = 1e-6

SSD_HEADS = 16
SSD_HEAD_DIM = 64
SSD_INNER = SSD_HEADS * SSD_HEAD_DIM
SSD_GROUPS = 2
SSD_STATE = 128
SSD_CONV = 4
SSD_CHUNK = 128
SSD_CONV_DIM = SSD_INNER + 2 * SSD_GROUPS * SSD_STATE
DT_MIN = 0.001
DT_MAX = 0.1

GMLP_GROUPS = 8
GMLP_INNER = 1024
GMLP_GROUP_DIM = GMLP_INNER // GMLP_GROUPS
GMLP_CHUNK = 128

XA_HEADS = 4
XA_HEAD_DIM = 256
XA_INNER = XA_HEADS * XA_HEAD_DIM

N_BRANCH = 3
BRANCH_WIDTH = 1024

IN_DIM = SSD_INNER + SSD_CONV_DIM + SSD_HEADS + 2 * GMLP_INNER + XA_INNER + N_BRANCH * D_MODEL

PEER_HEADS = 8
PEER_N_KEYS = 128
PEER_N_EXPERTS = PEER_N_KEYS * PEER_N_KEYS
PEER_QUERY_DIM = 256
PEER_HALF = PEER_QUERY_DIM // 2
PEER_TOPK = 16
PEER_TOKEN_BLOCK = 128

kernel_name = 'hybrid_ssd_gmlp_memxattn_peer'


def rms_norm(x, g):
    xf = x.astype(jnp.float32)
    y = xf * lax.rsqrt(jnp.mean(xf * xf, axis=-1, keepdims=True) + EPS)
    return (y * g.astype(jnp.float32)).astype(x.dtype)


def causal_depthwise_conv(x, w, b):
    k = w.shape[0]
    y = lax.conv_general_dilated(
        x, w[:, None, :].astype(x.dtype), window_strides=(1,), padding=[(k - 1, 0)],
        dimension_numbers=('NWC', 'WIO', 'NWC'), feature_group_count=x.shape[-1])
    return y + b.astype(x.dtype)


def ssd_chunked(xh, dt, a, bm, cm):
    out_dtype = xh.dtype
    b, s = xh.shape[0], xh.shape[1]
    c, l = s // SSD_CHUNK, SSD_CHUNK
    g, r = SSD_GROUPS, SSD_HEADS // SSD_GROUPS
    xdt = (xh.astype(jnp.float32) * dt[..., None]).reshape(b, c, l, g, r, SSD_HEAD_DIM)
    adt = (dt * a).reshape(b, c, l, g, r).transpose(0, 3, 4, 1, 2)
    bc = bm.astype(jnp.float32).reshape(b, c, l, g, SSD_STATE)
    cc = cm.astype(jnp.float32).reshape(b, c, l, g, SSD_STATE)
    a_cs = jnp.cumsum(adt, axis=-1)
    causal = jnp.tril(jnp.ones((l, l), dtype=bool))
    seg = a_cs[..., :, None] - a_cs[..., None, :]
    lmat = jnp.exp(jnp.where(causal, seg, -jnp.inf))
    cb = jnp.einsum('bclgn,bcsgn->bcgls', cc, bc)
    y_diag = jnp.einsum('bcgls,bgrcls,bcsgrp->bclgrp', cb, lmat, xdt)
    decay = jnp.exp(a_cs[..., -1:] - a_cs)
    states = jnp.einsum('bclgn,bgrcl,bclgrp->cbgrpn', bc, decay, xdt)
    chunk_decay = jnp.exp(a_cs[..., -1]).transpose(3, 0, 1, 2)

    def step(carry, inp):
        st, dec = inp
        return carry * dec[..., None, None] + st, carry

    init = jnp.zeros(states.shape[1:], jnp.float32)
    _, prev = lax.scan(step, init, (states, chunk_decay))
    y_off = jnp.einsum('bclgn,cbgrpn,bgrcl->bclgrp', cc, prev, jnp.exp(a_cs))
    return (y_diag + y_off).reshape(b, s, SSD_HEADS, SSD_HEAD_DIM).astype(out_dtype)


def ssd_branch(xbc_raw, z, dt_raw, conv_w, conv_b, dt_bias, a_log, d_skip, ssd_norm):
    b, s = z.shape[0], z.shape[1]
    xbc = jax.nn.silu(causal_depthwise_conv(xbc_raw, conv_w, conv_b))
    xs, bm, cm = jnp.split(xbc, [SSD_INNER, SSD_INNER + SSD_GROUPS * SSD_STATE], axis=-1)
    xh = xs.reshape(b, s, SSD_HEADS, SSD_HEAD_DIM)
    dt = jax.nn.softplus(dt_raw.astype(jnp.float32) + dt_bias.astype(jnp.float32))
    a = -jnp.exp(a_log.astype(jnp.float32))
    y = ssd_chunked(xh, dt, a,
                    bm.reshape(b, s, SSD_GROUPS, SSD_STATE),
                    cm.reshape(b, s, SSD_GROUPS, SSD_STATE))
    y = (y + d_skip.astype(xh.dtype)[:, None] * xh).reshape(b, s, SSD_INNER)
    return rms_norm(y * jax.nn.silu(z), ssd_norm)


def gmlp_branch(u, v, gmlp_norm, w_spatial, b_spatial):
    b, s = u.shape[0], u.shape[1]
    u = jax.nn.gelu(u)
    v = rms_norm(jax.nn.gelu(v), gmlp_norm)
    vc = v.reshape(b, s // GMLP_CHUNK, GMLP_CHUNK, GMLP_GROUPS, GMLP_GROUP_DIM)
    w = w_spatial * jnp.tril(jnp.ones((GMLP_CHUNK, GMLP_CHUNK), w_spatial.dtype))
    mixed = jnp.einsum('gts,bcsgk->bctgk', w, vc) + b_spatial.T[:, :, None]
    return u * mixed.reshape(b, s, GMLP_INNER)


def memory_cross_attention(q, mem_n, w_mem_kv):
    b, s = q.shape[0], q.shape[1]
    m = mem_n.shape[1]
    k, v = jnp.split(mem_n @ w_mem_kv, 2, axis=-1)
    qh = q.reshape(b, s, XA_HEADS, XA_HEAD_DIM)
    kh = k.reshape(b, m, XA_HEADS, XA_HEAD_DIM)
    vh = v.reshape(b, m, XA_HEADS, XA_HEAD_DIM)
    scores = jnp.einsum('bshd,bmhd->bhsm', qh, kh).astype(jnp.float32) * (XA_HEAD_DIM ** -0.5)
    p = jax.nn.softmax(scores, axis=-1).astype(vh.dtype)
    return jnp.einsum('bhsm,bmhd->bshd', p, vh).reshape(b, s, XA_INNER)


def peer_ffn(xn, w_peer_q, peer_keys, peer_u, peer_v):
    b, s, d = xn.shape
    xb = xn.reshape((b * s) // PEER_TOKEN_BLOCK, PEER_TOKEN_BLOCK, d)

    def block(xt):
        t = xt.shape[0]
        q = (xt @ w_peer_q).reshape(t, PEER_HEADS, 2, PEER_HALF)
        sc = jnp.einsum('thid,hikd->thik', q, peer_keys).astype(jnp.float32)
        top_v, top_i = lax.top_k(sc, PEER_TOPK)
        cand = (top_v[:, :, 0, :, None] + top_v[:, :, 1, None, :]).reshape(t, PEER_HEADS, PEER_TOPK * PEER_TOPK)
        cidx = (top_i[:, :, 0, :, None] * PEER_N_KEYS + top_i[:, :, 1, None, :]).reshape(t, PEER_HEADS, PEER_TOPK * PEER_TOPK)
        best_v, best_pos = lax.top_k(cand, PEER_TOPK)
        eid = jnp.take_along_axis(cidx, best_pos, axis=-1)
        gate = jax.nn.softmax(best_v, axis=-1).astype(xt.dtype)
        u = peer_u[eid]
        act = jax.nn.gelu(jnp.einsum('thkd,td->thk', u, xt))
        v = peer_v[eid]
        return jnp.einsum('thk,thkd->td', gate * act, v)

    return lax.map(block, xb).reshape(b, s, d)


def setup_inputs(seed: int = 0) -> dict:
    key = jax.random.key(seed)
    ks = jax.random.split(key, 24)
    f32 = jnp.float32
    L = DEPTH

    def normal(k, shape, scale):
        return jax.random.normal(k, shape, f32) * scale

    def gain(k, shape):
        return 1.0 + 0.01 * jax.random.normal(k, shape, f32)

    x = normal(ks[0], (BATCH, SEQ, D_MODEL), 1.0)
    mem = normal(ks[1], (BATCH, MEM_LEN, D_MODEL), 1.0)
    ln_mix = gain(ks[2], (L, D_MODEL))
    w_in = normal(ks[3], (L, D_MODEL, IN_DIM), D_MODEL ** -0.5)
    conv_w = normal(ks[4], (L, SSD_CONV, SSD_CONV_DIM), SSD_CONV ** -0.5)
    conv_b = normal(ks[5], (L, SSD_CONV_DIM), 0.01)
    dt0 = jnp.exp(jax.random.uniform(ks[6], (L, SSD_HEADS), f32, math.log(DT_MIN), math.log(DT_MAX)))
    dt_bias = dt0 + jnp.log(-jnp.expm1(-dt0))
    a_log = jnp.log(jax.random.uniform(ks[7], (L, SSD_HEADS), f32, 1.0, 16.0))
    d_skip = gain(ks[8], (L, SSD_HEADS))
    ssd_norm = gain(ks[9], (L, SSD_INNER))
    gmlp_norm = gain(ks[10], (L, GMLP_INNER))
    w_spatial = normal(ks[11], (L, GMLP_GROUPS, GMLP_CHUNK, GMLP_CHUNK), GMLP_CHUNK ** -0.5)
    b_spatial = gain(ks[12], (L, GMLP_GROUPS, GMLP_CHUNK))
    ln_mem = gain(ks[13], (L, D_MODEL))
    w_mem_kv = normal(ks[14], (L, D_MODEL, 2 * XA_INNER), D_MODEL ** -0.5)
    w_branch = normal(ks[15], (L, N_BRANCH, BRANCH_WIDTH, D_MODEL), BRANCH_WIDTH ** -0.5)
    w_out = normal(ks[16], (L, D_MODEL, D_MODEL), D_MODEL ** -0.5)
    ln_ffn = gain(ks[17], (L, D_MODEL))
    w_peer_q = normal(ks[18], (L, D_MODEL, PEER_HEADS * PEER_QUERY_DIM), D_MODEL ** -0.5)
    peer_keys = normal(ks[19], (L, PEER_HEADS, 2, PEER_N_KEYS, PEER_HALF), PEER_HALF ** -0.5)
    peer_u = normal(ks[20], (L, PEER_N_EXPERTS, D_MODEL), D_MODEL ** -0.5)
    peer_v = normal(ks[21], (L, PEER_N_EXPERTS, D_MODEL), PEER_HEADS ** -0.5)
    ln_final = gain(ks[22], (D_MODEL,))
    return {'x': x, 'mem': mem, 'ln_mix': ln_mix, 'w_in': w_in, 'conv_w': conv_w, 'conv_b': conv_b,
            'dt_bias': dt_bias, 'a_log': a_log, 'd_skip': d_skip, 'ssd_norm': ssd_norm,
            'gmlp_norm': gmlp_norm, 'w_spatial': w_spatial, 'b_spatial': b_spatial,
            'ln_mem': ln_mem, 'w_mem_kv': w_mem_kv, 'w_branch': w_branch, 'w_out': w_out,
            'ln_ffn': ln_ffn, 'w_peer_q': w_peer_q, 'peer_keys': peer_keys, 'peer_u': peer_u,
            'peer_v': peer_v, 'ln_final': ln_final}


def reference(x, mem, ln_mix, w_in, conv_w, conv_b, dt_bias, a_log, d_skip, ssd_norm,
              gmlp_norm, w_spatial, b_spatial, ln_mem, w_mem_kv, w_branch, w_out,
              ln_ffn, w_peer_q, peer_keys, peer_u, peer_v, ln_final):
    b, s = x.shape[0], x.shape[1]
    bounds = np.cumsum([SSD_INNER, SSD_CONV_DIM, SSD_HEADS, GMLP_INNER, GMLP_INNER, XA_INNER]).tolist()
    for l in range(DEPTH):
        h = rms_norm(x, ln_mix[l])
        proj = h @ w_in[l]
        z, xbc, dt_raw, u, v, q, gates = jnp.split(proj, bounds, axis=-1)
        y_ssd = ssd_branch(xbc, z, dt_raw, conv_w[l], conv_b[l], dt_bias[l], a_log[l], d_skip[l], ssd_norm[l])
        y_gmlp = gmlp_branch(u, v, gmlp_norm[l], w_spatial[l], b_spatial[l])
        y_mem = memory_cross_attention(q, rms_norm(mem, ln_mem[l]), w_mem_kv[l])
        branches = jnp.stack([y_ssd, y_gmlp, y_mem], axis=2)
        proj_b = jnp.einsum('bsnw,nwd->bsnd', branches, w_branch[l])
        g = jax.nn.sigmoid(gates.reshape(b, s, N_BRANCH, D_MODEL))
        merged = jnp.sum(g * proj_b, axis=2)
        x = x + merged @ w_out[l]
        x = x + peer_ffn(rms_norm(x, ln_ffn[l]), w_peer_q[l], peer_keys[l], peer_u[l], peer_v[l])
    return rms_norm(x, ln_final)
```

```cpp
#include <hip/hip_runtime.h>
#include <hip/hip_cooperative_groups.h>
#include <cstdio>
#include <cstdint>
namespace cg = cooperative_groups;
namespace pg8 {
#define PG8_LAS __attribute__((address_space(3)))
typedef unsigned short bf16_t;
typedef short bf16x8 __attribute__((ext_vector_type(8)));
typedef float f32x4 __attribute__((ext_vector_type(4)));
typedef unsigned u32x4 __attribute__((ext_vector_type(4)));
constexpr int BM = 256, BK = 64, HALF = 128, HTB = HALF * BK * 2  , STAGE_BYTES = 8 * HTB, NXCD = 8, WGM = 8;

__host__ __device__ __forceinline__ int lds_byte(int r, int c) { const int st = (r >> 4) * 2 + (c >> 5), rr = r & 15, cc = c & 31, ob = rr * 64 + cc * 2; return st * 1024 + (ob ^ (((ob >> 9) & 1) << 5)); }
__host__ __device__ __forceinline__ void stage_rc(int b, int& R, int& C) { const int st = b / 1024, sb = b % 1024, swz = sb ^ (((sb >> 9) & 1) << 5); R = (st >> 1) * 16 + swz / 64; C = (st & 1) * 32 + (swz % 64) / 2; }
__host__ __device__ __forceinline__ int perm32(int rho) { const int n = rho >> 4, i = rho & 15; return 8 * (i >> 2) + 4 * n + (i & 3); }

struct Unit { int pm, pn; };
struct Gemm { const bf16_t* A; const bf16_t* Bt; int M, N, K; };

template <class Epi, class Sched, bool STAMP = false>
__device__ __forceinline__ void gemm_phase(PG8_LAS unsigned char* lds, const Gemm g, const Sched& S, const Epi& E, unsigned long long* stamps) {
    int tid_ = threadIdx.x; asm volatile("" : "+v"(tid_)); const int tid = tid_, wid = __builtin_amdgcn_readfirstlane(tid >> 6), lane = tid & 63, wr = wid >> 2, wc = wid & 3, fr = lane & 15, fq = lane >> 4;
    const int K = g.K, nt = K / BK;
    int ts_lo = 0, ts_hi = 0, nts = 0; const unsigned long long rt_entry = STAMP ? (unsigned long long)wall_clock64() : 0ull;
#define PG8_STAMP() do { if (STAMP && wid == 0 && nts < 64) { const unsigned long long _c = (unsigned long long)clock64(); \
        ts_lo = (lane == nts) ? (int)(unsigned)_c : ts_lo; ts_hi = (lane == nts) ? (int)(unsigned)(_c >> 32) : ts_hi; ++nts; } } while (0)
    PG8_STAMP();
    unsigned voffA[2], voffB[2];
#pragma unroll
    for (int i = 0; i < 2; ++i) { int R, C; stage_rc(tid * 16 + i * 8192, R, C); const int Rb = Epi::PERM ? ((R & ~31) + perm32(R & 31)) : R;
        voffA[i] = (unsigned)(R * K + C) * 2u; voffB[i] = (unsigned)(Rb * K + C) * 2u; }
    const size_t kstep = (size_t)(BK * 2);
    const size_t hstep = (size_t)HALF * K * 2;
    const size_t tstep = 2 * hstep;
    const unsigned ldsw = (unsigned)wid * 1024u;
    const int aoff = lds_byte(wr * 64 + fr, fq * 8), boff = lds_byte(wc * 32 + fr, fq * 8);
#define PG8_SA(b, h) (((b) * 2 + (h)) * HTB)
#define PG8_SB(b, h) ((4 + (b) * 2 + (h)) * HTB)
#define PG8_STAGE(bufoff, gbase, voff) do { _Pragma("unroll") for (int _i = 0; _i < 2; ++_i) \
        __builtin_amdgcn_global_load_lds((const unsigned*)((const char*)(gbase) + (voff)[_i]), (PG8_LAS unsigned*)(lds + (bufoff) + ldsw + _i * 8192), 16, 0, 0); } while (0)
#define PG8_LDA(dst, b, h) do { _Pragma("unroll") for (int m = 0; m < 4; ++m) _Pragma("unroll") for (int k = 0; k < 2; ++k) dst[m][k] = *(const PG8_LAS bf16x8*)(lds + PG8_SA(b, h) + aoff + m * 2048 + k * 1024); } while (0)
#define PG8_LDB(dst, b, h) do { _Pragma("unroll") for (int n = 0; n < 2; ++n) _Pragma("unroll") for (int k = 0; k < 2; ++k) dst[n][k] = *(const PG8_LAS bf16x8*)(lds + PG8_SB(b, h) + boff + n * 2048 + k * 1024); } while (0)
#define PG8_MMA(ai, bj, At, Bt) do { __builtin_amdgcn_s_setprio(1); _Pragma("unroll") for (int m = 0; m < 4; ++m) _Pragma("unroll") for (int n = 0; n < 2; ++n) _Pragma("unroll") for (int k = 0; k < 2; ++k) \
        acc[ai][bj][m][n] = __builtin_amdgcn_mfma_f32_16x16x32_bf16(Bt[n][k], At[m][k], acc[ai][bj][m][n], 0, 0, 0); __builtin_amdgcn_s_setprio(0); } while (0)
#define PG8_WAIT_V(n) asm volatile("s_waitcnt vmcnt(" #n ")" ::: "memory")
#define PG8_WAIT_L(n) asm volatile("s_waitcnt lgkmcnt(" #n ")" ::: "memory")
#define PG8_BAR __builtin_amdgcn_s_barrier()
#define PG8_SCHED __builtin_amdgcn_sched_barrier(0)
    Unit cur, nxt; int ui = 0;
    if (!S.next(0, cur)) return;
    f32x4 acc[2][2][4][2];
#pragma unroll
    for (int a = 0; a < 2; ++a)
#pragma unroll
        for (int b = 0; b < 2; ++b)
#pragma unroll
            for (int m = 0; m < 4; ++m)
#pragma unroll
                for (int n = 0; n < 2; ++n) acc[a][b][m][n] = (f32x4){0.f, 0.f, 0.f, 0.f};
    bf16x8 At[4][2], B0[2][2], B1[2][2];
    const char* cA = (const char*)g.A + (size_t)cur.pm * tstep; const char* cB = (const char*)g.Bt + (size_t)cur.pn * tstep;
    S.a_ready(cur);
    PG8_STAGE(PG8_SB(0, 0), cB, voffB); PG8_STAGE(PG8_SA(0, 0), cA, voffA); PG8_STAGE(PG8_SB(0, 1), cB + hstep, voffB); PG8_STAGE(PG8_SA(0, 1), cA + hstep, voffA);
    if (wr == 1) PG8_BAR;
    PG8_WAIT_V(4); PG8_BAR;
    PG8_STAGE(PG8_SB(1, 0), cB + kstep, voffB); PG8_STAGE(PG8_SA(1, 0), cA + kstep, voffA); PG8_STAGE(PG8_SB(1, 1), cB + hstep + kstep, voffB);
    PG8_WAIT_V(6); PG8_BAR;
    PG8_STAMP();
    for (;;) {
        const bool has_next = S.next(ui + 1, nxt);
        const char* nA = has_next ? (const char*)g.A + (size_t)nxt.pm * tstep : cA; const char* nB = has_next ? (const char*)g.Bt + (size_t)nxt.pn * tstep : cB;
        for (int t = 0; t < nt; t += 2) {
            const bool last = (t == nt - 2);
            const char* a1 = cA + (size_t)(t + 1) * kstep;
            const char* a2 = last ? nA : cA + (size_t)(t + 2) * kstep; const char* b2 = last ? nB : cB + (size_t)(t + 2) * kstep;
            const char* a3 = a2 + kstep; const char* b3 = b2 + kstep;
            if (last && has_next) S.a_ready(nxt);
            PG8_LDB(B0, 0, 0); PG8_SCHED; PG8_LDA(At, 0, 0); PG8_STAGE(PG8_SA(1, 1), a1 + hstep, voffA);
            PG8_WAIT_L(8); PG8_BAR; PG8_WAIT_L(0); PG8_MMA(0, 0, At, B0); PG8_BAR; PG8_SCHED;
            PG8_LDB(B1, 0, 1); PG8_STAGE(PG8_SB(0, 0), b2, voffB);
            PG8_BAR; PG8_WAIT_L(0); PG8_MMA(0, 1, At, B1); PG8_BAR;
            PG8_LDA(At, 0, 1); PG8_STAGE(PG8_SA(0, 0), a2, voffA);
            PG8_BAR; PG8_WAIT_L(0); PG8_MMA(1, 0, At, B0); PG8_BAR; PG8_SCHED;
            PG8_STAGE(PG8_SB(0, 1), b2 + hstep, voffB);
            PG8_WAIT_V(6); PG8_BAR; PG8_MMA(1, 1, At, B1); PG8_BAR;
            PG8_LDB(B0, 1, 0); PG8_SCHED; PG8_LDA(At, 1, 0); PG8_STAGE(PG8_SA(0, 1), a2 + hstep, voffA);
            PG8_WAIT_L(8); PG8_BAR; PG8_WAIT_L(0); PG8_MMA(0, 0, At, B0); PG8_BAR; PG8_SCHED;
            PG8_LDB(B1, 1, 1); PG8_STAGE(PG8_SB(1, 0), b3, voffB);
            PG8_BAR; PG8_WAIT_L(0); PG8_MMA(0, 1, At, B1); PG8_BAR;
            PG8_LDA(At, 1, 1); PG8_STAGE(PG8_SA(1, 0), a3, voffA);
            PG8_BAR; PG8_WAIT_L(0); PG8_MMA(1, 0, At, B0); PG8_BAR; PG8_SCHED;
            PG8_STAGE(PG8_SB(1, 1), b3 + hstep, voffB);
            PG8_WAIT_V(6); PG8_BAR; PG8_MMA(1, 1, At, B1); PG8_BAR;
        }
        PG8_STAMP();
        if constexpr (!Epi::AFTER_DRAIN) { E(acc, cur, wr, wc, fr, fq); S.done(cur); }
        PG8_STAMP();
        if (!has_next) break;
#pragma unroll
        for (int a = 0; a < 2; ++a)
#pragma unroll
            for (int b = 0; b < 2; ++b)
#pragma unroll
                for (int m = 0; m < 4; ++m)
#pragma unroll
                    for (int n = 0; n < 2; ++n) acc[a][b][m][n] = (f32x4){0.f, 0.f, 0.f, 0.f};
        cur = nxt; cA = nA; cB = nB; ++ui;
    }
    PG8_WAIT_V(0);
    if (wr == 0) PG8_BAR;
    PG8_BAR;
    if constexpr (Epi::AFTER_DRAIN) { E.fused(acc, cur, wr, wc, fr, fq, lds, wid, lane); S.done(cur); }
    PG8_STAMP();
    if (STAMP && wid == 0) { stamps[lane] = lane < nts ? (((unsigned long long)(unsigned)ts_hi << 32) | (unsigned)ts_lo) : 0ull;
        if (lane == 62) stamps[62] = rt_entry; if (lane == 63) stamps[63] = (unsigned long long)wall_clock64(); }
#undef PG8_STAMP
#undef PG8_SA
#undef PG8_SB
#undef PG8_STAGE
#undef PG8_LDA
#undef PG8_LDB
#undef PG8_MMA
#undef PG8_WAIT_V
#undef PG8_WAIT_L
#undef PG8_BAR
#undef PG8_SCHED
}
}

#define LAS __attribute__((address_space(3)))
#ifndef FSCOPE
#define FSCOPE "agent"
#endif
typedef pg8::bf16_t bf16_t;
typedef pg8::bf16x8 bf16x8;
typedef pg8::f32x4 f32x4;
typedef pg8::u32x4 u32x4;
typedef unsigned u32x2 __attribute__((ext_vector_type(2)));

constexpr int T_ALL = 32768, DM = 1024, TS = 16384, SEQ = 2048, NSLAB = 2;
constexpr int IN_DIM = 8720;
constexpr float EPS = 1e-6f;
constexpr int LDS_BYTES = 160 * 1024;
constexpr int NTHR = 512;

constexpr size_t al256(size_t x) { return (x + 255) & ~(size_t)255; }
constexpr size_t WS_CTL   = 0;
constexpr size_t WS_WINKV = 16384;
constexpr size_t WS_WB    = WS_WINKV + (size_t)11008 * 1024 * 2;
constexpr size_t WS_WO    = WS_WB + (size_t)3 * 1024 * 1024 * 2;
constexpr size_t WS_WQ    = WS_WO + (size_t)1024 * 1024 * 2;
constexpr size_t WS_KEYS  = WS_WQ + (size_t)2048 * 1024 * 2;
constexpr size_t WS_WSP   = WS_KEYS + (size_t)8 * 2 * 128 * 128 * 2;
constexpr size_t WS_PU    = WS_WSP + (size_t)8 * 128 * 128 * 2;
constexpr size_t WS_PV    = WS_PU + (size_t)16384 * 1024 * 2;
constexpr size_t WS_KB    = WS_PV + (size_t)16384 * 1024 * 2;
constexpr size_t WS_VT    = WS_KB + (size_t)4096 * 1024 * 2;
constexpr size_t WS_XB    = WS_VT + (size_t)4096 * 1024 * 2;
constexpr size_t WS_VSS   = WS_XB + (size_t)T_ALL * 1024 * 2;
constexpr size_t WS_SSS   = WS_VSS + (size_t)T_ALL * 16 * 4;
constexpr size_t WS_XSS   = WS_SSS + (size_t)T_ALL * 16 * 4;
constexpr size_t WS_DT    = WS_XSS + (size_t)T_ALL * 16 * 4;
constexpr size_t WS_H     = WS_DT + (size_t)T_ALL * 16 * 4;
constexpr size_t WS_SLAB  = WS_H + (size_t)(T_ALL + 4096) * 1024 * 2;
constexpr size_t SL_YB    = 0;
constexpr size_t SL_XBC   = SL_YB + (size_t)3 * TS * 1024 * 2;
constexpr size_t SL_SG    = SL_XBC + (size_t)TS * 1536 * 2;
constexpr size_t SL_END   = SL_SG + (size_t)TS * 3072 * 2;
constexpr size_t WS_Q2    = WS_SLAB;
constexpr size_t WS_EID   = WS_Q2 + (size_t)T_ALL * 2048 * 2;
constexpr size_t WS_GATE  = WS_EID + (size_t)T_ALL * 128 * 4;
constexpr size_t WS_END   = (WS_SLAB + SL_END) > (WS_GATE + (size_t)T_ALL * 128 * 4) ? (WS_SLAB + SL_END) : (WS_GATE + (size_t)T_ALL * 128 * 4);
static_assert(WS_END <= (size_t)512 * 1024 * 1024, "workspace map exceeds 512 MiB");

struct Params { const float* in[23]; float* out; unsigned char* ws; int seg_lo, seg_hi; };
static_assert(sizeof(Params) == 25 * 8 + 8, "Params has padding");

enum { I_X = 0, I_MEM, I_LN_MIX, I_W_IN, I_CONV_W, I_CONV_B, I_DT_BIAS, I_A_LOG, I_D_SKIP, I_SSD_NORM, I_GMLP_NORM, I_W_SPATIAL, I_B_SPATIAL, I_LN_MEM,
       I_W_MEM_KV, I_W_BRANCH, I_W_OUT, I_LN_FFN, I_W_PEER_Q, I_PEER_KEYS, I_PEER_U, I_PEER_V, I_LN_FINAL };

typedef float f32x2_t __attribute__((ext_vector_type(2)));
typedef __bf16 bf16x2_t __attribute__((ext_vector_type(2)));
__device__ __forceinline__ unsigned pk2(float lo, float hi) { const f32x2_t v = {lo, hi}; const bf16x2_t r = __builtin_convertvector(v, bf16x2_t); return __builtin_bit_cast(unsigned, r); }
__device__ __forceinline__ float bf_lo(unsigned w) { return __uint_as_float(w << 16); }
__device__ __forceinline__ float bf_hi(unsigned w) { return __uint_as_float(w & 0xffff0000u); }
__device__ __forceinline__ float sigmoid_f(float x) { return __builtin_amdgcn_rcpf(1.f + __expf(-x)); }
__device__ __forceinline__ float silu_f(float x) { return x * sigmoid_f(x); }
__device__ __forceinline__ float gelu_f(float x) { const float y = 1.5957691216f * (x + 0.044715f * x * x * x); return x * sigmoid_f(y); }
__device__ __forceinline__ f32x4 mfma16(bf16x8 a, bf16x8 b, f32x4 c) { return __builtin_amdgcn_mfma_f32_16x16x32_bf16(a, b, c, 0, 0, 0); }
__device__ __forceinline__ int swz(int row, int chunk) { return row * 256 + ((chunk ^ (row & 7)) << 4); }
__device__ __forceinline__ void lds_wait() { asm volatile("s_waitcnt lgkmcnt(0)" ::: "memory"); }
__device__ __forceinline__ float wave_sum64(float v) {
#pragma unroll
    for (int o = 1; o < 64; o <<= 1) v += __shfl_xor(v, o);
    return v;
}
__device__ __forceinline__ unsigned ord_key(float f) { const unsigned u = __float_as_uint(f); return u ^ ((unsigned)((int)u >> 31) | 0x80000000u); }
__device__ __forceinline__ float unord_key(unsigned k) { const unsigned u = (k & 0x80000000u) ? (k ^ 0x80000000u) : ~k; return __uint_as_float(u); }
__device__ __forceinline__ void ins16(unsigned (&l)[16], unsigned x) {
#pragma unroll
    for (int j = 0; j < 16; ++j) { const unsigned hi = l[j] > x ? l[j] : x; x = l[j] > x ? x : l[j]; l[j] = hi; }
}


typedef const unsigned char __attribute__((address_space(4)))* kaptr_t;
__device__ __forceinline__ kaptr_t kargs() { kaptr_t ka = (kaptr_t)__builtin_amdgcn_kernarg_segment_ptr(); asm volatile("" : "+s"(ka)); return ka; }
__device__ __forceinline__ const float* ka_in(kaptr_t ka, int i) { return *(const float* const __attribute__((address_space(4)))*)(ka + 8 * i); }
__device__ __forceinline__ float* ka_out(kaptr_t ka) { return *(float* const __attribute__((address_space(4)))*)(ka + 184); }
__device__ __forceinline__ unsigned char* ka_ws(kaptr_t ka) { return *(unsigned char* const __attribute__((address_space(4)))*)(ka + 192); }

__device__ __forceinline__ float sum16(const float* p) {
    const f32x4 a = *(const f32x4*)p, b = *(const f32x4*)(p + 4), c = *(const f32x4*)(p + 8), d = *(const f32x4*)(p + 12);
    return (((a.x + a.y) + (a.z + a.w)) + ((b.x + b.y) + (b.z + b.w))) + (((c.x + c.y) + (c.z + c.w)) + ((d.x + d.y) + (d.z + d.w)));
}
struct Ctx {
    LAS unsigned char* lds;
    int tid, lane, wid, G, bid;
};
__device__ __forceinline__ Ctx fresh_ctx(LAS unsigned char* lds) {
    Ctx C; C.lds = lds;
    int tid = threadIdx.x; asm volatile("" : "+v"(tid));
    int bid = blockIdx.x; asm volatile("" : "+s"(bid));
    C.tid = tid; C.lane = tid & 63; C.wid = __builtin_amdgcn_readfirstlane(tid >> 6); C.G = gridDim.x; C.bid = bid;
    return C;
}

template <class MapF>
__device__ __forceinline__ void transpose_item(const float* W, int K, int N, bf16_t* WT, MapF map, LAS float* scr, int item, int lane) {
    const int nblk = (N + 31) / 32, kb = item / nblk, nb = item % nblk, k0 = 64 * kb, n0 = 32 * nb;
    const int nl = n0 + (lane & 31);
#pragma unroll 8
    for (int i = 0; i < 32; ++i) { const int kk = 2 * i + (lane >> 5); scr[kk * 33 + (lane & 31)] = (nl < N) ? W[(size_t)(k0 + kk) * N + nl] : 0.f; }
    lds_wait();
    const int c = lane & 7;
#pragma unroll
    for (int j = 0; j < 4; ++j) {
        const int n = (lane >> 3) + 8 * j; const LAS float* s = scr + (8 * c) * 33 + n;
        u32x4 o; o.x = pk2(s[0 * 33], s[1 * 33]); o.y = pk2(s[2 * 33], s[3 * 33]); o.z = pk2(s[4 * 33], s[5 * 33]); o.w = pk2(s[6 * 33], s[7 * 33]);
        if (n0 + n < N) *(u32x4*)(WT + (size_t)map(n0 + n) * K + k0 + 8 * c) = o;
    }
    lds_wait();
}
struct MapId { int off; __device__ __forceinline__ int operator()(int n) const { return n + off; } };
struct MapWin { __device__ __forceinline__ int operator()(int n) const { return n < 2560 ? n : (n < 2576 ? 8704 + (n - 2560) : n - 16); } };

__device__ __forceinline__ void rms_row_bf16(const float* xrow, const float* gain, bf16_t* orow, int lane) {
    const f32x4* xr = (const f32x4*)xrow + lane; const f32x4* gr = (const f32x4*)gain + lane;
    f32x4 v[4]; float s = 0.f;
#pragma unroll
    for (int j = 0; j < 4; ++j) { v[j] = xr[64 * j]; s += (v[j].x * v[j].x + v[j].y * v[j].y) + (v[j].z * v[j].z + v[j].w * v[j].w); }
    const float rstd = rsqrtf(wave_sum64(s) * (1.f / 1024.f) + EPS);
    u32x2* o8 = (u32x2*)orow + lane;
#pragma unroll
    for (int j = 0; j < 4; ++j) { const f32x4 g = gr[64 * j]; u32x2 w; w.x = pk2(v[j].x * rstd * g.x, v[j].y * rstd * g.y); w.y = pk2(v[j].z * rstd * g.z, v[j].w * rstd * g.w); o8[64 * j] = w; }
}
__device__ __forceinline__ void cvt_row_bf16(const float* src, bf16_t* dst, int lane, bool tril, size_t ebase) {
#pragma unroll
    for (int j = 0; j < 2; ++j) {
        const int e = j * 512 + lane * 8;
        f32x4 a = *(const f32x4*)(src + e), b = *(const f32x4*)(src + e + 4);
        if (tril) { const int t = (int)(((ebase + e) >> 7) & 127), s0 = (int)((ebase + e) & 127);
            a.x = (s0 + 0 <= t) ? a.x : 0.f; a.y = (s0 + 1 <= t) ? a.y : 0.f; a.z = (s0 + 2 <= t) ? a.z : 0.f; a.w = (s0 + 3 <= t) ? a.w : 0.f;
            b.x = (s0 + 4 <= t) ? b.x : 0.f; b.y = (s0 + 5 <= t) ? b.y : 0.f; b.z = (s0 + 6 <= t) ? b.z : 0.f; b.w = (s0 + 7 <= t) ? b.w : 0.f; }
        u32x4 o; o.x = pk2(a.x, a.y); o.y = pk2(a.z, a.w); o.z = pk2(b.x, b.y); o.w = pk2(b.z, b.w);
        *(u32x4*)(dst + e) = o;
    }
}

__device__ __forceinline__ void p0_prep(const Ctx& C) {
    LAS float* scr = (LAS float*)(C.lds + C.wid * 8448);
    const int gw = C.bid * 8 + C.wid, NGW = C.G * 8, lane = C.lane;
    const kaptr_t ka = kargs();
    unsigned char* ws = ka_ws(ka);
    bf16_t* WINKV = (bf16_t*)(ws + WS_WINKV);
    constexpr int I_IN = 16 * 273, I_KV = 16 * 64, I_BR = 16 * 32, I_O = 16 * 32, I_Q = 16 * 64;
    constexpr int NTR = I_IN + I_KV + 3 * I_BR + I_O + I_Q;
    for (int it = gw; it < NTR; it += NGW) {
        int r = it;
        if (r < I_IN) { transpose_item(ka_in(ka, I_W_IN), 1024, IN_DIM, WINKV, MapWin{}, scr, r, lane); continue; } r -= I_IN;
        if (r < I_KV) { transpose_item(ka_in(ka, I_W_MEM_KV), 1024, 2048, WINKV, MapId{8960}, scr, r, lane); continue; } r -= I_KV;
        if (r < 3 * I_BR) { const int n = r / I_BR; transpose_item(ka_in(ka, I_W_BRANCH) + (size_t)n * 1024 * 1024, 1024, 1024, (bf16_t*)(ws + WS_WB), MapId{n * 1024}, scr, r % I_BR, lane); continue; } r -= 3 * I_BR;
        if (r < I_O) { transpose_item(ka_in(ka, I_W_OUT), 1024, 1024, (bf16_t*)(ws + WS_WO), MapId{0}, scr, r, lane); continue; } r -= I_O;
        transpose_item(ka_in(ka, I_W_PEER_Q), 1024, 2048, (bf16_t*)(ws + WS_WQ), MapId{0}, scr, r, lane);
    }
    for (int it = gw; it < 240; it += NGW) { u32x4 z = {0u, 0u, 0u, 0u}; u32x4* d = (u32x4*)(WINKV + (size_t)(8720 + it) * 1024); d[lane] = z; d[64 + lane] = z; }
    bf16_t* H = (bf16_t*)(ws + WS_H);
    for (int it = gw; it < T_ALL + 4096; it += NGW) {
        if (it < T_ALL) rms_row_bf16(ka_in(ka, I_X) + (size_t)it * 1024, ka_in(ka, I_LN_MIX), H + (size_t)it * 1024, lane);
        else rms_row_bf16(ka_in(ka, I_MEM) + (size_t)(it - T_ALL) * 1024, ka_in(ka, I_LN_MEM), H + (size_t)it * 1024, lane);
    }
    for (int it = gw; it < 16384 * 2 + 256 + 128; it += NGW) {
        int r = it;
        if (r < 16384) { cvt_row_bf16(ka_in(ka, I_PEER_U) + (size_t)r * 1024, (bf16_t*)(ws + WS_PU) + (size_t)r * 1024, lane, false, 0); continue; } r -= 16384;
        if (r < 16384) { cvt_row_bf16(ka_in(ka, I_PEER_V) + (size_t)r * 1024, (bf16_t*)(ws + WS_PV) + (size_t)r * 1024, lane, false, 0); continue; } r -= 16384;
        if (r < 256) { cvt_row_bf16(ka_in(ka, I_PEER_KEYS) + (size_t)r * 1024, (bf16_t*)(ws + WS_KEYS) + (size_t)r * 1024, lane, false, 0); continue; } r -= 256;
        cvt_row_bf16(ka_in(ka, I_W_SPATIAL) + (size_t)r * 1024, (bf16_t*)(ws + WS_WSP) + (size_t)r * 1024, lane, true, (size_t)r * 1024);
    }
    if (C.bid == 0) for (int i = C.tid; i < 4096; i += NTHR) ((unsigned*)(ws + WS_CTL))[i] = 0u;
}

struct SchedInProj {
    int slab, G, c;
    __device__ __forceinline__ bool next(int i, pg8::Unit& u) const {
        const int L = i * G + c; if (L >= 2304) return false;
        const int wgid = (L % 8) * 288 + L / 8;
        if (wgid < 2240) { const int gid = wgid / 280, r = wgid % 280; u.pm = slab * 64 + gid * 8 + (r % 8); u.pn = r / 8; }
        else { const int r = wgid - 2240; u.pm = 128 + slab * 8 + (r % 8); u.pn = 35 + r / 8; }
        return true;
    }
    __device__ __forceinline__ void a_ready(const pg8::Unit&) const {}
    __device__ __forceinline__ void done(const pg8::Unit&) const {}
};
__device__ __forceinline__ f32x4 act4(int mode, f32x4 v) {
    f32x4 r;
    if (mode == 0) r = v;
    else if (mode == 1) { r.x = silu_f(v.x); r.y = silu_f(v.y); r.z = silu_f(v.z); r.w = silu_f(v.w); }
    else if (mode == 2) { r.x = gelu_f(v.x); r.y = gelu_f(v.y); r.z = gelu_f(v.z); r.w = gelu_f(v.w); }
    else if (mode == 3) { r.x = sigmoid_f(v.x); r.y = sigmoid_f(v.y); r.z = sigmoid_f(v.z); r.w = sigmoid_f(v.w); }
    else r = v * 0.0625f;
    return r;
}
struct EpiInProj {
    static constexpr bool PERM = true, AFTER_DRAIN = false;
    bf16_t *YB, *XBC, *GV, *SG, *KB, *VT; float *DT, *VSS; const float* dt_bias; int tok0;
    __device__ __forceinline__ void operator()(const f32x4 (&acc)[2][2][4][2], const pg8::Unit& u, int wr, int wc, int fr, int fq) const {
        const int pn = u.pn;
        const int rbase = u.pm * 256 + wr * 64 + fr;
        const int cl = wc * 32 + 8 * fq;
        if (pn < 34) {
            bf16_t* dst; int ld, cofs, mode;
            if (pn < 4)       { dst = YB;                         ld = 1024; cofs = pn * 256;        mode = 1; }
            else if (pn < 10) { dst = XBC;                        ld = 1536; cofs = (pn - 4) * 256;  mode = 0; }
            else if (pn < 14) { dst = YB + (size_t)TS * 1024;     ld = 1024; cofs = (pn - 10) * 256; mode = 2; }
            else if (pn < 18) { dst = GV;                         ld = 1024; cofs = (pn - 14) * 256; mode = 2; }
            else if (pn < 22) { dst = YB + (size_t)2 * TS * 1024; ld = 1024; cofs = (pn - 18) * 256; mode = 4; }
            else              { dst = SG;                         ld = 3072; cofs = (pn - 22) * 256; mode = 3; }
            const bool is_v = (pn >= 14 && pn < 18);
#pragma unroll
            for (int ai = 0; ai < 2; ++ai)
#pragma unroll
                for (int m = 0; m < 4; ++m) {
                    const int gt = rbase + ai * 128 + m * 16, lt = gt - tok0;
                    bf16_t* rowp = dst + (size_t)lt * ld + cofs + cl; float ss = 0.f;
#pragma unroll
                    for (int bj = 0; bj < 2; ++bj) {
                        const f32x4 v0 = act4(mode, acc[ai][bj][m][0]), v1 = act4(mode, acc[ai][bj][m][1]);
                        ss += (v0.x * v0.x + v0.y * v0.y) + (v0.z * v0.z + v0.w * v0.w) + (v1.x * v1.x + v1.y * v1.y) + (v1.z * v1.z + v1.w * v1.w);
                        u32x4 w; w.x = pk2(v0.x, v0.y); w.y = pk2(v0.z, v0.w); w.z = pk2(v1.x, v1.y); w.w = pk2(v1.z, v1.w);
                        *(u32x4*)(rowp + bj * 128) = w;
                    }
                    if (is_v) { ss += __shfl_xor(ss, 16); ss += __shfl_xor(ss, 32); if (fq == 0) VSS[(size_t)gt * 16 + (pn - 14) * 4 + wc] = ss; }
                    __builtin_amdgcn_sched_barrier(0);
                }
        } else if (pn == 34) {
            if (wc == 0 && fq < 2) {
                const f32x4 b0 = *(const f32x4*)(dt_bias + 8 * fq), b1 = *(const f32x4*)(dt_bias + 8 * fq + 4);
#pragma unroll
                for (int ai = 0; ai < 2; ++ai)
#pragma unroll
                    for (int m = 0; m < 4; ++m) {
                        const int gt = rbase + ai * 128 + m * 16;
                        f32x4 v0 = acc[ai][0][m][0] + b0, v1 = acc[ai][0][m][1] + b1;
#pragma unroll
                        for (int j = 0; j < 4; ++j) { v0[j] = v0[j] > 20.f ? v0[j] : log1pf(__expf(v0[j])); v1[j] = v1[j] > 20.f ? v1[j] : log1pf(__expf(v1[j])); }
                        *(f32x4*)(DT + (size_t)gt * 16 + 8 * fq) = v0; *(f32x4*)(DT + (size_t)gt * 16 + 8 * fq + 4) = v1;
                        __builtin_amdgcn_sched_barrier(0);
                    }
            }
        } else {
            const int pk = pn - 35;
#pragma unroll
            for (int ai = 0; ai < 2; ++ai)
#pragma unroll
                for (int m = 0; m < 4; ++m) {
                    const int mrow = rbase + ai * 128 + m * 16 - T_ALL;
#pragma unroll
                    for (int bj = 0; bj < 2; ++bj) {
                        const f32x4 v0 = acc[ai][bj][m][0], v1 = acc[ai][bj][m][1];
                        if (pk < 4) {
                            u32x4 w; w.x = pk2(v0.x, v0.y); w.y = pk2(v0.z, v0.w); w.z = pk2(v1.x, v1.y); w.w = pk2(v1.z, v1.w);
                            *(u32x4*)(KB + (size_t)mrow * 1024 + pk * 256 + bj * 128 + cl) = w;
                        } else {
                            const int b = mrow >> 8, mm = mrow & 255, hh = pk - 4, d0 = bj * 128 + cl;
                            bf16_t* vp = VT + ((size_t)((b * 4 + hh) * 256 + d0)) * 256 + mm;
                            const unsigned w0 = pk2(v0.x, v0.y), w1 = pk2(v0.z, v0.w), w2 = pk2(v1.x, v1.y), w3 = pk2(v1.z, v1.w);
                            vp[0 * 256] = (bf16_t)(w0 & 0xffff); vp[1 * 256] = (bf16_t)(w0 >> 16); vp[2 * 256] = (bf16_t)(w1 & 0xffff); vp[3 * 256] = (bf16_t)(w1 >> 16);
                            vp[4 * 256] = (bf16_t)(w2 & 0xffff); vp[5 * 256] = (bf16_t)(w2 >> 16); vp[6 * 256] = (bf16_t)(w3 & 0xffff); vp[7 * 256] = (bf16_t)(w3 >> 16);
                        }
                    }
                    __builtin_amdgcn_sched_barrier(0);
                }
        }
    }
};

struct P2Ptrs {
    bf16_t *YB, *XBC, *GV, *KB, *VT, *WSP; float *DT, *VSS, *SSS;
    const float *conv_w, *conv_b, *a_log, *d_skip, *ssd_norm, *gmlp_norm, *b_spatial;
    int tok0, slab;
};

constexpr int RP = 272;
__device__ __forceinline__ void ssd_item(const Ctx& C, const P2Ptrs& P, int bl, int h) {
    LAS unsigned char* L = C.lds;
    constexpr int O_C = 0, O_B = 34816, O_BT = 69632, O_XT = 104448, O_ST = 121856, O_XS = 139264, O_DT = 156672, O_ACS = 157184, O_ADT = 157696;
    constexpr int XSP = 136;
    const int tid = C.tid, lane = C.lane, wid = C.wid, fr = lane & 15, fq = lane >> 4;
    const int g = h >> 3;
    const float a_h = -__expf(P.a_log[h]), d_h = P.d_skip[h];
    LAS float* dtv = (LAS float*)(L + O_DT); LAS float* acs = (LAS float*)(L + O_ACS); LAS float* adt = (LAS float*)(L + O_ADT);
    f32x4 st[4];
#pragma unroll
    for (int j = 0; j < 4; ++j) st[j] = (f32x4){0.f, 0.f, 0.f, 0.f};
    for (int i = tid; i < 64 * RP / 16; i += NTHR) *(LAS u32x4*)(L + O_ST + i * 16) = (u32x4){0u, 0u, 0u, 0u};
    bf16_t* ZS = P.YB;
    const int l0 = 16 * wid;
    const int fb = fr * RP + fq * 16;
    const int fbw = fb + l0 * RP;
    for (int c = 0; c < 16; ++c) {
        const int lt0 = bl * SEQ + c * 128;
        if (tid < 128) { const float dt = P.DT[(size_t)(P.tok0 + lt0 + tid) * 16 + h]; dtv[tid] = dt; adt[tid] = dt * a_h; }
        __syncthreads();
        if (tid < 128) { float s = 0.f; for (int l2 = 0; l2 <= tid; ++l2) s += adt[l2]; acs[tid] = s; }
        __syncthreads();
        if (tid < 320) {
            const int cc = tid % 40, seg = tid / 40;
            const int kind = cc < 8 ? 0 : (cc < 24 ? 1 : 2);
            const int ch = kind == 0 ? h * 64 + cc * 8 : (kind == 1 ? 1024 + g * 128 + (cc - 8) * 8 : 1280 + g * 128 + (cc - 24) * 8);
            float w[4][8], bb[8];
#pragma unroll
            for (int k = 0; k < 4; ++k) { const f32x4 a = *(const f32x4*)(P.conv_w + k * 1536 + ch), b = *(const f32x4*)(P.conv_w + k * 1536 + ch + 4);
                w[k][0] = a.x; w[k][1] = a.y; w[k][2] = a.z; w[k][3] = a.w; w[k][4] = b.x; w[k][5] = b.y; w[k][6] = b.z; w[k][7] = b.w; }
            { const f32x4 a = *(const f32x4*)(P.conv_b + ch), b = *(const f32x4*)(P.conv_b + ch + 4); bb[0] = a.x; bb[1] = a.y; bb[2] = a.z; bb[3] = a.w; bb[4] = b.x; bb[5] = b.y; bb[6] = b.z; bb[7] = b.w; }
            float xm[3][8];
            const int r0 = seg * 16;
            const float acs_last = acs[127];
            const bf16_t* xsrc = P.XBC + (size_t)(lt0 + r0) * 1536 + ch;
#pragma unroll
            for (int q = 0; q < 3; ++q) {
                u32x4 raw = {0u, 0u, 0u, 0u};
                if (c * 128 + r0 - 3 + q >= 0) raw = *(const u32x4*)(xsrc + (q - 3) * 1536);
                xm[q][0] = bf_lo(raw.x); xm[q][1] = bf_hi(raw.x); xm[q][2] = bf_lo(raw.y); xm[q][3] = bf_hi(raw.y); xm[q][4] = bf_lo(raw.z); xm[q][5] = bf_hi(raw.z); xm[q][6] = bf_lo(raw.w); xm[q][7] = bf_hi(raw.w);
            }
            const int xs_row = O_XS + cc * 16;
            const int tr_base = (kind == 0 ? O_XT + (cc * 8) * RP : O_BT + ((cc - 8) * 8) * RP);
            const int rm_base = (kind == 1 ? O_B + (cc - 8) * 16 : O_C + (cc - 24) * 16);
#pragma unroll 1
            for (int rr = 0; rr < 16; ++rr) {
                const int r = r0 + rr;
                const u32x4 raw = *(const u32x4*)(xsrc + rr * 1536);
                float cur[8], o[8];
                cur[0] = bf_lo(raw.x); cur[1] = bf_hi(raw.x); cur[2] = bf_lo(raw.y); cur[3] = bf_hi(raw.y); cur[4] = bf_lo(raw.z); cur[5] = bf_hi(raw.z); cur[6] = bf_lo(raw.w); cur[7] = bf_hi(raw.w);
#pragma unroll
                for (int j = 0; j < 8; ++j) { const float v = bb[j] + w[0][j] * xm[0][j] + w[1][j] * xm[1][j] + w[2][j] * xm[2][j] + w[3][j] * cur[j]; o[j] = silu_f(v);
                    xm[0][j] = xm[1][j]; xm[1][j] = xm[2][j]; xm[2][j] = cur[j]; }
                u32x4 pkd; pkd.x = pk2(o[0], o[1]); pkd.y = pk2(o[2], o[3]); pkd.z = pk2(o[4], o[5]); pkd.w = pk2(o[6], o[7]);
                if (kind == 0) *(LAS u32x4*)(L + xs_row + r * XSP) = pkd; else *(LAS u32x4*)(L + rm_base + r * RP) = pkd;
                if (kind != 2) {
                    const float sc = (kind == 0) ? dtv[r] : __expf(acs_last - acs[r]);
#pragma unroll
                    for (int j = 0; j < 8; ++j) *(LAS unsigned short*)(L + tr_base + j * RP + r * 2) = (unsigned short)(pk2(o[j] * sc, 0.f) & 0xffffu);
                }
            }
        }
        __syncthreads();
        bf16x8 cf[4];
#pragma unroll
        for (int ks = 0; ks < 4; ++ks) cf[ks] = *(const LAS bf16x8*)(L + O_C + fbw + ks * 64);
        f32x4 cb[8];
#pragma unroll
        for (int j = 0; j < 8; ++j) {
            cb[j] = (f32x4){0.f, 0.f, 0.f, 0.f};
#pragma unroll
            for (int ks = 0; ks < 4; ++ks) { const bf16x8 bf = *(const LAS bf16x8*)(L + O_B + fb + j * 16 * RP + ks * 64); cb[j] = mfma16(bf, cf[ks], cb[j]); }
        }
        __syncthreads();
        const int l = l0 + fr;
        const float al = acs[l];
#pragma unroll
        for (int j = 0; j < 8; ++j) {
            const f32x4 as = *(const LAS f32x4*)(L + O_ACS + fq * 16 + j * 64);
            float mv[4];
#pragma unroll
            for (int r = 0; r < 4; ++r) { const int s = 16 * j + 4 * fq + r; mv[r] = (s <= l) ? cb[j][r] * __expf(al - as[r]) : 0.f; }
            u32x2 w; w.x = pk2(mv[0], mv[1]); w.y = pk2(mv[2], mv[3]);
            *(LAS u32x2*)(L + O_B + l * RP + fq * 8 + j * 32) = w;
        }
        __syncthreads();
        {
            bf16x8 mf[4];
#pragma unroll
            for (int ks = 0; ks < 4; ++ks) mf[ks] = *(const LAS bf16x8*)(L + O_B + fbw + ks * 64);
            const float el = __expf(al);
            float ss = 0.f;
            bf16_t* zrow = ZS + (size_t)(lt0 + l) * 1024 + h * 64 + 4 * fq;
            const float* nwp = P.ssd_norm + h * 64 + 4 * fq;
#pragma unroll
            for (int jj = 0; jj < 4; ++jj) {
                f32x4 yd = {0.f, 0.f, 0.f, 0.f}, yo = {0.f, 0.f, 0.f, 0.f};
#pragma unroll
                for (int ks = 0; ks < 4; ++ks) {
                    const bf16x8 xf = *(const LAS bf16x8*)(L + O_XT + fb + jj * 16 * RP + ks * 64); yd = mfma16(xf, mf[ks], yd);
                    const bf16x8 sf = *(const LAS bf16x8*)(L + O_ST + fb + jj * 16 * RP + ks * 64); yo = mfma16(sf, cf[ks], yo);
                }
                const u32x2 xs4 = *(const LAS u32x2*)(L + O_XS + l * XSP + fq * 8 + jj * 32);
                const u32x2 zs4 = *(const u32x2*)(zrow + 16 * jj);
                const f32x4 nw = *(const f32x4*)(nwp + 16 * jj);
                float y[4], v[4];
                y[0] = yd[0] + el * yo[0] + d_h * bf_lo(xs4.x); y[1] = yd[1] + el * yo[1] + d_h * bf_hi(xs4.x);
                y[2] = yd[2] + el * yo[2] + d_h * bf_lo(xs4.y); y[3] = yd[3] + el * yo[3] + d_h * bf_hi(xs4.y);
                v[0] = y[0] * bf_lo(zs4.x); v[1] = y[1] * bf_hi(zs4.x); v[2] = y[2] * bf_lo(zs4.y); v[3] = y[3] * bf_hi(zs4.y);
                ss += (v[0] * v[0] + v[1] * v[1]) + (v[2] * v[2] + v[3] * v[3]);
                u32x2 o; o.x = pk2(v[0] * nw.x, v[1] * nw.y); o.y = pk2(v[2] * nw.z, v[3] * nw.w);
                *(u32x2*)(zrow + 16 * jj) = o;
            }
            ss += __shfl_xor(ss, 16); ss += __shfl_xor(ss, 32);
            if (fq == 0) P.SSS[(size_t)(P.tok0 + lt0 + l) * 16 + h] = ss;
        }
        {
            const int pt = wid & 3, nh = wid >> 2;
            const float dec = __expf(acs[127]);
            bf16x8 xf[4];
#pragma unroll
            for (int ks = 0; ks < 4; ++ks) xf[ks] = *(const LAS bf16x8*)(L + O_XT + fb + pt * 16 * RP + ks * 64);
#pragma unroll
            for (int jj = 0; jj < 4; ++jj) {
                st[jj] = st[jj] * dec;
#pragma unroll
                for (int ks = 0; ks < 4; ++ks) { const bf16x8 bt = *(const LAS bf16x8*)(L + O_BT + fb + (nh * 4 + jj) * 16 * RP + ks * 64); st[jj] = mfma16(bt, xf[ks], st[jj]); }
            }
            __syncthreads();
            const int p = 16 * pt + fr;
#pragma unroll
            for (int jj = 0; jj < 4; ++jj) {
                u32x2 w; w.x = pk2(st[jj][0], st[jj][1]); w.y = pk2(st[jj][2], st[jj][3]);
                *(LAS u32x2*)(L + O_ST + p * RP + fq * 8 + (nh * 4 + jj) * 32) = w;
            }
        }
    }
}

__device__ __forceinline__ void gmlp_item(const Ctx& C, const P2Ptrs& P, int idx) {
    LAS unsigned char* L = C.lds;
    const int tid = C.tid, lane = C.lane, wid = C.wid, fr = lane & 15, fq = lane >> 4;
    const int bl = idx >> 7, c = (idx >> 3) & 15, g = idx & 7;
    const int lt0 = bl * SEQ + c * 128;
    bf16_t* GU = P.YB + (size_t)TS * 1024;
    {
        const int s = tid >> 2, qd = tid & 3;
        const float rstd = rsqrtf(sum16(P.VSS + (size_t)(P.tok0 + lt0 + s) * 16) * (1.f / 1024.f) + EPS);
#pragma unroll
        for (int k = 0; k < 4; ++k) {
            const int ch0 = qd * 32 + k * 8;
            const u32x4 raw = *(const u32x4*)(P.GV + (size_t)(lt0 + s) * 1024 + g * 128 + ch0);
            const f32x4 n0 = *(const f32x4*)(P.gmlp_norm + g * 128 + ch0), n1 = *(const f32x4*)(P.gmlp_norm + g * 128 + ch0 + 4);
            float v[8]; v[0] = bf_lo(raw.x) * n0.x; v[1] = bf_hi(raw.x) * n0.y; v[2] = bf_lo(raw.y) * n0.z; v[3] = bf_hi(raw.y) * n0.w;
            v[4] = bf_lo(raw.z) * n1.x; v[5] = bf_hi(raw.z) * n1.y; v[6] = bf_lo(raw.w) * n1.z; v[7] = bf_hi(raw.w) * n1.w;
#pragma unroll
            for (int j = 0; j < 8; ++j) *(LAS unsigned short*)(L + (ch0 + j) * RP + s * 2) = (unsigned short)(pk2(v[j] * rstd, 0.f) & 0xffffu);
        }
    }
    __syncthreads();
    const int t0 = 16 * wid, nks = (t0 + 15) / 32 + 1;
    const int fb = fr * RP + fq * 16;
    f32x4 acc[8];
#pragma unroll
    for (int j = 0; j < 8; ++j) acc[j] = (f32x4){0.f, 0.f, 0.f, 0.f};
    for (int ks = 0; ks < nks; ++ks) {
        const bf16x8 wf = *(const bf16x8*)(P.WSP + (size_t)(g * 128 + t0 + fr) * 128 + ks * 32 + fq * 8);
#pragma unroll
        for (int j = 0; j < 8; ++j) { const bf16x8 vf = *(const LAS bf16x8*)(L + fb + j * 16 * RP + ks * 64); acc[j] = mfma16(vf, wf, acc[j]); }
    }
    const int t = t0 + fr;
    const float bias = P.b_spatial[g * 128 + t];
#pragma unroll
    for (int j = 0; j < 8; ++j) {
        bf16_t* gp = GU + (size_t)(lt0 + t) * 1024 + g * 128 + 16 * j + 4 * fq;
        const u32x2 gu = *(const u32x2*)gp;
        u32x2 o; o.x = pk2(bf_lo(gu.x) * (acc[j][0] + bias), bf_hi(gu.x) * (acc[j][1] + bias)); o.y = pk2(bf_lo(gu.y) * (acc[j][2] + bias), bf_hi(gu.y) * (acc[j][3] + bias));
        *(u32x2*)gp = o;
    }
}

__device__ __forceinline__ void xattn_item(const Ctx& C, const P2Ptrs& P, int idx) {
    LAS unsigned char* L = C.lds;
    constexpr int PP = 528;
    const int lane = C.lane, wid = C.wid, fr = lane & 15, fq = lane >> 4;
    const int bl = idx >> 6, h = (idx >> 4) & 3, qt = idx & 15;
    const int b = P.slab * 8 + bl;
    const int trow = 16 * wid + fr;
    const int lt = bl * SEQ + qt * 128 + trow;
    bf16_t* QX = P.YB + (size_t)2 * TS * 1024;
    bf16_t* qrow = QX + (size_t)lt * 1024 + h * 256;
    bf16x8 qf[8];
#pragma unroll
    for (int ks = 0; ks < 8; ++ks) qf[ks] = *(const bf16x8*)(qrow + ks * 32 + fq * 8);
    f32x4 s[16];
    const bf16_t* kbase = P.KB + (size_t)(b * 256 + fr) * 1024 + h * 256 + fq * 8;
    bf16x8 fa[8], fb[8];
#pragma unroll
    for (int ks = 0; ks < 8; ++ks) fa[ks] = *(const bf16x8*)(kbase + ks * 32);
#pragma unroll
    for (int j = 0; j < 16; j += 2) {
#pragma unroll
        for (int ks = 0; ks < 8; ++ks) fb[ks] = *(const bf16x8*)(kbase + (j + 1) * 16 * 1024 + ks * 32);
        __builtin_amdgcn_sched_barrier(0);
        s[j] = (f32x4){0.f, 0.f, 0.f, 0.f};
#pragma unroll
        for (int ks = 0; ks < 8; ++ks) s[j] = mfma16(fa[ks], qf[ks], s[j]);
        __builtin_amdgcn_sched_barrier(0);
        if (j + 2 < 16) {
#pragma unroll
            for (int ks = 0; ks < 8; ++ks) fa[ks] = *(const bf16x8*)(kbase + (j + 2) * 16 * 1024 + ks * 32);
        }
        __builtin_amdgcn_sched_barrier(0);
        s[j + 1] = (f32x4){0.f, 0.f, 0.f, 0.f};
#pragma unroll
        for (int ks = 0; ks < 8; ++ks) s[j + 1] = mfma16(fb[ks], qf[ks], s[j + 1]);
        __builtin_amdgcn_sched_barrier(0);
    }
    const bf16_t* vbase = P.VT + (size_t)((b * 4 + h) * 256 + fr) * 256 + fq * 8;
#pragma unroll
    for (int ks = 0; ks < 8; ++ks) fa[ks] = *(const bf16x8*)(vbase + ks * 32);
    float mx = -3.0e38f;
#pragma unroll
    for (int j = 0; j < 16; ++j) mx = fmaxf(fmaxf(fmaxf(s[j][0], s[j][1]), fmaxf(s[j][2], s[j][3])), mx);
    mx = fmaxf(mx, __shfl_xor(mx, 16)); mx = fmaxf(mx, __shfl_xor(mx, 32));
    float sum = 0.f;
#pragma unroll
    for (int j = 0; j < 16; ++j) {
        const float p0 = __expf(s[j][0] - mx), p1 = __expf(s[j][1] - mx), p2 = __expf(s[j][2] - mx), p3 = __expf(s[j][3] - mx);
        sum += (p0 + p1) + (p2 + p3);
        u32x2 w; w.x = pk2(p0, p1); w.y = pk2(p2, p3);
        *(LAS u32x2*)(L + trow * PP + fq * 8 + j * 32) = w;
    }
    sum += __shfl_xor(sum, 16); sum += __shfl_xor(sum, 32);
    __syncthreads();
    bf16x8 pf[8];
#pragma unroll
    for (int ks = 0; ks < 8; ++ks) pf[ks] = *(const LAS bf16x8*)(L + trow * PP + fq * 16 + ks * 64);
    const float inv = 1.f / sum;
#pragma unroll
    for (int j = 0; j < 16; j += 2) {
#pragma unroll
        for (int ks = 0; ks < 8; ++ks) fb[ks] = *(const bf16x8*)(vbase + (j + 1) * 16 * 256 + ks * 32);
        __builtin_amdgcn_sched_barrier(0);
        {
            f32x4 o = {0.f, 0.f, 0.f, 0.f};
#pragma unroll
            for (int ks = 0; ks < 8; ++ks) o = mfma16(fa[ks], pf[ks], o);
            u32x2 w; w.x = pk2(o[0] * inv, o[1] * inv); w.y = pk2(o[2] * inv, o[3] * inv);
            *(u32x2*)(qrow + 16 * j + 4 * fq) = w;
        }
        __builtin_amdgcn_sched_barrier(0);
        if (j + 2 < 16) {
#pragma unroll
            for (int ks = 0; ks < 8; ++ks) fa[ks] = *(const bf16x8*)(vbase + (j + 2) * 16 * 256 + ks * 32);
        }
        __builtin_amdgcn_sched_barrier(0);
        {
            f32x4 o = {0.f, 0.f, 0.f, 0.f};
#pragma unroll
            for (int ks = 0; ks < 8; ++ks) o = mfma16(fb[ks], pf[ks], o);
            u32x2 w; w.x = pk2(o[0] * inv, o[1] * inv); w.y = pk2(o[2] * inv, o[3] * inv);
            *(u32x2*)(qrow + 16 * (j + 1) + 4 * fq) = w;
        }
        __builtin_amdgcn_sched_barrier(0);
    }
}

__device__ __forceinline__ void p2_mixers(const Ctx& C, const P2Ptrs& P, unsigned* queue) {
    LAS int* slot = (LAS int*)(C.lds + LDS_BYTES - 16);
    int sq_next = C.bid;
    for (;;) {
        __syncthreads();
#ifdef STATIC_Q
        if (C.tid == 0) { *slot = sq_next; }
        sq_next += C.G;
#else
        if (C.tid == 0) *slot = (int)atomicAdd(queue, 1u);
#endif
        __syncthreads();
        const int item = *slot;
        if (item >= 128 + 512 + 1024) break;
#ifdef CNT_TEST
        if (C.tid == 0) atomicAdd(queue + 64 + item, 1u);
#endif
#ifndef P2MASK
#define P2MASK 7
#endif
#ifdef ZERO_LDS
        for (int i = C.tid; i < (LDS_BYTES - 64) / 16; i += NTHR) *(LAS u32x4*)(C.lds + i * 16) = (u32x4){0u, 0u, 0u, 0u};
        __syncthreads();
#endif
        if (item < 128) { if (P2MASK & 1) ssd_item(C, P, item >> 4, item & 15); }
        else if (item < 640) { if (P2MASK & 2) xattn_item(C, P, item - 128); }
        else { if (P2MASK & 4) gmlp_item(C, P, item - 640); }
    }
}

struct SchedBranch {
    int G, c;
    __device__ __forceinline__ bool next(int i, pg8::Unit& u) const {
        const int tile = i / 3, n = i - 3 * tile; const int L = tile * G + c; if (L >= 256) return false;
        const int wgid = (L % 8) * 32 + L / 8;
        u.pm = n * 64 + (wgid >> 2); u.pn = n * 4 + (wgid & 3); return true;
    }
    __device__ __forceinline__ void a_ready(const pg8::Unit&) const {}
    __device__ __forceinline__ void done(const pg8::Unit&) const {}
};
struct EpiBranch {
    static constexpr bool PERM = true, AFTER_DRAIN = false;
    const bf16_t* SG; float* MERGED; bf16_t* MB; const float* SSS; int tok0;
    __device__ __forceinline__ void operator()(const f32x4 (&acc)[2][2][4][2], const pg8::Unit& u, int wr, int wc, int fr, int fq) const {
        const int n = u.pn >> 2, pn = u.pn & 3, pm = u.pm & 63;
        const int rbase = pm * 256 + wr * 64 + fr;
        const int cbase = pn * 256 + wc * 32 + 8 * fq;
#pragma unroll
        for (int ai = 0; ai < 2; ++ai)
#pragma unroll
            for (int m = 0; m < 4; ++m) {
                const int lt = rbase + ai * 128 + m * 16;
                const float rs = (n == 0) ? rsqrtf(sum16(SSS + (size_t)(tok0 + lt) * 16) * (1.f / 1024.f) + EPS) : 1.f;
#pragma unroll
                for (int bj = 0; bj < 2; ++bj) {
                    const int col = cbase + bj * 128;
                    const u32x4 gw = *(const u32x4*)(SG + (size_t)lt * 3072 + n * 1024 + col);
                    float* mp = MERGED + (size_t)lt * 1024 + col;
                    f32x4 v0 = acc[ai][bj][m][0] * rs, v1 = acc[ai][bj][m][1] * rs;
                    v0.x *= bf_lo(gw.x); v0.y *= bf_hi(gw.x); v0.z *= bf_lo(gw.y); v0.w *= bf_hi(gw.y);
                    v1.x *= bf_lo(gw.z); v1.y *= bf_hi(gw.z); v1.z *= bf_lo(gw.w); v1.w *= bf_hi(gw.w);
                    if (n > 0) { v0 = v0 + *(const f32x4*)mp; v1 = v1 + *(const f32x4*)(mp + 4); }
                    if (n < 2) { *(f32x4*)mp = v0; *(f32x4*)(mp + 4) = v1; }
                    else { u32x4 w; w.x = pk2(v0.x, v0.y); w.y = pk2(v0.z, v0.w); w.z = pk2(v1.x, v1.y); w.w = pk2(v1.z, v1.w); *(u32x4*)(MB + (size_t)lt * 1024 + col) = w; }
                }
                __builtin_amdgcn_sched_barrier(0);
            }
    }
};
struct SchedTile256 {
    int G, c;
    __device__ __forceinline__ bool next(int i, pg8::Unit& u) const {
        const int L = i * G + c; if (L >= 256) return false;
        const int wgid = (L % 8) * 32 + L / 8; u.pm = wgid >> 2; u.pn = wgid & 3; return true;
    }
    __device__ __forceinline__ void a_ready(const pg8::Unit&) const {}
    __device__ __forceinline__ void done(const pg8::Unit&) const {}
};
struct EpiOut {
    static constexpr bool PERM = true, AFTER_DRAIN = false;
    const float* X; float* X2; bf16_t* XB; float* XSS; const float* ln_ffn; int tok0;
    __device__ __forceinline__ void operator()(const f32x4 (&acc)[2][2][4][2], const pg8::Unit& u, int wr, int wc, int fr, int fq) const {
        const int rbase = tok0 + u.pm * 256 + wr * 64 + fr;
        const int cbase = u.pn * 256 + wc * 32 + 8 * fq;
#pragma unroll
        for (int ai = 0; ai < 2; ++ai)
#pragma unroll
            for (int m = 0; m < 4; ++m) {
                const int gt = rbase + ai * 128 + m * 16; float ss = 0.f;
#pragma unroll
                for (int bj = 0; bj < 2; ++bj) {
                    const int col = cbase + bj * 128; const size_t off = (size_t)gt * 1024 + col;
                    const f32x4 v0 = acc[ai][bj][m][0] + *(const f32x4*)(X + off), v1 = acc[ai][bj][m][1] + *(const f32x4*)(X + off + 4);
                    *(f32x4*)(X2 + off) = v0; *(f32x4*)(X2 + off + 4) = v1;
                    ss += (v0.x * v0.x + v0.y * v0.y) + (v0.z * v0.z + v0.w * v0.w) + (v1.x * v1.x + v1.y * v1.y) + (v1.z * v1.z + v1.w * v1.w);
                    const f32x4 g0 = *(const f32x4*)(ln_ffn + col), g1 = *(const f32x4*)(ln_ffn + col + 4);
                    u32x4 w; w.x = pk2(v0.x * g0.x, v0.y * g0.y); w.y = pk2(v0.z * g0.z, v0.w * g0.w); w.z = pk2(v1.x * g1.x, v1.y * g1.y); w.w = pk2(v1.z * g1.z, v1.w * g1.w);
                    *(u32x4*)(XB + off) = w;
                }
                ss += __shfl_xor(ss, 16); ss += __shfl_xor(ss, 32); if (fq == 0) XSS[(size_t)gt * 16 + u.pn * 4 + wc] = ss;
                __builtin_amdgcn_sched_barrier(0);
            }
    }
};

struct SchedStatic {
    int nM, nN, nwg, G, c;
    __device__ __forceinline__ bool next(int i, pg8::Unit& u) const {
        const int L = i * G + c; if (L >= nwg) return false;
        int wgid = L; { const int q = nwg / 8, r = nwg % 8, xcd = wgid % 8, off = wgid / 8; wgid = (xcd < r ? xcd * (q + 1) : r * (q + 1) + (xcd - r) * q) + off; }
        const int nig = 8 * nN, gid = wgid / nig, fm = gid * 8, gsz = (nM - fm) < 8 ? (nM - fm) : 8;
        u.pm = fm + ((wgid % nig) % gsz); u.pn = (wgid % nig) / gsz; return true;
    }
    __device__ __forceinline__ void a_ready(const pg8::Unit&) const {}
    __device__ __forceinline__ void done(const pg8::Unit&) const {}
};
struct EpiQ {
    static constexpr bool PERM = true, AFTER_DRAIN = false;
    bf16_t* Q2; const float* XSS;
    __device__ __forceinline__ void operator()(const f32x4 (&acc)[2][2][4][2], const pg8::Unit& u, int wr, int wc, int fr, int fq) const {
        const int rbase = u.pm * 256 + wr * 64 + fr;
        const int cbase = u.pn * 256 + wc * 32 + 8 * fq;
#pragma unroll
        for (int ai = 0; ai < 2; ++ai)
#pragma unroll
            for (int m = 0; m < 4; ++m) {
                const int gt = rbase + ai * 128 + m * 16;
                const float rs = rsqrtf(sum16(XSS + (size_t)gt * 16) * (1.f / 1024.f) + EPS);
#pragma unroll
                for (int bj = 0; bj < 2; ++bj) {
                    const f32x4 v0 = acc[ai][bj][m][0] * rs, v1 = acc[ai][bj][m][1] * rs;
                    u32x4 w; w.x = pk2(v0.x, v0.y); w.y = pk2(v0.z, v0.w); w.z = pk2(v1.x, v1.y); w.w = pk2(v1.z, v1.w);
                    *(u32x4*)(Q2 + (size_t)gt * 2048 + cbase + bj * 128) = w;
                }
                __builtin_amdgcn_sched_barrier(0);
            }
    }
};

struct P67Ptrs { const bf16_t *Q2, *KEYS, *XB, *PU, *PV; int* EID; float* GATE; const float* XSS; float* X2; const float* ln_final; };

__device__ __forceinline__ void p67_tile(const Ctx& C, const P67Ptrs& P, int tile) {
    LAS unsigned char* L = C.lds;
    const int tid = C.tid, lane = C.lane, wid = C.wid, fr = lane & 15, fq = lane >> 4;
    const int gt0 = tile * 128;
    constexpr int O_SC = 0, O_MG = 0, O_FK = 16384, O_WL = 135168, O_EL = 139264;
    for (int h = 0; h < 8; ++h) {
        {
            const int t = 16 * wid + fr;
#pragma unroll
            for (int i = 0; i < 2; ++i) {
                bf16x8 qf[4];
#pragma unroll
                for (int ks = 0; ks < 4; ++ks) qf[ks] = *(const bf16x8*)(P.Q2 + (size_t)(gt0 + t) * 2048 + h * 256 + i * 128 + ks * 32 + fq * 8);
#pragma unroll
                for (int j = 0; j < 8; ++j) {
                    f32x4 a = {0.f, 0.f, 0.f, 0.f};
                    const bf16_t* kp = P.KEYS + (size_t)((h * 2 + i) * 128 + 16 * j + fr) * 128 + fq * 8;
#pragma unroll
                    for (int ks = 0; ks < 4; ++ks) { const bf16x8 kf = *(const bf16x8*)(kp + ks * 32); a = mfma16(kf, qf[ks], a); }
                    *(LAS f32x4*)(L + O_SC + ((i * 128 + t) * 132 + 16 * j + 4 * fq) * 4) = a;
                }
            }
        }
        __syncthreads();
        const int tt = tid & 127, ii = (tid >> 7) & 1, hf = tid >> 8;
        unsigned list[16];
#pragma unroll
        for (int j = 0; j < 16; ++j) list[j] = 0u;
        {
            const LAS unsigned char* row = L + O_SC + ((ii * 128 + tt) * 132 + hf * 64) * 4;
#pragma unroll 4
            for (int e4 = 0; e4 < 16; ++e4) {
                const f32x4 v = *(const LAS f32x4*)(row + e4 * 16);
#pragma unroll
                for (int q = 0; q < 4; ++q) ins16(list, (ord_key(v[q]) & ~127u) | (unsigned)(127 - (hf * 64 + e4 * 4 + q)));
            }
        }
        __syncthreads();
        if (hf == 1) {
#pragma unroll
            for (int j = 0; j < 16; ++j) *(LAS unsigned*)(L + O_MG + (j * 256 + (tid & 255)) * 4) = list[j];
        }
        __syncthreads();
        if (hf == 0) {
#pragma unroll
            for (int j = 0; j < 16; ++j) ins16(list, *(const LAS unsigned*)(L + O_MG + (j * 256 + tid) * 4));
#pragma unroll
            for (int j = 0; j < 16; ++j) *(LAS unsigned*)(L + O_FK + ((ii * 16 + j) * 128 + tt) * 4) = list[j];
        }
        __syncthreads();
        if (tid < 128) {
            float v1[16], v2[16];
#pragma unroll
            for (int a = 0; a < 16; ++a) { v1[a] = unord_key(*(const LAS unsigned*)(L + O_FK + ((0 * 16 + a) * 128 + tid) * 4) & ~127u); v2[a] = unord_key(*(const LAS unsigned*)(L + O_FK + ((1 * 16 + a) * 128 + tid) * 4) & ~127u); }
            unsigned cl[16];
#pragma unroll
            for (int j = 0; j < 16; ++j) cl[j] = 0u;
#pragma unroll
            for (int a = 0; a < 16; ++a)
#pragma unroll
                for (int b = 0; b < 16; ++b)
                    if ((a + 1) * (b + 1) <= 16) ins16(cl, (ord_key(v1[a] + v2[b]) & ~255u) | (unsigned)(255 - (a * 16 + b)));
            float val[16]; int eid[16]; float mx = -3.0e38f;
#pragma unroll
            for (int j = 0; j < 16; ++j) {
                const int pos = 255 - (int)(cl[j] & 255u), a = pos >> 4, b = pos & 15;
                const unsigned ka = *(const LAS unsigned*)(L + O_FK + ((0 * 16 + a) * 128 + tid) * 4), kb = *(const LAS unsigned*)(L + O_FK + ((1 * 16 + b) * 128 + tid) * 4);
                val[j] = unord_key(ka & ~127u) + unord_key(kb & ~127u);
                eid[j] = (127 - (int)(ka & 127u)) * 128 + (127 - (int)(kb & 127u));
                mx = fmaxf(mx, val[j]);
            }
            float sum = 0.f;
#pragma unroll
            for (int j = 0; j < 16; ++j) { val[j] = __expf(val[j] - mx); sum += val[j]; }
            const float inv = 1.f / sum;
            int* ep = P.EID + (size_t)(gt0 + tid) * 128 + h * 16; float* gp = P.GATE + (size_t)(gt0 + tid) * 128 + h * 16;
#pragma unroll
            for (int j = 0; j < 16; j += 4) {
                *(int4*)(ep + j) = make_int4(eid[j], eid[j + 1], eid[j + 2], eid[j + 3]);
                *(f32x4*)(gp + j) = (f32x4){val[j] * inv, val[j + 1] * inv, val[j + 2] * inv, val[j + 3] * inv};
            }
        }
        __syncthreads();
    }
    LAS float* WL = (LAS float*)(L + O_WL) + wid * 128; LAS int* EL = (LAS int*)(L + O_EL) + wid * 128;
    const int g4 = lane >> 4, s16 = lane & 15;
    for (int tl = 0; tl < 16; ++tl) {
        const int gt = gt0 + 16 * wid + tl;
        const float rstd = rsqrtf(sum16(P.XSS + (size_t)gt * 16) * (1.f / 1024.f) + EPS);
        float xf[64];
#pragma unroll
        for (int j = 0; j < 8; ++j) { const u32x4 w = *(const u32x4*)(P.XB + (size_t)gt * 1024 + j * 128 + s16 * 8);
            xf[j * 8 + 0] = bf_lo(w.x); xf[j * 8 + 1] = bf_hi(w.x); xf[j * 8 + 2] = bf_lo(w.y); xf[j * 8 + 3] = bf_hi(w.y); xf[j * 8 + 4] = bf_lo(w.z); xf[j * 8 + 5] = bf_hi(w.z); xf[j * 8 + 6] = bf_lo(w.w); xf[j * 8 + 7] = bf_hi(w.w); }
        const int e0 = P.EID[(size_t)gt * 128 + lane], e1 = P.EID[(size_t)gt * 128 + 64 + lane];
        const float ga0 = P.GATE[(size_t)gt * 128 + lane], ga1 = P.GATE[(size_t)gt * 128 + 64 + lane];
#pragma unroll 2
        for (int it = 0; it < 32; ++it) {
            const int p = 4 * it + g4, src = p & 63;
            const int e = __shfl(it < 16 ? e0 : e1, src); const float gate = __shfl(it < 16 ? ga0 : ga1, src);
            const bf16_t* row = P.PU + (size_t)e * 1024 + s16 * 8;
            float dot = 0.f;
#pragma unroll
            for (int j = 0; j < 8; ++j) { const u32x4 w = *(const u32x4*)(row + j * 128);
                dot += bf_lo(w.x) * xf[j * 8 + 0] + bf_hi(w.x) * xf[j * 8 + 1] + bf_lo(w.y) * xf[j * 8 + 2] + bf_hi(w.y) * xf[j * 8 + 3]
                     + bf_lo(w.z) * xf[j * 8 + 4] + bf_hi(w.z) * xf[j * 8 + 5] + bf_lo(w.w) * xf[j * 8 + 6] + bf_hi(w.w) * xf[j * 8 + 7]; }
            dot += __shfl_xor(dot, 1); dot += __shfl_xor(dot, 2); dot += __shfl_xor(dot, 4); dot += __shfl_xor(dot, 8);
            const float act = gelu_f(dot * rstd);
            if (s16 == 0) { WL[p] = gate * act; EL[p] = e; }
        }
        lds_wait();
        float acc[16];
#pragma unroll
        for (int j = 0; j < 16; ++j) acc[j] = 0.f;
#pragma unroll 4
        for (int p = 0; p < 128; ++p) {
            const int e = EL[p]; const float w = WL[p];
            const bf16_t* row = P.PV + (size_t)e * 1024 + lane * 8;
#pragma unroll
            for (int j = 0; j < 2; ++j) { const u32x4 q = *(const u32x4*)(row + j * 512);
                acc[j * 8 + 0] += w * bf_lo(q.x); acc[j * 8 + 1] += w * bf_hi(q.x); acc[j * 8 + 2] += w * bf_lo(q.y); acc[j * 8 + 3] += w * bf_hi(q.y);
                acc[j * 8 + 4] += w * bf_lo(q.z); acc[j * 8 + 5] += w * bf_hi(q.z); acc[j * 8 + 6] += w * bf_lo(q.w); acc[j * 8 + 7] += w * bf_hi(q.w); }
        }
        float ss = 0.f; float x3[16];
#pragma unroll
        for (int j = 0; j < 2; ++j) { const f32x4 a = *(const f32x4*)(P.X2 + (size_t)gt * 1024 + j * 512 + lane * 8), b = *(const f32x4*)(P.X2 + (size_t)gt * 1024 + j * 512 + lane * 8 + 4);
            x3[j * 8 + 0] = a.x + acc[j * 8 + 0]; x3[j * 8 + 1] = a.y + acc[j * 8 + 1]; x3[j * 8 + 2] = a.z + acc[j * 8 + 2]; x3[j * 8 + 3] = a.w + acc[j * 8 + 3];
            x3[j * 8 + 4] = b.x + acc[j * 8 + 4]; x3[j * 8 + 5] = b.y + acc[j * 8 + 5]; x3[j * 8 + 6] = b.z + acc[j * 8 + 6]; x3[j * 8 + 7] = b.w + acc[j * 8 + 7]; }
#pragma unroll
        for (int j = 0; j < 16; ++j) ss += x3[j] * x3[j];
        const float r3 = rsqrtf(wave_sum64(ss) * (1.f / 1024.f) + EPS);
#pragma unroll
        for (int j = 0; j < 2; ++j) { const f32x4 g0 = *(const f32x4*)(P.ln_final + j * 512 + lane * 8), g1 = *(const f32x4*)(P.ln_final + j * 512 + lane * 8 + 4);
            *(f32x4*)(P.X2 + (size_t)gt * 1024 + j * 512 + lane * 8) = (f32x4){x3[j * 8 + 0] * r3 * g0.x, x3[j * 8 + 1] * r3 * g0.y, x3[j * 8 + 2] * r3 * g0.z, x3[j * 8 + 3] * r3 * g0.w};
            *(f32x4*)(P.X2 + (size_t)gt * 1024 + j * 512 + lane * 8 + 4) = (f32x4){x3[j * 8 + 4] * r3 * g1.x, x3[j * 8 + 5] * r3 * g1.y, x3[j * 8 + 6] * r3 * g1.z, x3[j * 8 + 7] * r3 * g1.w}; }
        lds_wait();
    }
}

#ifndef MK_MULTI
#define MK_MULTI 0
#endif
constexpr int NSEG = 10;

__global__ void __launch_bounds__(NTHR, 2) fwd_megakernel(Params prm) {
    extern __shared__ __attribute__((aligned(16))) unsigned char lds_raw[];
    LAS unsigned char* const lds = (LAS unsigned char*)lds_raw;
    const int lo = prm.seg_lo, hi = prm.seg_hi;
#if MK_MULTI
#define GSYNC(k) do {} while (0)
#else
    cg::grid_group grid = cg::this_grid();
#define GSYNC(k) do { if (lo <= (k) && (k) + 1 < hi) { asm volatile("s_waitcnt vmcnt(0)" ::: "memory"); __builtin_amdgcn_fence(__ATOMIC_RELEASE, FSCOPE); asm volatile("s_waitcnt vmcnt(0)" ::: "memory"); \
        grid.sync(); __builtin_amdgcn_fence(__ATOMIC_ACQUIRE, FSCOPE); asm volatile("s_waitcnt vmcnt(0)" ::: "memory"); } } while (0)
#endif
#ifndef SEGMASK
#define SEGMASK 0x3ff
#endif
#define SEG(k) if (((SEGMASK >> (k)) & 1) && lo <= (k) && (k) < hi)

    SEG(0) { const Ctx C = fresh_ctx(lds); p0_prep(C); }
    GSYNC(0);
    for (int slab = 0; slab <= 2; ++slab) {
        const int sb = 1 + 3 * slab;
        SEG(sb) {
            if (slab > 0) {
                const Ctx C = fresh_ctx(lds); const kaptr_t ka = kargs(); unsigned char* ws = ka_ws(ka);
                const int ps = slab - 1;
                pg8::Gemm g{(bf16_t*)(ws + WS_H) + (size_t)ps * TS * 1024, (bf16_t*)(ws + WS_WO), 0, 0, 1024};
                SchedTile256 S{C.G, C.bid};
                EpiOut E{ka_in(ka, I_X), ka_out(ka), (bf16_t*)(ws + WS_XB), (float*)(ws + WS_XSS), ka_in(ka, I_LN_FFN), ps * TS};
                pg8::gemm_phase<EpiOut, SchedTile256>(C.lds, g, S, E, nullptr);
            }
            if (slab < 2) {
                const Ctx C = fresh_ctx(lds); const kaptr_t ka = kargs(); unsigned char* ws = ka_ws(ka); unsigned char* sl = ws + WS_SLAB;
                pg8::Gemm g{(bf16_t*)(ws + WS_H), (bf16_t*)(ws + WS_WINKV), 0, 0, 1024};
                SchedInProj S{slab, C.G, C.bid};
                EpiInProj E{(bf16_t*)(sl + SL_YB), (bf16_t*)(sl + SL_XBC), (bf16_t*)(ka_out(ka) + (size_t)TS * 1024), (bf16_t*)(sl + SL_SG), (bf16_t*)(ws + WS_KB), (bf16_t*)(ws + WS_VT),
                            (float*)(ws + WS_DT), (float*)(ws + WS_VSS), ka_in(ka, I_DT_BIAS), slab * TS};
                pg8::gemm_phase<EpiInProj, SchedInProj>(C.lds, g, S, E, nullptr);
            }
        }
        GSYNC(sb);
        if (slab < 2) {
            SEG(sb + 1) {
                const Ctx C = fresh_ctx(lds); const kaptr_t ka = kargs(); unsigned char* ws = ka_ws(ka); unsigned char* sl = ws + WS_SLAB;
                P2Ptrs P{(bf16_t*)(sl + SL_YB), (bf16_t*)(sl + SL_XBC), (bf16_t*)(ka_out(ka) + (size_t)TS * 1024), (bf16_t*)(ws + WS_KB), (bf16_t*)(ws + WS_VT), (bf16_t*)(ws + WS_WSP),
                         (float*)(ws + WS_DT), (float*)(ws + WS_VSS), (float*)(ws + WS_SSS),
                         ka_in(ka, I_CONV_W), ka_in(ka, I_CONV_B), ka_in(ka, I_A_LOG), ka_in(ka, I_D_SKIP), ka_in(ka, I_SSD_NORM), ka_in(ka, I_GMLP_NORM), ka_in(ka, I_B_SPATIAL), slab * TS, slab};
                p2_mixers(C, P, (unsigned*)(ws + WS_CTL) + slab);
            }
            GSYNC(sb + 1);
            SEG(sb + 2) {
                const Ctx C = fresh_ctx(lds); const kaptr_t ka = kargs(); unsigned char* ws = ka_ws(ka); unsigned char* sl = ws + WS_SLAB;
                pg8::Gemm g{(bf16_t*)(sl + SL_YB), (bf16_t*)(ws + WS_WB), 0, 0, 1024};
                SchedBranch S{C.G, C.bid};
                EpiBranch E{(bf16_t*)(sl + SL_SG), ka_out(ka) + (size_t)TS * 1024, (bf16_t*)(ws + WS_H) + (size_t)slab * TS * 1024, (float*)(ws + WS_SSS), slab * TS};
                pg8::gemm_phase<EpiBranch, SchedBranch>(C.lds, g, S, E, nullptr);
            }
            GSYNC(sb + 2);
        }
    }
    SEG(8) {
        const Ctx C = fresh_ctx(lds); const kaptr_t ka = kargs(); unsigned char* ws = ka_ws(ka);
        pg8::Gemm g{(bf16_t*)(ws + WS_XB), (bf16_t*)(ws + WS_WQ), 0, 0, 1024};
        SchedStatic S{128, 8, 1024, C.G, C.bid};
        EpiQ E{(bf16_t*)(ws + WS_Q2), (float*)(ws + WS_XSS)};
        pg8::gemm_phase<EpiQ, SchedStatic>(C.lds, g, S, E, nullptr);
    }
    GSYNC(8);
    SEG(9) {
        const Ctx C = fresh_ctx(lds); const kaptr_t ka = kargs(); unsigned char* ws = ka_ws(ka);
        P67Ptrs P{(bf16_t*)(ws + WS_Q2), (bf16_t*)(ws + WS_KEYS), (bf16_t*)(ws + WS_XB), (bf16_t*)(ws + WS_PU), (bf16_t*)(ws + WS_PV),
                  (int*)(ws + WS_EID), (float*)(ws + WS_GATE), (float*)(ws + WS_XSS), ka_out(ka), ka_in(ka, I_LN_FINAL)};
        for (int tile = C.bid; tile < 256; tile += C.G) { p67_tile(C, P, tile); __syncthreads(); }
    }
#ifdef DBG_STOP
    {
        asm volatile("s_waitcnt vmcnt(0)" ::: "memory"); __builtin_amdgcn_fence(__ATOMIC_RELEASE, FSCOPE); asm volatile("s_waitcnt vmcnt(0)" ::: "memory");
        grid.sync(); __builtin_amdgcn_fence(__ATOMIC_ACQUIRE, FSCOPE); asm volatile("s_waitcnt vmcnt(0)" ::: "memory");
        const kaptr_t ka = kargs(); unsigned char* ws = ka_ws(ka); float* out = ka_out(ka); unsigned char* sl = ws + WS_SLAB;
        const size_t n = (size_t)TS * 1024;
        const bf16_t* YB = (const bf16_t*)(sl + SL_YB); const bf16_t* XBC = (const bf16_t*)(sl + SL_XBC); const bf16_t* SG = (const bf16_t*)(sl + SL_SG);
        const bf16_t* KB = (const bf16_t*)(ws + WS_KB); const bf16_t* VT = (const bf16_t*)(ws + WS_VT); const bf16_t* MB = (const bf16_t*)(ws + WS_H); const bf16_t* XB = (const bf16_t*)(ws + WS_XB);
        const float* DT = (const float*)(ws + WS_DT); const float* VSS = (const float*)(ws + WS_VSS); const float* SSS = (const float*)(ws + WS_SSS); const float* XSS = (const float*)(ws + WS_XSS);
        float cnt_val = 0.f;
#ifdef CNT_TEST
        { const unsigned* q = (const unsigned*)(ws + WS_CTL) + 64; int bad = 0; for (int k = 0; k < 1664; ++k) bad += (q[k] != 1u) ? 1 : 0; cnt_val = 1.f + (float)bad; }
#endif
        for (size_t i = (size_t)blockIdx.x * NTHR + threadIdx.x; i < n; i += (size_t)gridDim.x * NTHR) {
            float v = 0.f;
#define BFV(p, idx) __uint_as_float(((unsigned)(p)[idx]) << 16)
#ifndef DUMPMASK
#define DUMPMASK 7
#endif
#ifdef XCOPY
            if (DUMPMASK & 16) v += BFV(XBC, i);
#endif
            if (DUMPMASK & 32) v += BFV(VT, i % ((size_t)2048 * 1024));
            if (DUMPMASK & 64) v += BFV(KB, i % ((size_t)2048 * 1024));
            if (DBG_STOP <= 3) { if (DUMPMASK & 1) v += BFV(YB, i); if (DUMPMASK & 2) v += BFV(YB, i + n); if (DUMPMASK & 4) v += BFV(YB, i + 2 * n); }
            if (DBG_STOP <= 2 && !(DUMPMASK & 8)) { v += BFV(XBC, i) + BFV(XBC, i + n / 2) + BFV(SG, i) + BFV(SG, i + n) + BFV(SG, i + 2 * n) + BFV(KB, i % ((size_t)2048 * 1024)) + BFV(VT, i % ((size_t)2048 * 1024))
                                     + DT[i % ((size_t)TS * 16)] + 1e-3f * VSS[i % ((size_t)TS * 16)]; }
            if (DBG_STOP == 2 && !(DUMPMASK & 8)) v += 1e-3f * SSS[i % ((size_t)TS * 16)];
            if (DBG_STOP == 3) v += BFV(MB, i);
            if (DBG_STOP >= 4) v = out[i] + BFV(XB, i) + 1e-3f * XSS[i % ((size_t)TS * 16)];
#ifdef CNT_TEST
            v = cnt_val; out[i + n] = v;
#endif
            out[i] = v;
        }
    }
#endif
}

extern "C" void kernel_launch(void* const* d_in, const int* in_sizes, int n_in, void* d_out, int out_size, void* d_ws, size_t ws_size, hipStream_t stream) {
    static int grid_blocks = 0;
    if (grid_blocks == 0) {
        if (n_in != 23 || out_size != T_ALL * DM || ws_size < WS_END) { fprintf(stderr, "kernel_launch: unexpected problem (n_in %d out %d ws %zu, need %zu)\n", n_in, out_size, ws_size, (size_t)WS_END); grid_blocks = -1; return; }
        int dev = 0, cus = 0, per_cu = 0;
        (void)hipGetDevice(&dev);
        (void)hipDeviceGetAttribute(&cus, hipDeviceAttributeMultiprocessorCount, dev);
        (void)hipFuncSetAttribute((const void*)fwd_megakernel, hipFuncAttributeMaxDynamicSharedMemorySize, LDS_BYTES);
        (void)hipOccupancyMaxActiveBlocksPerMultiprocessor(&per_cu, fwd_megakernel, NTHR, LDS_BYTES);
        if (per_cu < 1) { fprintf(stderr, "kernel_launch: occupancy query says 0 blocks per CU\n"); per_cu = 1; }
        grid_blocks = cus;
    }
    if (grid_blocks < 0) return;
    Params p{};
    for (int i = 0; i < 23; ++i) p.in[i] = (const float*)d_in[i];
    p.out = (float*)d_out; p.ws = (unsigned char*)d_ws;
#if MK_MULTI
    for (int s = 0; s < NSEG; ++s) { p.seg_lo = s; p.seg_hi = s + 1; hipLaunchKernelGGL(fwd_megakernel, dim3(grid_blocks), dim3(NTHR), LDS_BYTES, stream, p); }
#else
#ifdef DBG_STOP
    p.seg_lo = 0; p.seg_hi = DBG_STOP + 1;
#else
    p.seg_lo = 0; p.seg_hi = NSEG;
#endif
    void* args[] = {&p};
    hipError_t e = hipLaunchCooperativeKernel((void*)fwd_megakernel, dim3(grid_blocks), dim3(NTHR), args, LDS_BYTES, stream);
    if (e != hipSuccess) fprintf(stderr, "cooperative launch failed: %s (grid %d)\n", hipGetErrorString(e), grid_blocks);
#endif
}
```

```cpp
#include <hip/hip_runtime.h>
#include <hip/hip_cooperative_groups.h>
#include <cstdio>
#include <cstdint>
namespace cg = cooperative_groups;
namespace pg8 {
#define PG8_LAS __attribute__((address_space(3)))
typedef unsigned short bf16_t;
typedef short bf16x8 __attribute__((ext_vector_type(8)));
typedef float f32x4 __attribute__((ext_vector_type(4)));
typedef unsigned u32x4 __attribute__((ext_vector_type(4)));
constexpr int BM = 256, BK = 64, HALF = 128, HTB = HALF * BK * 2  , STAGE_BYTES = 8 * HTB, NXCD = 8, WGM = 8;

__host__ __device__ __forceinline__ int lds_byte(int r, int c) { const int st = (r >> 4) * 2 + (c >> 5), rr = r & 15, cc = c & 31, ob = rr * 64 + cc * 2; return st * 1024 + (ob ^ (((ob >> 9) & 1) << 5)); }
__host__ __device__ __forceinline__ void stage_rc(int b, int& R, int& C) { const int st = b / 1024, sb = b % 1024, swz = sb ^ (((sb >> 9) & 1) << 5); R = (st >> 1) * 16 + swz / 64; C = (st & 1) * 32 + (swz % 64) / 2; }
__host__ __device__ __forceinline__ int perm32(int rho) { const int n = rho >> 4, i = rho & 15; return 8 * (i >> 2) + 4 * n + (i & 3); }

struct Unit { int pm, pn; };
struct Gemm { const bf16_t* A; const bf16_t* Bt; int M, N, K; };

template <class Epi, class Sched, bool STAMP = false>
__device__ __forceinline__ void gemm_phase(PG8_LAS unsigned char* lds, const Gemm g, const Sched& S, const Epi& E, unsigned long long* stamps, int wave_s) {
    int tid_ = (wave_s << 6) | (int)__builtin_amdgcn_mbcnt_hi(~0u, __builtin_amdgcn_mbcnt_lo(~0u, 0u)); asm volatile("" : "+v"(tid_)); const int tid = tid_, wid = __builtin_amdgcn_readfirstlane(tid >> 6), lane = tid & 63, wr = wid >> 2, wc = wid & 3, fr = lane & 15, fq = lane >> 4;
    const int K = g.K, nt = K / BK;
    int ts_lo = 0, ts_hi = 0, nts = 0; const unsigned long long rt_entry = STAMP ? (unsigned long long)wall_clock64() : 0ull;
#define PG8_STAMP() do { if (STAMP && wid == 0 && nts < 64) { const unsigned long long _c = (unsigned long long)clock64(); \
        ts_lo = (lane == nts) ? (int)(unsigned)_c : ts_lo; ts_hi = (lane == nts) ? (int)(unsigned)(_c >> 32) : ts_hi; ++nts; } } while (0)
    PG8_STAMP();
    unsigned voffA[2], voffB[2];
#pragma unroll
    for (int i = 0; i < 2; ++i) { int R, C; stage_rc(tid * 16 + i * 8192, R, C); const int Rb = Epi::PERM ? ((R & ~31) + perm32(R & 31)) : R;
        voffA[i] = (unsigned)(R * K + C) * 2u; voffB[i] = (unsigned)(Rb * K + C) * 2u; }
    const size_t kstep = (size_t)(BK * 2);
    const size_t hstep = (size_t)HALF * K * 2;
    const size_t tstep = 2 * hstep;
    const unsigned ldsw = (unsigned)wid * 1024u;
    const int aoff = lds_byte(wr * 64 + fr, fq * 8), boff = lds_byte(wc * 32 + fr, fq * 8);
#define PG8_SA(b, h) (((b) * 2 + (h)) * HTB)
#define PG8_SB(b, h) ((4 + (b) * 2 + (h)) * HTB)
#define PG8_STAGE(bufoff, gbase, voff) do { _Pragma("unroll") for (int _i = 0; _i < 2; ++_i) \
        __builtin_amdgcn_global_load_lds((const unsigned*)((const char*)(gbase) + (voff)[_i]), (PG8_LAS unsigned*)(lds + (bufoff) + ldsw + _i * 8192), 16, 0, 0); } while (0)
#define PG8_LDA(dst, b, h) do { _Pragma("unroll") for (int m = 0; m < 4; ++m) _Pragma("unroll") for (int k = 0; k < 2; ++k) dst[m][k] = *(const PG8_LAS bf16x8*)(lds + PG8_SA(b, h) + aoff + m * 2048 + k * 1024); } while (0)
#define PG8_LDB(dst, b, h) do { _Pragma("unroll") for (int n = 0; n < 2; ++n) _Pragma("unroll") for (int k = 0; k < 2; ++k) dst[n][k] = *(const PG8_LAS bf16x8*)(lds + PG8_SB(b, h) + boff + n * 2048 + k * 1024); } while (0)
#define PG8_MMA(ai, bj, At, Bt) do { __builtin_amdgcn_s_setprio(1); _Pragma("unroll") for (int m = 0; m < 4; ++m) _Pragma("unroll") for (int n = 0; n < 2; ++n) _Pragma("unroll") for (int k = 0; k < 2; ++k) \
        acc[ai][bj][m][n] = __builtin_amdgcn_mfma_f32_16x16x32_bf16(Bt[n][k], At[m][k], acc[ai][bj][m][n], 0, 0, 0); __builtin_amdgcn_s_setprio(0); } while (0)
#define PG8_WAIT_V(n) asm volatile("s_waitcnt vmcnt(" #n ")" ::: "memory")
#define PG8_WAIT_L(n) asm volatile("s_waitcnt lgkmcnt(" #n ")" ::: "memory")
#define PG8_BAR __builtin_amdgcn_s_barrier()
#define PG8_SCHED __builtin_amdgcn_sched_barrier(0)
    Unit cur, nxt; int ui = 0;
    if (!S.next(0, cur)) return;
    f32x4 acc[2][2][4][2];
#pragma unroll
    for (int a = 0; a < 2; ++a)
#pragma unroll
        for (int b = 0; b < 2; ++b)
#pragma unroll
            for (int m = 0; m < 4; ++m)
#pragma unroll
                for (int n = 0; n < 2; ++n) acc[a][b][m][n] = (f32x4){0.f, 0.f, 0.f, 0.f};
    bf16x8 At[4][2], B0[2][2], B1[2][2];
    const char* cA = (const char*)g.A + (size_t)cur.pm * tstep; const char* cB = (const char*)g.Bt + (size_t)cur.pn * tstep;
    S.a_ready(cur);
    PG8_STAGE(PG8_SB(0, 0), cB, voffB); PG8_STAGE(PG8_SA(0, 0), cA, voffA); PG8_STAGE(PG8_SB(0, 1), cB + hstep, voffB); PG8_STAGE(PG8_SA(0, 1), cA + hstep, voffA);
    if (wr == 1) PG8_BAR;
    PG8_WAIT_V(4); PG8_BAR;
    PG8_STAGE(PG8_SB(1, 0), cB + kstep, voffB); PG8_STAGE(PG8_SA(1, 0), cA + kstep, voffA); PG8_STAGE(PG8_SB(1, 1), cB + hstep + kstep, voffB);
    PG8_WAIT_V(6); PG8_BAR;
    PG8_STAMP();
    for (;;) {
        const bool has_next = S.next(ui + 1, nxt);
        const char* nA = has_next ? (const char*)g.A + (size_t)nxt.pm * tstep : cA; const char* nB = has_next ? (const char*)g.Bt + (size_t)nxt.pn * tstep : cB;
        for (int t = 0; t < nt; t += 2) {
            const bool last = (t == nt - 2);
            const char* a1 = cA + (size_t)(t + 1) * kstep;
            const char* a2 = last ? nA : cA + (size_t)(t + 2) * kstep; const char* b2 = last ? nB : cB + (size_t)(t + 2) * kstep;
            const char* a3 = a2 + kstep; const char* b3 = b2 + kstep;
            if (last && has_next) S.a_ready(nxt);
            PG8_LDB(B0, 0, 0); PG8_SCHED; PG8_LDA(At, 0, 0); PG8_STAGE(PG8_SA(1, 1), a1 + hstep, voffA);
            PG8_WAIT_L(8); PG8_BAR; PG8_WAIT_L(0); PG8_MMA(0, 0, At, B0); PG8_BAR; PG8_SCHED;
            PG8_LDB(B1, 0, 1); PG8_STAGE(PG8_SB(0, 0), b2, voffB);
            PG8_BAR; PG8_WAIT_L(0); PG8_MMA(0, 1, At, B1); PG8_BAR;
            PG8_LDA(At, 0, 1); PG8_STAGE(PG8_SA(0, 0), a2, voffA);
            PG8_BAR; PG8_WAIT_L(0); PG8_MMA(1, 0, At, B0); PG8_BAR; PG8_SCHED;
            PG8_STAGE(PG8_SB(0, 1), b2 + hstep, voffB);
            PG8_WAIT_V(6); PG8_BAR; PG8_MMA(1, 1, At, B1); PG8_BAR;
            PG8_LDB(B0, 1, 0); PG8_SCHED; PG8_LDA(At, 1, 0); PG8_STAGE(PG8_SA(0, 1), a2 + hstep, voffA);
            PG8_WAIT_L(8); PG8_BAR; PG8_WAIT_L(0); PG8_MMA(0, 0, At, B0); PG8_BAR; PG8_SCHED;
            PG8_LDB(B1, 1, 1); PG8_STAGE(PG8_SB(1, 0), b3, voffB);
            PG8_BAR; PG8_WAIT_L(0); PG8_MMA(0, 1, At, B1); PG8_BAR;
            PG8_LDA(At, 1, 1); PG8_STAGE(PG8_SA(1, 0), a3, voffA);
            PG8_BAR; PG8_WAIT_L(0); PG8_MMA(1, 0, At, B0); PG8_BAR; PG8_SCHED;
            PG8_STAGE(PG8_SB(1, 1), b3 + hstep, voffB);
            PG8_WAIT_V(6); PG8_BAR; PG8_MMA(1, 1, At, B1); PG8_BAR;
        }
        PG8_STAMP();
        if constexpr (!Epi::AFTER_DRAIN) { if constexpr (Epi::WANTS_SCRATCH) E(acc, cur, wr, wc, fr, fq, At, B0, B1); else E(acc, cur, wr, wc, fr, fq); S.done(cur); }
        PG8_STAMP();
        if (!has_next) break;
        if constexpr (!Epi::MUT_ACC)
#pragma unroll
        for (int a = 0; a < 2; ++a)
#pragma unroll
            for (int b = 0; b < 2; ++b)
#pragma unroll
                for (int m = 0; m < 4; ++m)
#pragma unroll
                    for (int n = 0; n < 2; ++n) acc[a][b][m][n] = (f32x4){0.f, 0.f, 0.f, 0.f};
        cur = nxt; cA = nA; cB = nB; ++ui;
    }
    PG8_WAIT_V(0);
    if (wr == 0) PG8_BAR;
    PG8_BAR;
    if constexpr (Epi::AFTER_DRAIN) { E.fused(acc, cur, wr, wc, fr, fq, lds, wid, lane); S.done(cur); }
    PG8_STAMP();
    if (STAMP && wid == 0) { stamps[lane] = lane < nts ? (((unsigned long long)(unsigned)ts_hi << 32) | (unsigned)ts_lo) : 0ull;
        if (lane == 62) stamps[62] = rt_entry; if (lane == 63) stamps[63] = (unsigned long long)wall_clock64(); }
#undef PG8_STAMP
#undef PG8_SA
#undef PG8_SB
#undef PG8_STAGE
#undef PG8_LDA
#undef PG8_LDB
#undef PG8_MMA
#undef PG8_WAIT_V
#undef PG8_WAIT_L
#undef PG8_BAR
#undef PG8_SCHED
}
}

#define LAS __attribute__((address_space(3)))
#ifndef FSCOPE
#define FSCOPE "agent"
#endif
typedef pg8::bf16_t bf16_t;
typedef pg8::bf16x8 bf16x8;
typedef pg8::f32x4 f32x4;
typedef pg8::u32x4 u32x4;
typedef unsigned u32x2 __attribute__((ext_vector_type(2)));

constexpr int T_ALL = 32768, DM = 1024, TS = 16384, SEQ = 2048, NSLAB = 2;
constexpr int IN_DIM = 8720;
constexpr float EPS = 1e-6f;
constexpr int LDS_BYTES = 160 * 1024;
constexpr int NTHR = 512;

constexpr size_t al256(size_t x) { return (x + 255) & ~(size_t)255; }
constexpr size_t WS_CTL   = 0;
constexpr size_t WS_BAR   = 16384;
constexpr size_t WS_WINKV = 32768;
constexpr size_t WS_WB    = WS_WINKV + (size_t)11008 * 1024 * 2;
constexpr size_t WS_WO    = WS_WB + (size_t)3 * 1024 * 1024 * 2;
constexpr size_t WS_WQ    = WS_WO + (size_t)1024 * 1024 * 2;
constexpr size_t WS_KEYS  = WS_WQ + (size_t)2048 * 1024 * 2;
constexpr size_t WS_WSP   = WS_KEYS + (size_t)8 * 2 * 128 * 128 * 2;
constexpr size_t WS_PU    = WS_WSP + (size_t)8 * 128 * 128 * 2;
constexpr size_t WS_PV    = WS_PU + (size_t)16384 * 1024;
constexpr size_t WS_SU    = WS_PV + (size_t)16384 * 1024;
constexpr size_t WS_SV    = WS_SU + (size_t)16384 * 4;
constexpr size_t WS_KB    = WS_SV + (size_t)16384 * 4;
constexpr size_t WS_VT    = WS_KB + (size_t)4096 * 1024 * 2;
constexpr size_t WS_XB    = WS_VT + (size_t)4096 * 1024 * 2;
constexpr size_t WS_VSS   = WS_XB + (size_t)T_ALL * 1024 * 2;
constexpr size_t WS_SSS   = WS_VSS + (size_t)T_ALL * 16 * 4;
constexpr size_t WS_XSS   = WS_SSS + (size_t)T_ALL * 16 * 4;
constexpr size_t WS_DT    = WS_XSS + (size_t)T_ALL * 16 * 4;
constexpr size_t WS_H     = WS_DT + (size_t)T_ALL * 16 * 4;
constexpr size_t WS_SLAB  = WS_H + (size_t)(T_ALL + 4096) * 1024 * 2;
constexpr size_t SL_YB    = 0;
constexpr size_t SL_XBC   = SL_YB + (size_t)3 * TS * 1024 * 2;
constexpr size_t SL_SG    = SL_XBC + (size_t)TS * 1536 * 2;
constexpr size_t SL_END   = SL_SG + (size_t)TS * 3072 * 2;
constexpr size_t WS_Q2    = WS_SLAB;
constexpr size_t WS_EID   = WS_Q2 + (size_t)T_ALL * 2048 * 2;
constexpr size_t WS_GATE  = WS_EID + (size_t)T_ALL * 128 * 4;
constexpr size_t WS_PD    = WS_Q2;
constexpr size_t WS_PW    = WS_GATE + (size_t)T_ALL * 128 * 4;
constexpr size_t WS_SS3   = WS_PW + (size_t)T_ALL * 128 * 4;
constexpr size_t WS_PEND  = WS_SS3 + (size_t)T_ALL * 8 * 4;
constexpr size_t WS_END   = (WS_SLAB + SL_END) > WS_PEND ? (WS_SLAB + SL_END) : WS_PEND;
static_assert((size_t)8 * T_ALL * 128 * 4 <= (size_t)T_ALL * 2048 * 2, "partial dots must fit over Q2");
static_assert(WS_END <= (size_t)512 * 1024 * 1024, "workspace map exceeds 512 MiB");

struct Params { const float* in[23]; float* out; unsigned char* ws; int seg_lo, seg_hi; };
static_assert(sizeof(Params) == 25 * 8 + 8, "Params has padding");

enum { I_X = 0, I_MEM, I_LN_MIX, I_W_IN, I_CONV_W, I_CONV_B, I_DT_BIAS, I_A_LOG, I_D_SKIP, I_SSD_NORM, I_GMLP_NORM, I_W_SPATIAL, I_B_SPATIAL, I_LN_MEM,
       I_W_MEM_KV, I_W_BRANCH, I_W_OUT, I_LN_FFN, I_W_PEER_Q, I_PEER_KEYS, I_PEER_U, I_PEER_V, I_LN_FINAL };

typedef float f32x2_t __attribute__((ext_vector_type(2)));
typedef short s16x4 __attribute__((ext_vector_type(4)));
typedef short s16x8 __attribute__((ext_vector_type(8)));
typedef float f2v __attribute__((ext_vector_type(2)));
typedef __bf16 bf16x2_t __attribute__((ext_vector_type(2)));
__device__ __forceinline__ unsigned pk2(float lo, float hi) { const f32x2_t v = {lo, hi}; const bf16x2_t r = __builtin_convertvector(v, bf16x2_t); return __builtin_bit_cast(unsigned, r); }
__device__ __forceinline__ float dpp_xor1(float v) { return __builtin_bit_cast(float, __builtin_amdgcn_update_dpp(0, __builtin_bit_cast(int, v), 0xB1, 0xf, 0xf, true)); }
__device__ __forceinline__ float dpp_xor2(float v) { return __builtin_bit_cast(float, __builtin_amdgcn_update_dpp(0, __builtin_bit_cast(int, v), 0x4E, 0xf, 0xf, true)); }
__device__ __forceinline__ float dpp_xor4(float v) { const int h = __builtin_amdgcn_update_dpp(0, __builtin_bit_cast(int, v), 0x141, 0xf, 0xf, true); return __builtin_bit_cast(float, __builtin_amdgcn_update_dpp(0, h, 0x1B, 0xf, 0xf, true)); }
__device__ __forceinline__ float bf_lo(unsigned w) { return __uint_as_float(w << 16); }
__device__ __forceinline__ float bf_hi(unsigned w) { return __uint_as_float(w & 0xffff0000u); }
__device__ __forceinline__ float sigmoid_f(float x) { return __builtin_amdgcn_rcpf(1.f + __expf(-x)); }
__device__ __forceinline__ float silu_f(float x) { return x * sigmoid_f(x); }
__device__ __forceinline__ float gelu_f(float x) { const float y = 1.5957691216f * (x + 0.044715f * x * x * x); return x * sigmoid_f(y); }
__device__ __forceinline__ f32x4 mfma16(bf16x8 a, bf16x8 b, f32x4 c) { return __builtin_amdgcn_mfma_f32_16x16x32_bf16(a, b, c, 0, 0, 0); }
__device__ __forceinline__ int swz(int row, int chunk) { return row * 256 + ((chunk ^ (row & 7)) << 4); }
__device__ __forceinline__ void lds_wait() { asm volatile("s_waitcnt lgkmcnt(0)" ::: "memory"); }
__device__ __forceinline__ float wave_sum64(float v) {
#pragma unroll
    for (int o = 1; o < 64; o <<= 1) v += __shfl_xor(v, o);
    return v;
}
__device__ __forceinline__ unsigned ord_key(float f) { const unsigned u = __float_as_uint(f); return u ^ ((unsigned)((int)u >> 31) | 0x80000000u); }
__device__ __forceinline__ float unord_key(unsigned k) { const unsigned u = (k & 0x80000000u) ? (k ^ 0x80000000u) : ~k; return __uint_as_float(u); }
__device__ __forceinline__ void ins16(unsigned (&l)[16], unsigned x) {
#pragma unroll
    for (int j = 0; j < 16; ++j) { const unsigned hi = l[j] > x ? l[j] : x; x = l[j] > x ? x : l[j]; l[j] = hi; }
}


#undef LAS
#define XB_TMO      128
#define XB_XCNT(j)  (256  + 64 * (j))
#define XB_XSUB(j)  (1280 + 64 * (j))
#define XB_XGEN(j)  (2304 + 64 * (j))
#define XB_TOP      3328
#define XB_TOPGEN   3392
#define XCD_BAR_WORDS 3456
#define XB_SPIN_CAP (1u << 23)
#define LAS __attribute__((address_space(3)))

__device__ __forceinline__ unsigned xb_ld(unsigned* p)              { return __hip_atomic_load(p, __ATOMIC_RELAXED, __HIP_MEMORY_SCOPE_AGENT); }
__device__ __forceinline__ unsigned xb_add(unsigned* p, unsigned v) { return __hip_atomic_fetch_add(p, v, __ATOMIC_RELAXED, __HIP_MEMORY_SCOPE_AGENT); }
__device__ __forceinline__ unsigned xb_xcc_id() { return (unsigned)__builtin_amdgcn_s_getreg((3 << 11) | 20) & 0xFu; }
#define XB_T0(b) ((b).wv == 0u && __builtin_amdgcn_mbcnt_hi(~0u, __builtin_amdgcn_mbcnt_lo(~0u, 0u)) == 0u)
#define XB_SPIN(cond, bar) do { unsigned _sp = 0; while (cond) { __builtin_amdgcn_s_sleep(1); \
    if ((++_sp & 255u) == 0u) { if (xb_ld(&(bar)[XB_TMO])) break; if (_sp > XB_SPIN_CAP) { atomicAdd(&(bar)[XB_TMO], 1u); break; } } } } while (0)

struct XcdBarrier {
    unsigned wv;
    unsigned* bar; unsigned x;
    volatile LAS unsigned* st;
};

__device__ __forceinline__ XcdBarrier xcd_barrier_post(unsigned wv, unsigned* bar, volatile LAS unsigned* st) {
    XcdBarrier b; b.wv = wv; b.bar = bar; b.x = xb_xcc_id(); b.st = st;
    if (XB_T0(b)) (void)xb_add(&bar[XB_XCNT(b.x)], 1u);
    return b;
}
__device__ __forceinline__ void xcd_barrier_complete(unsigned* bar, unsigned x, unsigned& nloc, unsigned& nx) {
    const unsigned G = gridDim.x * gridDim.y * gridDim.z;
    unsigned sum, cnt, mine, sp = 0u;
    for (;;) {
        sum = 0u; cnt = 0u; mine = 0u;
#pragma unroll
        for (unsigned j = 0; j < 16; ++j) { const unsigned c = xb_ld(&bar[XB_XCNT(j)]); sum += c; cnt += (c > 0u) ? 1u : 0u; mine = (j == x) ? c : mine; }
        if (sum == G) break;
        __builtin_amdgcn_s_sleep(1);
        if ((++sp & 255u) == 0u) { if (xb_ld(&bar[XB_TMO])) break; if (sp > XB_SPIN_CAP) { atomicAdd(&bar[XB_TMO], 1u); break; } }
    }
    nloc = mine > 0u ? mine : 1u; nx = cnt > 0u ? cnt : 1u;
}

__device__ __forceinline__ void xcd_barrier(const XcdBarrier& b) {
    asm volatile("s_waitcnt vmcnt(0)" ::: "memory");
    __syncthreads();
    if (XB_T0(b)) {
        unsigned* bar = b.bar;
        __builtin_amdgcn_s_waitcnt(0);
        unsigned nloc = b.st[0], nx = b.st[1];
        if (nloc == 0u) { xcd_barrier_complete(bar, b.x, nloc, nx); b.st[0] = nloc; b.st[1] = nx; }
        const unsigned old = xb_add(&bar[XB_XSUB(b.x)], 1u);
        const unsigned gen = old / nloc;
        if (old + 1u == (gen + 1u) * nloc) {
            __builtin_amdgcn_fence(__ATOMIC_RELEASE, "agent");
            asm volatile("s_waitcnt vmcnt(0)" ::: "memory");
            const unsigned og = xb_add(&bar[XB_TOP], 1u);
            const unsigned tg = og / nx;
            if (og + 1u == (tg + 1u) * nx) xb_add(&bar[XB_TOPGEN], 1u);
            else XB_SPIN(xb_ld(&bar[XB_TOPGEN]) == tg, bar);
            __builtin_amdgcn_fence(__ATOMIC_ACQUIRE, "agent");
            xb_add(&bar[XB_XGEN(b.x)], 1u);
            asm volatile("s_waitcnt vmcnt(0)" ::: "memory");
        } else {
            XB_SPIN(xb_ld(&bar[XB_XGEN(b.x)]) == gen, bar);
            __builtin_amdgcn_fence(__ATOMIC_ACQUIRE, "agent");
            asm volatile("s_waitcnt vmcnt(0)" ::: "memory");
        }
    }
    __syncthreads();
}

typedef const unsigned char __attribute__((address_space(4)))* kaptr_t;
__device__ __forceinline__ kaptr_t kargs() { kaptr_t ka = (kaptr_t)__builtin_amdgcn_kernarg_segment_ptr(); asm volatile("" : "+s"(ka)); return ka; }
__device__ __forceinline__ const float* ka_in(kaptr_t ka, int i) { return *(const float* const __attribute__((address_space(4)))*)(ka + 8 * i); }
__device__ __forceinline__ float* ka_out(kaptr_t ka) { return *(float* const __attribute__((address_space(4)))*)(ka + 184); }
__device__ __forceinline__ unsigned char* ka_ws(kaptr_t ka) { return *(unsigned char* const __attribute__((address_space(4)))*)(ka + 192); }

__device__ __forceinline__ float sum16(const float* p) {
    const f32x4 a = *(const f32x4*)p, b = *(const f32x4*)(p + 4), c = *(const f32x4*)(p + 8), d = *(const f32x4*)(p + 12);
    return (((a.x + a.y) + (a.z + a.w)) + ((b.x + b.y) + (b.z + b.w))) + (((c.x + c.y) + (c.z + c.w)) + ((d.x + d.y) + (d.z + d.w)));
}
__device__ __forceinline__ void merge16(unsigned (&a)[16], const unsigned (&b)[16]) {
#pragma unroll
    for (int i = 0; i < 16; ++i) a[i] = max(a[i], b[15 - i]);
#pragma unroll
    for (int ls = 3; ls >= 0; --ls)
#pragma unroll
        for (int i = 0; i < 16; ++i) {
            const int st = 1 << ls;
            if ((i & st) == 0) { const unsigned hi = max(a[i], a[i + st]), lo = min(a[i], a[i + st]); a[i] = hi; a[i + st] = lo; }
        }
}
__device__ __forceinline__ void sort16(unsigned (&a)[16]) {
#pragma unroll
    for (int lp = 0; lp < 4; ++lp)
#pragma unroll
        for (int lk = lp; lk >= 0; --lk)
#pragma unroll
            for (int i = 0; i < 16; ++i) {
                const int p = 1 << lp, k = 1 << lk, r = k % p, l = i + k;
                if (l < 16 && i >= r && ((i - r) % (2 * k)) < k && (i / (2 * p)) == (l / (2 * p))) { const unsigned hi = max(a[i], a[l]), lo = min(a[i], a[l]); a[i] = hi; a[l] = lo; }
            }
}
struct Ctx {
    LAS unsigned char* lds;
    int tid, lane, wid, G, bid;
};
__device__ __forceinline__ Ctx fresh_ctx(LAS unsigned char* lds, int wave_s) {
    Ctx C; C.lds = lds;
    int tid = (wave_s << 6) | (int)__builtin_amdgcn_mbcnt_hi(~0u, __builtin_amdgcn_mbcnt_lo(~0u, 0u)); asm volatile("" : "+v"(tid));
    int bid = blockIdx.x; asm volatile("" : "+s"(bid));
    C.tid = tid; C.lane = tid & 63; C.wid = wave_s; C.G = gridDim.x; C.bid = bid;
    return C;
}

template <class MapF>
__device__ __forceinline__ void transpose_item(const float* W, int K, int N, bf16_t* WT, MapF map, LAS float* scr, int item, int lane, const float* krow_scale = nullptr) {
    const int nblk = (N + 31) / 32, kb = item / nblk, nb = item % nblk, k0 = 64 * kb, n0 = 32 * nb;
    const int nl = n0 + (lane & 31);
    float tv[32];
#pragma unroll
    for (int i = 0; i < 32; ++i) { const int kk = 2 * i + (lane >> 5); tv[i] = (nl < N) ? W[(size_t)(k0 + kk) * N + nl] : 0.f; if (krow_scale) tv[i] *= krow_scale[k0 + kk]; }
#pragma unroll
    for (int i = 0; i < 32; ++i) { const int kk = 2 * i + (lane >> 5); scr[kk * 33 + (lane & 31)] = tv[i]; }
    lds_wait();
    const int c = lane & 7;
#pragma unroll
    for (int j = 0; j < 4; ++j) {
        const int n = (lane >> 3) + 8 * j; const LAS float* s = scr + (8 * c) * 33 + n;
        u32x4 o; o.x = pk2(s[0 * 33], s[1 * 33]); o.y = pk2(s[2 * 33], s[3 * 33]); o.z = pk2(s[4 * 33], s[5 * 33]); o.w = pk2(s[6 * 33], s[7 * 33]);
        if (n0 + n < N) *(u32x4*)(WT + (size_t)map(n0 + n) * K + k0 + 8 * c) = o;
    }
    lds_wait();
}
struct MapId { int off; __device__ __forceinline__ int operator()(int n) const { return n + off; } };
struct MapWin { __device__ __forceinline__ int operator()(int n) const { return n < 2560 ? n : (n < 2576 ? 8704 + (n - 2560) : n - 16); } };

__device__ __forceinline__ void rms_row_load(f32x4 (&v)[4], const float* xrow, int lane) {
    const f32x4* xr = (const f32x4*)xrow + lane;
#pragma unroll
    for (int j = 0; j < 4; ++j) v[j] = xr[64 * j];
}
__device__ __forceinline__ void rms_row_finish(const f32x4 (&v)[4], const float* gain, bf16_t* orow, int lane) {
    const f32x4* gr = (const f32x4*)gain + lane; float s = 0.f;
#pragma unroll
    for (int j = 0; j < 4; ++j) s += (v[j].x * v[j].x + v[j].y * v[j].y) + (v[j].z * v[j].z + v[j].w * v[j].w);
    const float rstd = rsqrtf(wave_sum64(s) * (1.f / 1024.f) + EPS);
    u32x2* o8 = (u32x2*)orow + lane;
#pragma unroll
    for (int j = 0; j < 4; ++j) { const f32x4 g = gr[64 * j]; u32x2 w; w.x = pk2(v[j].x * rstd * g.x, v[j].y * rstd * g.y); w.y = pk2(v[j].z * rstd * g.z, v[j].w * rstd * g.w); o8[64 * j] = w; }
}
__device__ __forceinline__ void cvt_row_bf16(const float* src, bf16_t* dst, int lane, bool tril, size_t ebase) {
#pragma unroll
    for (int j = 0; j < 2; ++j) {
        const int e = j * 512 + lane * 8;
        f32x4 a = *(const f32x4*)(src + e), b = *(const f32x4*)(src + e + 4);
        if (tril) { const int t = (int)(((ebase + e) >> 7) & 127), s0 = (int)((ebase + e) & 127);
            a.x = (s0 + 0 <= t) ? a.x : 0.f; a.y = (s0 + 1 <= t) ? a.y : 0.f; a.z = (s0 + 2 <= t) ? a.z : 0.f; a.w = (s0 + 3 <= t) ? a.w : 0.f;
            b.x = (s0 + 4 <= t) ? b.x : 0.f; b.y = (s0 + 5 <= t) ? b.y : 0.f; b.z = (s0 + 6 <= t) ? b.z : 0.f; b.w = (s0 + 7 <= t) ? b.w : 0.f; }
        u32x4 o; o.x = pk2(a.x, a.y); o.y = pk2(a.z, a.w); o.z = pk2(b.x, b.y); o.w = pk2(b.z, b.w);
        *(u32x4*)(dst + e) = o;
    }
}

__device__ __forceinline__ void fp8_row_load(f32x4 (&v)[4], const float* src, int lane) {
    const f32x4* p = (const f32x4*)(src + lane * 16);
#pragma unroll
    for (int j = 0; j < 4; ++j) v[j] = p[j];
}
__device__ __forceinline__ void fp8_row_finish(const f32x4 (&v_)[4], unsigned char* dst, float* inv_scale, int lane, const float* col_scale) {
    f32x4 v[4];
#pragma unroll
    for (int j = 0; j < 4; ++j) { v[j] = v_[j]; if (col_scale) v[j] = v[j] * *(const f32x4*)(col_scale + lane * 16 + 4 * j); }
    float m = 0.f;
#pragma unroll
    for (int j = 0; j < 4; ++j) m = fmaxf(m, fmaxf(fmaxf(fabsf(v[j].x), fabsf(v[j].y)), fmaxf(fabsf(v[j].z), fabsf(v[j].w))));
#pragma unroll
    for (int o = 1; o < 64; o <<= 1) m = fmaxf(m, __shfl_xor(m, o));
    const float sc = m > 0.f ? 440.f / m : 1.f;
    u32x4 w;
#pragma unroll
    for (int j = 0; j < 4; ++j) { int t = 0; t = __builtin_amdgcn_cvt_pk_fp8_f32(v[j].x * sc, v[j].y * sc, t, false); t = __builtin_amdgcn_cvt_pk_fp8_f32(v[j].z * sc, v[j].w * sc, t, true); w[j] = (unsigned)t; }
    *(u32x4*)(dst + (size_t)(lane >> 3) * (16384 * 128) + (lane & 7) * 16) = w;
    if (lane == 0) *inv_scale = m > 0.f ? m / 440.f : 1.f;
}
__device__ __forceinline__ void p0_prep(const Ctx& C) {
    LAS float* scr = (LAS float*)(C.lds + C.wid * 8448);
    const int gw = C.bid * 8 + C.wid, NGW = C.G * 8, lane = C.lane;
    const kaptr_t ka = kargs();
    unsigned char* ws = ka_ws(ka);
    bf16_t* WINKV = (bf16_t*)(ws + WS_WINKV);
    constexpr int I_IN = 16 * 273, I_KV = 16 * 64, I_BR = 16 * 32, I_O = 16 * 32, I_Q = 16 * 64;
    constexpr int NTR = I_IN + I_KV + 3 * I_BR + I_O + I_Q;
    for (int it = gw; it < NTR; it += NGW) {
        int r = it;
        if (r < I_IN) { transpose_item(ka_in(ka, I_W_IN), 1024, IN_DIM, WINKV, MapWin{}, scr, r, lane); continue; } r -= I_IN;
        if (r < I_KV) { transpose_item(ka_in(ka, I_W_MEM_KV), 1024, 2048, WINKV, MapId{8960}, scr, r, lane); continue; } r -= I_KV;
        if (r < 3 * I_BR) { const int n = r / I_BR; transpose_item(ka_in(ka, I_W_BRANCH) + (size_t)n * 1024 * 1024, 1024, 1024, (bf16_t*)(ws + WS_WB), MapId{n * 1024}, scr, r % I_BR, lane); continue; } r -= 3 * I_BR;
        if (r < I_O) { transpose_item(ka_in(ka, I_W_OUT), 1024, 1024, (bf16_t*)(ws + WS_WO), MapId{0}, scr, r, lane); continue; } r -= I_O;
        transpose_item(ka_in(ka, I_W_PEER_Q), 1024, 2048, (bf16_t*)(ws + WS_WQ), MapId{0}, scr, r, lane, ka_in(ka, I_LN_FFN));
    }
    for (int it = gw; it < 240; it += NGW) { u32x4 z = {0u, 0u, 0u, 0u}; u32x4* d = (u32x4*)(WINKV + (size_t)(8720 + it) * 1024); d[lane] = z; d[64 + lane] = z; }
    bf16_t* H = (bf16_t*)(ws + WS_H);
    {
        const float* X = ka_in(ka, I_X); const float* MEMP = ka_in(ka, I_MEM); const float* g0 = ka_in(ka, I_LN_MIX); const float* g1 = ka_in(ka, I_LN_MEM);
        f32x4 cur[4], nxt[4];
        if (gw < T_ALL + 4096) rms_row_load(cur, gw < T_ALL ? X + (size_t)gw * 1024 : MEMP + (size_t)(gw - T_ALL) * 1024, lane);
        for (int it = gw; it < T_ALL + 4096; it += NGW) {
            const int nit = it + NGW;
            if (nit < T_ALL + 4096) rms_row_load(nxt, nit < T_ALL ? X + (size_t)nit * 1024 : MEMP + (size_t)(nit - T_ALL) * 1024, lane);
            rms_row_finish(cur, it < T_ALL ? g0 : g1, H + (size_t)it * 1024, lane);
#pragma unroll
            for (int j = 0; j < 4; ++j) cur[j] = nxt[j];
        }
    }
    {
        const float* PUf = ka_in(ka, I_PEER_U); const float* PVf = ka_in(ka, I_PEER_V);
        f32x4 cur[4], nxt[4];
        if (gw < 32768) fp8_row_load(cur, gw < 16384 ? PUf + (size_t)gw * 1024 : PVf + (size_t)(gw - 16384) * 1024, lane);
        for (int it = gw; it < 32768; it += NGW) {
            const int nit = it + NGW;
            if (nit < 32768) fp8_row_load(nxt, nit < 16384 ? PUf + (size_t)nit * 1024 : PVf + (size_t)(nit - 16384) * 1024, lane);
            if (it < 16384) fp8_row_finish(cur, ws + WS_PU + (size_t)it * 128, (float*)(ws + WS_SU) + it, lane, ka_in(ka, I_LN_FFN));
            else fp8_row_finish(cur, ws + WS_PV + (size_t)(it - 16384) * 128, (float*)(ws + WS_SV) + (it - 16384), lane, nullptr);
#pragma unroll
            for (int j = 0; j < 4; ++j) cur[j] = nxt[j];
        }
    }
    for (int it = gw; it < 256 + 128; it += NGW) {
        int r = it;
        if (r < 256) {
            const float* src = ka_in(ka, I_PEER_KEYS) + (size_t)r * 1024; bf16_t* kt = (bf16_t*)(ws + WS_KEYS);
#pragma unroll
            for (int j = 0; j < 2; ++j) {
                const int e = j * 512 + lane * 8, E = r * 1024 + e, k = (E >> 7) & 127, d = E & 127;
                const f32x4 a = *(const f32x4*)(src + e), b = *(const f32x4*)(src + e + 4);
                u32x4 o; o.x = pk2(a.x, a.y); o.y = pk2(a.z, a.w); o.z = pk2(b.x, b.y); o.w = pk2(b.z, b.w);
                *(u32x4*)(kt + (size_t)(E >> 14) * 16384 + (((k >> 4) * 4 + (d >> 5)) * 16 + (k & 15)) * 32 + (d & 31)) = o;
            }
            continue; } r -= 256;
        {
            const float* src = ka_in(ka, I_W_SPATIAL) + (size_t)r * 1024; bf16_t* wt = (bf16_t*)(ws + WS_WSP);
#pragma unroll
            for (int j = 0; j < 2; ++j) {
                const int e = j * 512 + lane * 8, E = r * 1024 + e, t = (E >> 7) & 127, s0 = E & 127;
                f32x4 a = *(const f32x4*)(src + e), b = *(const f32x4*)(src + e + 4);
                a.x = (s0 + 0 <= t) ? a.x : 0.f; a.y = (s0 + 1 <= t) ? a.y : 0.f; a.z = (s0 + 2 <= t) ? a.z : 0.f; a.w = (s0 + 3 <= t) ? a.w : 0.f;
                b.x = (s0 + 4 <= t) ? b.x : 0.f; b.y = (s0 + 5 <= t) ? b.y : 0.f; b.z = (s0 + 6 <= t) ? b.z : 0.f; b.w = (s0 + 7 <= t) ? b.w : 0.f;
                u32x4 o; o.x = pk2(a.x, a.y); o.y = pk2(a.z, a.w); o.z = pk2(b.x, b.y); o.w = pk2(b.z, b.w);
                *(u32x4*)(wt + (size_t)(E >> 14) * 16384 + (((t >> 4) * 4 + (s0 >> 5)) * 16 + (t & 15)) * 32 + (s0 & 31)) = o;
            }
        }
    }
    if (C.bid == 0) for (int i = C.tid; i < 4096; i += NTHR) ((unsigned*)(ws + WS_CTL))[i] = 0u;
}

struct SchedInProj {
    int slab, G, c;
    __device__ __forceinline__ bool next(int i, pg8::Unit& u) const {
        const int L = i * G + c; if (L >= 2304) return false;
        const int wgid = (L % 8) * 288 + L / 8;
        if (wgid < 2240) { const int gid = wgid / 280, r = wgid % 280; u.pm = slab * 64 + gid * 8 + (r % 8); u.pn = r / 8; }
        else { const int r = wgid - 2240; u.pm = 128 + slab * 8 + (r % 8); u.pn = 35 + r / 8; }
        return true;
    }
    __device__ __forceinline__ void a_ready(const pg8::Unit&) const {}
    __device__ __forceinline__ void done(const pg8::Unit&) const {}
};
__device__ __forceinline__ f32x4 sigmoid4_of(f32x4 t) {
    f32x4 e; e.x = __builtin_amdgcn_exp2f(t.x); e.y = __builtin_amdgcn_exp2f(t.y); e.z = __builtin_amdgcn_exp2f(t.z); e.w = __builtin_amdgcn_exp2f(t.w);
    const f32x4 d = e + 1.0f;
    f32x4 r; r.x = __builtin_amdgcn_rcpf(d.x); r.y = __builtin_amdgcn_rcpf(d.y); r.z = __builtin_amdgcn_rcpf(d.z); r.w = __builtin_amdgcn_rcpf(d.w);
    return r;
}
template <int mode>
__device__ __forceinline__ f32x4 act4(f32x4 v) {
    f32x4 r;
    if (mode == 0) r = v;
    else if (mode == 1) r = v * sigmoid4_of(v * (-1.4426950409f));
    else if (mode == 2) { const f32x4 y = v * ((v * v) * (0.044715f * -2.3022081914f) + (-2.3022081914f)); r = v * sigmoid4_of(y); }
    else if (mode == 3) r = sigmoid4_of(v * (-1.4426950409f));
    else r = v * 0.0625f;
    return r;
}
struct EpiInProj {
    static constexpr bool PERM = true, AFTER_DRAIN = false, WANTS_SCRATCH = false, MUT_ACC = false;
    unsigned char* ws; bf16_t* GV; const float* dt_bias; int tok0;
    template <int MODE>
    __device__ __forceinline__ void store_tile(const f32x4 (&acc)[2][2][4][2], bf16_t* rowp_run, int ld, int rbase, bool is_v, int pn, int wc, int fq) const {
        float* const VSS = (float*)(ws + WS_VSS);
#pragma unroll
        for (int ai = 0; ai < 2; ++ai)
#pragma unroll
            for (int m = 0; m < 4; ++m) {
                const int gt = rbase + ai * 128 + m * 16;
                asm volatile("" : "+v"(rowp_run));
                bf16_t* rowp = rowp_run; float ss = 0.f;
                rowp_run += (size_t)((m == 3) ? 80 : 16) * ld;
#pragma unroll
                for (int bj = 0; bj < 2; ++bj) {
                    const f32x4 v0 = act4<MODE>(acc[ai][bj][m][0]), v1 = act4<MODE>(acc[ai][bj][m][1]);
                    if (MODE == 2 && is_v) { const f32x4 q2 = v0 * v0 + v1 * v1; ss += (q2.x + q2.y) + (q2.z + q2.w); }
                    u32x4 w; w.x = pk2(v0.x, v0.y); w.y = pk2(v0.z, v0.w); w.z = pk2(v1.x, v1.y); w.w = pk2(v1.z, v1.w);
                    *(u32x4*)(rowp + bj * 128) = w;
                    __builtin_amdgcn_sched_barrier(0);
                }
                if (MODE == 2 && is_v) { ss += __shfl_xor(ss, 16); ss += __shfl_xor(ss, 32); if (fq == 0) VSS[(size_t)gt * 16 + (pn - 14) * 4 + wc] = ss; }
                __builtin_amdgcn_sched_barrier(0);
            }
    }
    __device__ __forceinline__ void operator()(const f32x4 (&acc)[2][2][4][2], const pg8::Unit& u, int wr, int wc, int fr, int fq) const {
        bf16_t* const YB = (bf16_t*)(ws + WS_SLAB + SL_YB); bf16_t* const XBC = (bf16_t*)(ws + WS_SLAB + SL_XBC); bf16_t* const SG = (bf16_t*)(ws + WS_SLAB + SL_SG);
        bf16_t* const KB = (bf16_t*)(ws + WS_KB); bf16_t* const VT = (bf16_t*)(ws + WS_VT); float* const DT = (float*)(ws + WS_DT); float* const VSS = (float*)(ws + WS_VSS);
        const int pn = u.pn;
        const int rbase = u.pm * 256 + wr * 64 + fr;
        const int cl = wc * 32 + 8 * fq;
        if (pn < 34) {
            bf16_t* dst; int ld, cofs, mode;
            if (pn < 4)       { dst = YB;                         ld = 1024; cofs = pn * 256;        mode = 1; }
            else if (pn < 10) { dst = XBC;                        ld = 1536; cofs = (pn - 4) * 256;  mode = 0; }
            else if (pn < 14) { dst = YB + (size_t)TS * 1024;     ld = 1024; cofs = (pn - 10) * 256; mode = 2; }
            else if (pn < 18) { dst = GV;                         ld = 1024; cofs = (pn - 14) * 256; mode = 2; }
            else if (pn < 22) { dst = YB + (size_t)2 * TS * 1024; ld = 1024; cofs = (pn - 18) * 256; mode = 4; }
            else              { dst = SG; ld = 0; cofs = 0; mode = 3; }
            const bool is_v = (pn >= 14 && pn < 18);
            if (pn >= 22) {
                unsigned char* gt8 = (unsigned char*)SG + (size_t)((u.pm - tok0 / 256) * 12 + (pn - 22)) * 65536 + (wr * 4 + wc) * 8192 + (fr + 16 * fq) * 8;
#pragma unroll
                for (int ai = 0; ai < 2; ++ai)
#pragma unroll
                    for (int m = 0; m < 4; ++m)
#pragma unroll
                        for (int bj = 0; bj < 2; ++bj) {
                            const f32x4 v0 = acc[ai][bj][m][0], v1 = acc[ai][bj][m][1];
                            f32x4 s0 = sigmoid4_of(v0 * (-1.4426950409f)) * 255.f + 0.5f, s1 = sigmoid4_of(v1 * (-1.4426950409f)) * 255.f + 0.5f;
                            s0.x = fmaxf(s0.x, 1.f); s0.y = fmaxf(s0.y, 1.f); s0.z = fmaxf(s0.z, 1.f); s0.w = fmaxf(s0.w, 1.f); s1.x = fmaxf(s1.x, 1.f); s1.y = fmaxf(s1.y, 1.f); s1.z = fmaxf(s1.z, 1.f); s1.w = fmaxf(s1.w, 1.f);
                            const unsigned b8[8] = {(unsigned)s0.x, (unsigned)s0.y, (unsigned)s0.z, (unsigned)s0.w, (unsigned)s1.x, (unsigned)s1.y, (unsigned)s1.z, (unsigned)s1.w};
                            u32x2 w; w.x = b8[0] | (b8[1] << 8) | (b8[2] << 16) | (b8[3] << 24); w.y = b8[4] | (b8[5] << 8) | (b8[6] << 16) | (b8[7] << 24);
                            *(u32x2*)(gt8 + (ai * 8 + m * 2 + bj) * 512) = w;
                            __builtin_amdgcn_sched_barrier(0);
                        }
                return;
            }
            bf16_t* rowp0 = dst + (size_t)(rbase - tok0) * ld + cofs + cl;
            switch (mode) {
                case 0: store_tile<0>(acc, rowp0, ld, rbase, false, pn, wc, fq); break;
                case 1: store_tile<1>(acc, rowp0, ld, rbase, false, pn, wc, fq); break;
                case 2: store_tile<2>(acc, rowp0, ld, rbase, is_v, pn, wc, fq); break;
                default: store_tile<4>(acc, rowp0, ld, rbase, false, pn, wc, fq); break;
            }
        } else if (pn == 34) {
            if (wc == 0 && fq < 2) {
                const f32x4 b0 = *(const f32x4*)(dt_bias + 8 * fq), b1 = *(const f32x4*)(dt_bias + 8 * fq + 4);
#pragma unroll
                for (int ai = 0; ai < 2; ++ai)
#pragma unroll
                    for (int m = 0; m < 4; ++m) {
                        const int gt = rbase + ai * 128 + m * 16;
                        f32x4 v0 = acc[ai][0][m][0] + b0, v1 = acc[ai][0][m][1] + b1;
#pragma unroll
                        for (int j = 0; j < 4; ++j) { v0[j] = fmaxf(v0[j], 0.f) + __logf(1.f + __expf(-fabsf(v0[j]))); v1[j] = fmaxf(v1[j], 0.f) + __logf(1.f + __expf(-fabsf(v1[j]))); }
                        *(f32x4*)(DT + (size_t)gt * 16 + 8 * fq) = v0; *(f32x4*)(DT + (size_t)gt * 16 + 8 * fq + 4) = v1;
                        __builtin_amdgcn_sched_barrier(0);
                    }
            }
        } else {
            const int pk = pn - 35;
#pragma unroll
            for (int ai = 0; ai < 2; ++ai)
#pragma unroll
                for (int m = 0; m < 4; ++m) {
                    const int mrow = rbase + ai * 128 + m * 16 - T_ALL;
#pragma unroll
                    for (int bj = 0; bj < 2; ++bj) {
                        const f32x4 v0 = acc[ai][bj][m][0], v1 = acc[ai][bj][m][1];
                        if (pk < 4) {
                            u32x4 w; w.x = pk2(v0.x, v0.y); w.y = pk2(v0.z, v0.w); w.z = pk2(v1.x, v1.y); w.w = pk2(v1.z, v1.w);
                            *(u32x4*)(KB + (size_t)mrow * 1024 + pk * 256 + bj * 128 + cl) = w;
                        } else {
                            u32x4 w; w.x = pk2(v0.x, v0.y); w.y = pk2(v0.z, v0.w); w.z = pk2(v1.x, v1.y); w.w = pk2(v1.z, v1.w);
                            *(u32x4*)(VT + (size_t)((((u.pm - T_ALL / 256) * 4 + (pk - 4)) * 2 + bj) * 32768) + (mrow & 255) * 128 + cl) = w;
                        }
                    }
                    __builtin_amdgcn_sched_barrier(0);
                }
        }
    }
};

struct P2Ptrs {
    bf16_t *YB, *XBC, *GV, *KB, *VT, *WSP; float *DT, *VSS, *SSS;
    bf16_t *YD, *ST; float* CD;
    const float *conv_w, *conv_b, *a_log, *d_skip, *ssd_norm, *gmlp_norm, *b_spatial;
    int tok0, slab;
};

constexpr int RP = 272;
__device__ __forceinline__ void conv_w8(const float* conv_w, const float* conv_b, int ch, float (&w)[4][8], float (&bb)[8]) {
#pragma unroll
    for (int k = 0; k < 4; ++k) { const f32x4 a = *(const f32x4*)(conv_w + k * 1536 + ch), b = *(const f32x4*)(conv_w + k * 1536 + ch + 4);
        w[k][0] = a.x; w[k][1] = a.y; w[k][2] = a.z; w[k][3] = a.w; w[k][4] = b.x; w[k][5] = b.y; w[k][6] = b.z; w[k][7] = b.w; }
    const f32x4 a = *(const f32x4*)(conv_b + ch), b = *(const f32x4*)(conv_b + ch + 4); bb[0] = a.x; bb[1] = a.y; bb[2] = a.z; bb[3] = a.w; bb[4] = b.x; bb[5] = b.y; bb[6] = b.z; bb[7] = b.w;
}
__device__ __forceinline__ void unpack8(const u32x4 raw, float (&x)[8]) {
    x[0] = bf_lo(raw.x); x[1] = bf_hi(raw.x); x[2] = bf_lo(raw.y); x[3] = bf_hi(raw.y); x[4] = bf_lo(raw.z); x[5] = bf_hi(raw.z); x[6] = bf_lo(raw.w); x[7] = bf_hi(raw.w);
}
template <int NR>
__device__ __forceinline__ void conv_load(u32x4 (&raw)[NR + 3], const bf16_t* xsrc  , int r0, bool at_seq_start) {
#pragma unroll
    for (int q = 0; q < NR + 3; ++q) { raw[q] = (u32x4){0u, 0u, 0u, 0u}; if (!at_seq_start || r0 + q - 3 >= 0) raw[q] = *(const u32x4*)(xsrc + (q - 3) * 1536); }
}
template <int NR, class F>
__device__ __forceinline__ void conv_compute(const u32x4 (&raw)[NR + 3], const float (&w)[4][8], const float (&bb)[8], F&& emit) {
    float xm[3][8];
    unpack8(raw[0], xm[0]); unpack8(raw[1], xm[1]); unpack8(raw[2], xm[2]);
#pragma unroll
    for (int rr = 0; rr < NR; ++rr) {
        float cur[8], o[8]; unpack8(raw[rr + 3], cur);
#pragma unroll
        for (int j = 0; j < 8; ++j) { const float v = bb[j] + w[0][j] * xm[0][j] + w[1][j] * xm[1][j] + w[2][j] * xm[2][j] + w[3][j] * cur[j]; o[j] = silu_f(v);
            xm[0][j] = xm[1][j]; xm[1][j] = xm[2][j]; xm[2][j] = cur[j]; }
        emit(rr, o);
    }
}
template <int NR, class F>
__device__ __forceinline__ void conv_rows(const bf16_t* xsrc, int r0, bool at_seq_start, const float (&w)[4][8], const float (&bb)[8], F&& emit) {
    u32x4 raw[NR + 3]; conv_load<NR>(raw, xsrc, r0, at_seq_start); conv_compute<NR>(raw, w, bb, emit);
}
__device__ __forceinline__ float dt_scan(const float* DT, size_t tok, int h, float a_h, LAS float* dtv, LAS float* acs, int lane) {
    const float d0 = DT[(tok + 2 * lane) * 16 + h], d1 = DT[(tok + 2 * lane + 1) * 16 + h];
    const float s0 = d0 * a_h, s1 = s0 + d1 * a_h;
    float inc = s1;
#pragma unroll
    for (int o = 1; o < 64; o <<= 1) { const float t = __shfl_up(inc, o); if (lane >= o) inc += t; }
    const float exc = inc - s1;
    if (dtv) { dtv[2 * lane] = d0; dtv[2 * lane + 1] = d1; }
    acs[2 * lane] = exc + s0; acs[2 * lane + 1] = inc;
    return __shfl(inc, 63);
}
__device__ __forceinline__ void ssd_a_item(const Ctx& C, const P2Ptrs& P, int idx) {
    LAS unsigned char* L = C.lds;
    constexpr int O_C = 0, O_B = 34816, O_BT = 69632, O_XT = 104448, O_XW = 121856, O_DT = 139264, O_ACS = 143360, O_CW = 147456;
    constexpr int XSP = 144;
    const int tid = C.tid, lane = C.lane, wid = C.wid, fr = lane & 15, fq = lane >> 4;
    const int bl = idx >> 5, c = (idx >> 1) & 15, g = idx & 1;
    const int lt0 = bl * SEQ + c * 128;
    const bool seq_start = (c == 0);
    LAS float* dtv = (LAS float*)(L + O_DT); LAS float* acs = (LAS float*)(L + O_ACS);
    const int bcc = tid & 31, bseg = tid >> 5, br0 = bseg * 8;
    const int bch = (bcc < 16) ? 1024 + g * 128 + bcc * 8 : 1280 + g * 128 + (bcc - 16) * 8;
    u32x4 braw[11]; conv_load<8>(braw, P.XBC + (size_t)(lt0 + br0) * 1536 + bch, br0, seq_start);
    float bw[4][8], bbb[8]; conv_w8(P.conv_w, P.conv_b, bch, bw, bbb);
    {
        float cwv[5];
#pragma unroll
        for (int k = 0; k < 5; ++k) cwv[k] = (k < 4) ? P.conv_w[k * 1536 + g * 512 + tid] : P.conv_b[g * 512 + tid];
#pragma unroll
        for (int k = 0; k < 5; ++k) ((LAS float*)(L + O_CW))[k * 512 + tid] = cwv[k];
    }
    {
        const int h = g * 8 + wid;
        const float tot = dt_scan(P.DT, (size_t)(P.tok0 + lt0), h, -__expf(P.a_log[h]), dtv + wid * 128, acs + wid * 128, lane);
        if (lane == 0) P.CD[(bl * 16 + c) * 16 + h] = __expf(tot);
    }
    {
        const int cc = bcc, r0 = br0;
        const int rm = (cc < 16 ? O_B : O_C) + (cc & 15) * 16, tr = O_BT + (cc & 15) * 8 * RP;
        conv_compute<8>(braw, bw, bbb, [&](int rr, const float (&o)[8]) {
            const int r = r0 + rr;
            u32x4 pk; pk.x = pk2(o[0], o[1]); pk.y = pk2(o[2], o[3]); pk.z = pk2(o[4], o[5]); pk.w = pk2(o[6], o[7]);
            *(LAS u32x4*)(L + rm + r * RP) = pk;
            if (cc < 16) {
                *(LAS unsigned short*)(L + tr + 0 * RP + r * 2) = (unsigned short)(pk.x & 0xffffu); *(LAS unsigned short*)(L + tr + 1 * RP + r * 2) = (unsigned short)(pk.x >> 16);
                *(LAS unsigned short*)(L + tr + 2 * RP + r * 2) = (unsigned short)(pk.y & 0xffffu); *(LAS unsigned short*)(L + tr + 3 * RP + r * 2) = (unsigned short)(pk.y >> 16);
                *(LAS unsigned short*)(L + tr + 4 * RP + r * 2) = (unsigned short)(pk.z & 0xffffu); *(LAS unsigned short*)(L + tr + 5 * RP + r * 2) = (unsigned short)(pk.z >> 16);
                *(LAS unsigned short*)(L + tr + 6 * RP + r * 2) = (unsigned short)(pk.w & 0xffffu); *(LAS unsigned short*)(L + tr + 7 * RP + r * 2) = (unsigned short)(pk.w >> 16);
            }
        });
    }
    __syncthreads();
    const int l0 = 16 * wid, fb = fr * RP + fq * 16, fbw = fb + l0 * RP, l = l0 + fr;
    f32x4 cb[8];
    {
        bf16x8 cf[4];
#pragma unroll
        for (int ks = 0; ks < 4; ++ks) cf[ks] = *(const LAS bf16x8*)(L + O_C + fbw + ks * 64);
#pragma unroll
        for (int j = 0; j < 8; ++j) {
            cb[j] = (f32x4){0.f, 0.f, 0.f, 0.f};
#pragma unroll
            for (int ks = 0; ks < 4; ++ks) { const bf16x8 bf = *(const LAS bf16x8*)(L + O_B + fb + j * 16 * RP + ks * 64); cb[j] = mfma16(bf, cf[ks], cb[j]); }
        }
    }
    __syncthreads();
    const int xcc = tid & 7, xseg = tid >> 3, xr0 = xseg * 2;
    u32x4 xraw[5];
    conv_load<2>(xraw, P.XBC + (size_t)(lt0 + xr0) * 1536 + (g * 8) * 64 + xcc * 8, xr0, seq_start);
    for (int hh = 0; hh < 8; ++hh) {
        const int h = g * 8 + hh;
        const float d_h = P.d_skip[h];
        LAS float* acsh = acs + hh * 128; LAS float* dth = dtv + hh * 128;
        {
            float w[4][8], bb[8];
#pragma unroll
            for (int k = 0; k < 4; ++k) { const f32x4 a4 = *(const LAS f32x4*)(L + O_CW + (k * 512 + hh * 64 + xcc * 8) * 4), b4 = *(const LAS f32x4*)(L + O_CW + (k * 512 + hh * 64 + xcc * 8 + 4) * 4);
                w[k][0] = a4.x; w[k][1] = a4.y; w[k][2] = a4.z; w[k][3] = a4.w; w[k][4] = b4.x; w[k][5] = b4.y; w[k][6] = b4.z; w[k][7] = b4.w; }
            { const f32x4 a4 = *(const LAS f32x4*)(L + O_CW + (4 * 512 + hh * 64 + xcc * 8) * 4), b4 = *(const LAS f32x4*)(L + O_CW + (4 * 512 + hh * 64 + xcc * 8 + 4) * 4);
                bb[0] = a4.x; bb[1] = a4.y; bb[2] = a4.z; bb[3] = a4.w; bb[4] = b4.x; bb[5] = b4.y; bb[6] = b4.z; bb[7] = b4.w; }
            const float acs_last = acsh[127];
            const int cc = xcc, r0 = xr0;
            conv_compute<2>(xraw, w, bb, [&](int rr, const float (&o)[8]) {
                const int r = r0 + rr;
                u32x4 pk; pk.x = pk2(o[0], o[1]); pk.y = pk2(o[2], o[3]); pk.z = pk2(o[4], o[5]); pk.w = pk2(o[6], o[7]);
                *(LAS u32x4*)(L + O_B + r * XSP + cc * 16) = pk;
                const float dtr = dth[r], wd = dtr * __expf(acs_last - acsh[r]);
#pragma unroll
                for (int j = 0; j < 8; ++j) {
                    *(LAS unsigned short*)(L + O_XT + (cc * 8 + j) * RP + r * 2) = (unsigned short)(pk2(o[j] * dtr, 0.f) & 0xffffu);
                    *(LAS unsigned short*)(L + O_XW + (cc * 8 + j) * RP + r * 2) = (unsigned short)(pk2(o[j] * wd, 0.f) & 0xffffu);
                }
            });
            if (hh + 1 < 8) conv_load<2>(xraw, P.XBC + (size_t)(lt0 + xr0) * 1536 + (h + 1) * 64 + xcc * 8, xr0, seq_start);
        }
        {
            const float al = acsh[l];
#pragma unroll
            for (int j = 0; j < 8; ++j) {
                const f32x4 as = *(const LAS f32x4*)(L + O_ACS + (hh * 128 + 16 * j + 4 * fq) * 4);
                float mv[4];
#pragma unroll
                for (int r = 0; r < 4; ++r) { const int sidx = 16 * j + 4 * fq + r; mv[r] = (sidx <= l) ? cb[j][r] * __expf(al - as[r]) : 0.f; }
                u32x2 wv; wv.x = pk2(mv[0], mv[1]); wv.y = pk2(mv[2], mv[3]);
                *(LAS u32x2*)(L + O_C + l * RP + fq * 8 + j * 32) = wv;
            }
        }
        __syncthreads();
        {
            bf16x8 mf[4];
#pragma unroll
            for (int ks = 0; ks < 4; ++ks) mf[ks] = *(const LAS bf16x8*)(L + O_C + fbw + ks * 64);
            bf16_t* yblk = P.YD + (size_t)((((lt0 + l0) >> 4) * 16 + h) * 2) * 512 + lane * 8;
            u32x2 yo4[4];
#pragma unroll
            for (int jj = 0; jj < 4; ++jj) {
                f32x4 yd = {0.f, 0.f, 0.f, 0.f};
#pragma unroll
                for (int ks = 0; ks < 4; ++ks) { const bf16x8 xf = *(const LAS bf16x8*)(L + O_XT + fb + jj * 16 * RP + ks * 64); yd = mfma16(xf, mf[ks], yd); }
                const u32x2 xs4 = *(const LAS u32x2*)(L + O_B + l * XSP + fq * 8 + jj * 32);
                yo4[jj].x = pk2(yd[0] + d_h * bf_lo(xs4.x), yd[1] + d_h * bf_hi(xs4.x)); yo4[jj].y = pk2(yd[2] + d_h * bf_lo(xs4.y), yd[3] + d_h * bf_hi(xs4.y));
            }
            *(u32x4*)yblk = (u32x4){yo4[0].x, yo4[0].y, yo4[1].x, yo4[1].y}; *(u32x4*)(yblk + 512) = (u32x4){yo4[2].x, yo4[2].y, yo4[3].x, yo4[3].y};
        }
        {
            const int pt = wid & 3, nh = wid >> 2;
            bf16x8 xw[4];
#pragma unroll
            for (int ks = 0; ks < 4; ++ks) xw[ks] = *(const LAS bf16x8*)(L + O_XW + fb + pt * 16 * RP + ks * 64);
            bf16_t* sp = P.ST + (size_t)((bl * 16 + c) * 16 + h) * 8192 + pt * 2048 + fr * 32 + 4 * fq;
#pragma unroll
            for (int jj = 0; jj < 4; ++jj) {
                f32x4 st = {0.f, 0.f, 0.f, 0.f};
#pragma unroll
                for (int ks = 0; ks < 4; ++ks) { const bf16x8 bt = *(const LAS bf16x8*)(L + O_BT + fb + (nh * 4 + jj) * 16 * RP + ks * 64); st = mfma16(bt, xw[ks], st); }
                u32x2 o; o.x = pk2(st[0], st[1]); o.y = pk2(st[2], st[3]);
                *(u32x2*)(sp + ((nh * 4 + jj) >> 1) * 512 + ((nh * 4 + jj) & 1) * 16) = o;
            }
        }
        __syncthreads();
    }
}
__device__ __forceinline__ void ssd_scan_item(const Ctx& C, const P2Ptrs& P, int idx) {
    const int bh = idx >> 2, part = idx & 3, bl = bh >> 4, h = bh & 15;
    const size_t e0 = (size_t)part * 2048 + C.tid * 4;
    u32x2 v[16]; float dec[16];
#pragma unroll
    for (int c = 0; c < 16; ++c) { v[c] = *(const u32x2*)(P.ST + (size_t)((bl * 16 + c) * 16 + h) * 8192 + e0); dec[c] = P.CD[(bl * 16 + c) * 16 + h]; }
    float run[4] = {0.f, 0.f, 0.f, 0.f};
#pragma unroll
    for (int c = 0; c < 16; ++c) {
        u32x2 o; o.x = pk2(run[0], run[1]); o.y = pk2(run[2], run[3]);
        *(u32x2*)(P.ST + (size_t)((bl * 16 + c) * 16 + h) * 8192 + e0) = o;
        run[0] = run[0] * dec[c] + bf_lo(v[c].x); run[1] = run[1] * dec[c] + bf_hi(v[c].x); run[2] = run[2] * dec[c] + bf_lo(v[c].y); run[3] = run[3] * dec[c] + bf_hi(v[c].y);
    }
}
__device__ __forceinline__ void ssd_c_item(const Ctx& C, const P2Ptrs& P, int idx) {
    LAS unsigned char* L = C.lds;
    constexpr int O_C = 0, O_ACS = 34816;
    const int tid = C.tid, lane = C.lane, wid = C.wid, fr = lane & 15, fq = lane >> 4;
    const int bl = idx >> 5, c = (idx >> 1) & 15, g = idx & 1;
    const int lt0 = bl * SEQ + c * 128;
    LAS float* acs = (LAS float*)(L + O_ACS);
    {
        const int cc = tid & 15, seg = tid >> 4, r0 = seg * 4;
        const int ch = 1280 + g * 128 + cc * 8;
        u32x4 craw[7]; conv_load<4>(craw, P.XBC + (size_t)(lt0 + r0) * 1536 + ch, r0, c == 0);
        float w[4][8], bb[8]; conv_w8(P.conv_w, P.conv_b, ch, w, bb);
        { const int h = g * 8 + wid; (void)dt_scan(P.DT, (size_t)(P.tok0 + lt0), h, -__expf(P.a_log[h]), (LAS float*)nullptr, acs + wid * 128, lane); }
        conv_compute<4>(craw, w, bb, [&](int rr, const float (&o)[8]) {
            u32x4 pk; pk.x = pk2(o[0], o[1]); pk.y = pk2(o[2], o[3]); pk.z = pk2(o[4], o[5]); pk.w = pk2(o[6], o[7]);
            *(LAS u32x4*)(L + O_C + (r0 + rr) * RP + cc * 16) = pk;
        });
    }
    __syncthreads();
    const int l0 = 16 * wid, l = l0 + fr;
    bf16x8 cf[4];
#pragma unroll
    for (int ks = 0; ks < 4; ++ks) cf[ks] = *(const LAS bf16x8*)(L + O_C + (l0 + fr) * RP + fq * 16 + ks * 64);
    bf16_t* ZS = P.YB;
    float ssg = 0.f;
    constexpr int O_ST = 38912;
    u32x4 stA, stB;
#define PC_LD(HH) do { const bf16_t* sp_ = P.ST + (size_t)((bl * 16 + c) * 16 + g * 8 + (HH)) * 8192 + tid * 16; stA = *(const u32x4*)sp_; stB = *(const u32x4*)(sp_ + 8); } while (0)
#define PC_ST(HH) do { *(LAS u32x4*)(L + O_ST + ((HH) & 1) * 16384 + tid * 32) = stA; *(LAS u32x4*)(L + O_ST + ((HH) & 1) * 16384 + tid * 32 + 16) = stB; } while (0)
    PC_LD(0); PC_ST(0);
    __syncthreads();
#pragma unroll 1
    for (int hh = 0; hh < 8; ++hh) {
        const int h = g * 8 + hh;
        if (hh + 1 < 8) PC_LD(hh + 1);
        const float el = __expf(acs[hh * 128 + l]);
        const LAS unsigned char* sp = L + O_ST + (hh & 1) * 16384 + fr * 64 + fq * 16;
        bf16_t* zrow = ZS + (size_t)(lt0 + l) * 1024 + h * 64 + 4 * fq;
        const bf16_t* yblk = P.YD + (size_t)((((lt0 + l0) >> 4) * 16 + h) * 2) * 512 + lane * 8;
        const u32x4 ydv0 = *(const u32x4*)yblk, ydv1 = *(const u32x4*)(yblk + 512);
        const float* nwp = P.ssd_norm + h * 64 + 4 * fq;
        float ss = 0.f;
#pragma unroll
        for (int jj = 0; jj < 4; ++jj) {
            f32x4 yo = {0.f, 0.f, 0.f, 0.f};
#pragma unroll
            for (int ks = 0; ks < 4; ++ks) { const bf16x8 sf = *(const LAS bf16x8*)(sp + jj * 4096 + ks * 1024); yo = mfma16(sf, cf[ks], yo); }
            const u32x4 ydv = (jj < 2) ? ydv0 : ydv1; const u32x2 yd4 = (jj & 1) ? (u32x2){ydv.z, ydv.w} : (u32x2){ydv.x, ydv.y}, zs4 = *(const u32x2*)(zrow + 16 * jj);
            const f32x4 nw = *(const f32x4*)(nwp + 16 * jj);
            float v[4];
            v[0] = (bf_lo(yd4.x) + el * yo[0]) * bf_lo(zs4.x); v[1] = (bf_hi(yd4.x) + el * yo[1]) * bf_hi(zs4.x);
            v[2] = (bf_lo(yd4.y) + el * yo[2]) * bf_lo(zs4.y); v[3] = (bf_hi(yd4.y) + el * yo[3]) * bf_hi(zs4.y);
            ss += (v[0] * v[0] + v[1] * v[1]) + (v[2] * v[2] + v[3] * v[3]);
            u32x2 o; o.x = pk2(v[0] * nw.x, v[1] * nw.y); o.y = pk2(v[2] * nw.z, v[3] * nw.w);
            *(u32x2*)(zrow + 16 * jj) = o;
        }
        ssg += ss;
        if (hh + 1 < 8) PC_ST(hh + 1);
        __syncthreads();
    }
#undef PC_LD
#undef PC_ST
    ssg += __shfl_xor(ssg, 16); ssg += __shfl_xor(ssg, 32);
    if (fq == 0) P.SSS[(size_t)(P.tok0 + lt0 + l) * 2 + g] = ssg;
}

__device__ __forceinline__ void gmlp_item(const Ctx& C, const P2Ptrs& P, int idx) {
    LAS unsigned char* L = C.lds;
    const int tid = C.tid, lane = C.lane, wid = C.wid, fr = lane & 15, fq = lane >> 4;
    const int bl = idx >> 7, c = (idx >> 3) & 15, g = idx & 7;
    const int lt0 = bl * SEQ + c * 128;
    bf16_t* GU = P.YB + (size_t)TS * 1024;
    const int s = tid >> 2, qd = tid & 3;
    u32x4 raw[4];
#pragma unroll
    for (int k = 0; k < 4; ++k) raw[k] = *(const u32x4*)(P.GV + (size_t)(lt0 + s) * 1024 + g * 128 + k * 32 + qd * 8);
    const float ssq = sum16(P.VSS + (size_t)(P.tok0 + lt0 + s) * 16);
    const int t0 = 16 * wid, nks = (t0 + 15) / 32 + 1, t = t0 + fr;
    bf16x8 wf[4];
#pragma unroll
    for (int ks = 0; ks < 4; ++ks) { wf[ks] = (bf16x8){0, 0, 0, 0, 0, 0, 0, 0}; if (ks < nks) wf[ks] = *(const bf16x8*)(P.WSP + (size_t)g * 16384 + ((wid * 4 + ks) * 16 + fr) * 32 + fq * 8); }
    bf16_t* gp0 = GU + (size_t)(lt0 + t) * 1024 + g * 128 + 8 * fq;
    u32x4 gu[4];
#pragma unroll
    for (int j = 0; j < 4; ++j) gu[j] = *(const u32x4*)(gp0 + 32 * j);
    const float bias = P.b_spatial[g * 128 + t];
    {
        const float rstd = rsqrtf(ssq * (1.f / 1024.f) + EPS);
#pragma unroll
        for (int k = 0; k < 4; ++k) {
            const int ch0 = k * 32 + qd * 8;
            const f32x4 n0 = *(const f32x4*)(P.gmlp_norm + g * 128 + ch0), n1 = *(const f32x4*)(P.gmlp_norm + g * 128 + ch0 + 4);
            float v[8]; v[0] = bf_lo(raw[k].x) * n0.x; v[1] = bf_hi(raw[k].x) * n0.y; v[2] = bf_lo(raw[k].y) * n0.z; v[3] = bf_hi(raw[k].y) * n0.w;
            v[4] = bf_lo(raw[k].z) * n1.x; v[5] = bf_hi(raw[k].z) * n1.y; v[6] = bf_lo(raw[k].w) * n1.z; v[7] = bf_hi(raw[k].w) * n1.w;
#pragma unroll
            for (int j = 0; j < 8; ++j) *(LAS unsigned short*)(L + (32 * k + 16 * (j >> 2) + 4 * qd + (j & 3)) * RP + s * 2) = (unsigned short)(pk2(v[j] * rstd, 0.f) & 0xffffu);
        }
    }
    __syncthreads();
    const int fb = fr * RP + fq * 16;
    f32x4 acc[8];
#pragma unroll
    for (int j = 0; j < 8; ++j) acc[j] = (f32x4){0.f, 0.f, 0.f, 0.f};
#pragma unroll
    for (int ks = 0; ks < 4; ++ks) {
        if (ks < nks) {
#pragma unroll
            for (int j = 0; j < 8; ++j) { const bf16x8 vf = *(const LAS bf16x8*)(L + fb + j * 16 * RP + ks * 64); acc[j] = mfma16(vf, wf[ks], acc[j]); }
        }
    }
#pragma unroll
    for (int j = 0; j < 4; ++j) {
        u32x4 o; o.x = pk2(bf_lo(gu[j].x) * (acc[2 * j][0] + bias), bf_hi(gu[j].x) * (acc[2 * j][1] + bias)); o.y = pk2(bf_lo(gu[j].y) * (acc[2 * j][2] + bias), bf_hi(gu[j].y) * (acc[2 * j][3] + bias));
        o.z = pk2(bf_lo(gu[j].z) * (acc[2 * j + 1][0] + bias), bf_hi(gu[j].z) * (acc[2 * j + 1][1] + bias)); o.w = pk2(bf_lo(gu[j].w) * (acc[2 * j + 1][2] + bias), bf_hi(gu[j].w) * (acc[2 * j + 1][3] + bias));
        *(u32x4*)(gp0 + 32 * j) = o;
    }
}

__device__ __forceinline__ void xattn_item(const Ctx& C, const P2Ptrs& P, int idx) {
    LAS unsigned char* L = C.lds;
    constexpr int VP = 288, O_A = 0, O_B = 73728;
    const int tid = C.tid, lane = C.lane, wid = C.wid, fr = lane & 15, fq = lane >> 4;
    const int bl = idx >> 5, h = (idx >> 3) & 3, qt = idx & 7;
    const int b = P.slab * 8 + bl;
    const int lt = bl * SEQ + qt * 256 + 32 * wid + fr;
    bf16_t* QX = P.YB + (size_t)2 * TS * 1024;
    bf16_t* qrow = QX + (size_t)lt * 1024 + h * 256;
    const int srow = tid >> 4, sc16 = tid & 15;
    const int fb = fr * RP + fq * 16;
    const int trb = (4 * fq + ((lane & 15) >> 2)) * VP + (lane & 3) * 8;
    u32x4 stg[8];
    const bf16_t* kg = P.KB + (size_t)(b * 256 + srow) * 1024 + h * 256 + sc16 * 8;
    const bf16_t* vg = P.VT + ((size_t)((b * 4 + h) * 2) * 256 + srow) * 128 + sc16 * 8;
#define XA_LOADK(half) do { unsigned ko_ = (half) * 256u; _Pragma("unroll") for (int q = 0; q < 8; ++q) { stg[q] = *(const u32x4*)((const unsigned char*)kg + ko_); ko_ += 32u * 2048u; asm volatile("" : "+v"(ko_)); } } while (0)
#define XA_LOADV(half) do { unsigned vo_ = (half) * 65536u; _Pragma("unroll") for (int q = 0; q < 8; ++q) { stg[q] = *(const u32x4*)((const unsigned char*)vg + vo_); vo_ += 32u * 256u; asm volatile("" : "+v"(vo_)); } } while (0)
#define XA_STOREK(buf) do { _Pragma("unroll") for (int q = 0; q < 8; ++q) *(LAS u32x4*)(L + (buf) + (srow + 32 * q) * RP + sc16 * 16) = stg[q]; } while (0)
#define XA_STOREV(buf) do { _Pragma("unroll") for (int q = 0; q < 8; ++q) *(LAS u32x4*)(L + (buf) + (srow + 32 * q) * VP + sc16 * 16) = stg[q]; } while (0)
#define XA_QK(buf, half) do { _Pragma("unroll") for (int j = 0; j < 16; ++j) { _Pragma("unroll") for (int ks = 0; ks < 4; ++ks) { const bf16x8 kf = *(const LAS bf16x8*)(L + (buf) + fb + j * 16 * RP + ks * 64); \
        s0[j] = mfma16(kf, qf[0][ks], s0[j]); s1[j] = mfma16(kf, qf[1][ks], s1[j]); } if ((j & 1) == 1) __builtin_amdgcn_sched_barrier(0); } } while (0)
    XA_LOADK(0);
    bf16x8 qf[2][4];
#define XA_LOADQ(half) do { _Pragma("unroll") for (int rb = 0; rb < 2; ++rb) { _Pragma("unroll") for (int ks = 0; ks < 4; ++ks) qf[rb][ks] = *(const bf16x8*)(qrow + rb * 16 * 1024 + (half) * 128 + ks * 32 + fq * 8); } } while (0)
    XA_LOADQ(0);
    f32x4 s0[16], s1[16];
#pragma unroll
    for (int j = 0; j < 16; ++j) { s0[j] = (f32x4){0.f, 0.f, 0.f, 0.f}; s1[j] = (f32x4){0.f, 0.f, 0.f, 0.f}; }
    XA_STOREK(O_A);
    __syncthreads();
    XA_LOADK(1);
    XA_QK(O_A, 0);
    XA_LOADQ(1);
    XA_STOREK(O_B);
    __syncthreads();
    XA_QK(O_B, 1);
    u32x2 p0r[16], p1r[16]; float inv0, inv1;
#define XA_SOFTMAX(S, PR, INV) do { float mx = -3.0e38f; _Pragma("unroll") for (int j = 0; j < 16; ++j) mx = fmaxf(fmaxf(fmaxf(S[j][0], S[j][1]), fmaxf(S[j][2], S[j][3])), mx); \
        mx = fmaxf(mx, __shfl_xor(mx, 16)); mx = fmaxf(mx, __shfl_xor(mx, 32)); float sum = 0.f; \
        _Pragma("unroll") for (int j = 0; j < 16; ++j) { const float e0 = __expf(S[j][0] - mx), e1 = __expf(S[j][1] - mx), e2 = __expf(S[j][2] - mx), e3 = __expf(S[j][3] - mx); sum += (e0 + e1) + (e2 + e3); PR[j].x = pk2(e0, e1); PR[j].y = pk2(e2, e3); } \
        sum += __shfl_xor(sum, 16); sum += __shfl_xor(sum, 32); INV = 1.f / sum; } while (0)
    __builtin_amdgcn_sched_barrier(0);
    XA_SOFTMAX(s0, p0r, inv0);
    __builtin_amdgcn_sched_barrier(0);
    XA_LOADV(0);
    XA_SOFTMAX(s1, p1r, inv1);
    __builtin_amdgcn_sched_barrier(0);
    XA_STOREV(O_A);
    __syncthreads();
    XA_LOADV(1);
#define XA_PV(buf, dh) do { _Pragma("unroll") for (int jd = 0; jd < 8; ++jd) { f32x4 o0 = {0.f, 0.f, 0.f, 0.f}, o1 = {0.f, 0.f, 0.f, 0.f}; \
        _Pragma("unroll") for (int ks = 0; ks < 8; ++ks) { const s16x4 vlo = __builtin_amdgcn_ds_read_tr16_b64_v4i16((LAS s16x4*)(L + (buf) + trb + ks * 32 * VP + jd * 32)), vhi = __builtin_amdgcn_ds_read_tr16_b64_v4i16((LAS s16x4*)(L + (buf) + trb + (ks * 32 + 16) * VP + jd * 32)); \
            const s16x8 v8 = {vlo.x, vlo.y, vlo.z, vlo.w, vhi.x, vhi.y, vhi.z, vhi.w}; const bf16x8 vf = __builtin_bit_cast(bf16x8, v8); \
            const u32x4 a0 = {p0r[2 * ks].x, p0r[2 * ks].y, p0r[2 * ks + 1].x, p0r[2 * ks + 1].y}, a1 = {p1r[2 * ks].x, p1r[2 * ks].y, p1r[2 * ks + 1].x, p1r[2 * ks + 1].y}; \
            o0 = mfma16(vf, __builtin_bit_cast(bf16x8, a0), o0); o1 = mfma16(vf, __builtin_bit_cast(bf16x8, a1), o1); } \
        u32x2 w0, w1; w0.x = pk2(o0[0] * inv0, o0[1] * inv0); w0.y = pk2(o0[2] * inv0, o0[3] * inv0); w1.x = pk2(o1[0] * inv1, o1[1] * inv1); w1.y = pk2(o1[2] * inv1, o1[3] * inv1); \
        *(u32x2*)(qrow + (dh) * 128 + 16 * jd + 4 * fq) = w0; *(u32x2*)(qrow + 16 * 1024 + (dh) * 128 + 16 * jd + 4 * fq) = w1; __builtin_amdgcn_sched_barrier(0); } } while (0)
    XA_PV(O_A, 0);
    XA_STOREV(O_B);
    __syncthreads();
    XA_PV(O_B, 1);
#undef XA_LOADK
#undef XA_LOADQ
#undef XA_LOADV
#undef XA_STOREK
#undef XA_STOREV
#undef XA_QK
#undef XA_SOFTMAX
#undef XA_PV
}

__device__ __forceinline__ void p2_mixers(const Ctx& C, const P2Ptrs& P, unsigned* queue) {
    LAS int* slot = (LAS int*)(C.lds + LDS_BYTES - 16);
    for (;;) {
        __syncthreads();
        if (C.tid == 0) *slot = (int)atomicAdd(queue, 1u);
        __syncthreads();
        const int item = *slot;
        if (item >= 256 + 256 + 1024) break;
        Ctx Ci = C; { int t_ = C.tid; asm volatile("" : "+v"(t_)); Ci.tid = t_; Ci.lane = t_ & 63; }
        if (item < 768) { const int k = item / 3, r = item - 3 * k; if (r == 0) ssd_a_item(Ci, P, k); else if (r == 1) xattn_item(Ci, P, k); else gmlp_item(Ci, P, k); }
        else gmlp_item(Ci, P, 256 + (item - 768));
    }
}
__device__ __forceinline__ void p2_scan(const Ctx& C, const P2Ptrs& P) { for (int it = C.bid; it < 512; it += C.G) ssd_scan_item(C, P, it); }
__device__ __forceinline__ void p2_pass_c(const Ctx& C, const P2Ptrs& P) { for (int it = C.bid; it < 256; it += C.G) { ssd_c_item(C, P, it); __syncthreads(); } }

struct SchedBranch {
    int G, c;
    __device__ __forceinline__ bool next(int i, pg8::Unit& u) const {
        const int tile = i / 3, n = i - 3 * tile; const int L = tile * G + c; if (L >= 256) return false;
        const int wgid = (L % 8) * 32 + L / 8;
        u.pm = n * 64 + (wgid >> 2); u.pn = n * 4 + (wgid & 3); return true;
    }
    __device__ __forceinline__ void a_ready(const pg8::Unit&) const {}
    __device__ __forceinline__ void done(const pg8::Unit&) const {}
};
struct EpiBranch {
    static constexpr bool PERM = true, AFTER_DRAIN = false, WANTS_SCRATCH = false, MUT_ACC = true;
    unsigned char* ws; int tok0; int noop;
    __device__ __forceinline__ void operator()(f32x4 (&acc)[2][2][4][2], const pg8::Unit& u, int wr, int wc, int fr, int fq) const {
        const int n = u.pn >> 2, pn = u.pn & 3, pm = u.pm & 63;
        if (noop == 1) { asm volatile("" :: "v"(acc[0][0][0][0][0]), "v"(acc[1][1][3][1][3])); return; }
        const unsigned char* const SG = ws + WS_SLAB + SL_SG; unsigned char* const MB = ws + WS_H + (size_t)tok0 * 2048; const float* const SSS = (const float*)(ws + WS_SSS) + (size_t)tok0 * 2;
        const unsigned lg = (unsigned)(fr + 16 * fq) * 8u;
        const unsigned lm = (unsigned)(fr * 1024 + 8 * fq) * 2u;
        const unsigned ls = (unsigned)fr * 8u;
        const unsigned char* const rg = SG + (size_t)((pm * 12 + n * 4 + pn) * 65536 + (wr * 4 + wc) * 8192);
        unsigned char* const rm = MB + (size_t)((pm * 256 + wr * 64) * 1024 + pn * 256 + wc * 32) * 2;
        const unsigned char* const rs_ = (const unsigned char*)SSS + (size_t)(pm * 256 + wr * 64) * 8;
#define EB_OFF(k) ((k) * 512)
#define EB_CVT4(w) (f32x4){(float)((w) & 0xffu), (float)(((w) >> 8) & 0xffu), (float)(((w) >> 16) & 0xffu), (float)((w) >> 24)}
#define EB_RCP4(w) (f32x4){__builtin_amdgcn_rcpf((float)((w) & 0xffu)), __builtin_amdgcn_rcpf((float)(((w) >> 8) & 0xffu)), __builtin_amdgcn_rcpf((float)(((w) >> 16) & 0xffu)), __builtin_amdgcn_rcpf((float)((w) >> 24))}
        if (n == 2) {
            u32x2 g[16];
#pragma unroll
            for (int k = 0; k < 16; ++k) g[k] = *(const u32x2*)(rg + (EB_OFF(k)) + lg);
#pragma unroll
            for (int k = 0; k < 16; ++k) {
                const int ai = k >> 3, m = (k >> 1) & 3, bj = k & 1;
                const f32x4 v0 = (acc[ai][bj][m][0] * (1.f / 255.f)) * EB_CVT4(g[k].x), v1 = (acc[ai][bj][m][1] * (1.f / 255.f)) * EB_CVT4(g[k].y);
                u32x4 w; w.x = pk2(v0.x, v0.y); w.y = pk2(v0.z, v0.w); w.z = pk2(v1.x, v1.y); w.w = pk2(v1.z, v1.w);
                *(u32x4*)(rm + ((ai * 128 + m * 16) * 1024 + bj * 128) * 2 + lm) = w;
                if ((k & 3) == 3) __builtin_amdgcn_sched_barrier(0);
            }
        }
        {
            constexpr int EB_RING = 4;
            u32x2 g[EB_RING][2], h[EB_RING][2], sq[EB_RING];
            const int hoff = (n < 2) ? 4 * 65536 : 0;
#define EB_LOADB(b, p) do { if (n < 2) { _Pragma("unroll") for (int j = 0; j < 2; ++j) { g[p][j] = *(const u32x2*)(rg + (EB_OFF((b) * 2 + j)) + lg); h[p][j] = *(const u32x2*)(rg + (hoff + EB_OFF((b) * 2 + j)) + lg); } \
            sq[p] = *(const u32x2*)(rs_ + ((((b) >> 2) * 128 + ((b) & 3) * 16) * 8) + ls); } \
            else { _Pragma("unroll") for (int j = 0; j < 2; ++j) { g[p][j] = (u32x2){0x01010101u, 0x01010101u}; h[p][j] = (u32x2){0x01010101u, 0x01010101u}; } sq[p] = (u32x2){0x3f800000u, 0x3f800000u}; } } while (0)
#pragma unroll
            for (int b = 0; b < EB_RING; ++b) EB_LOADB(b, b);
#pragma unroll
            for (int b = 0; b < 8; ++b) {
                const int p = b % EB_RING;
                const unsigned sqx = sq[p].x, sqy = sq[p].y;
                const float rsn = rsqrtf((__builtin_bit_cast(float, sqx) + __builtin_bit_cast(float, sqy)) * (1.f / 1024.f) + EPS);
                const float rs = (n == 0) ? rsn : (n == 1) ? 1.f : 0.f;
#pragma unroll
                for (int j = 0; j < 2; ++j) {
                    const int k = b * 2 + j, ai = k >> 3, m = (k >> 1) & 3, bj = k & 1;
                    const f32x4 r0 = EB_CVT4(g[p][j].x) * EB_RCP4(h[p][j].x), r1 = EB_CVT4(g[p][j].y) * EB_RCP4(h[p][j].y);
                    acc[ai][bj][m][0] = (acc[ai][bj][m][0] * rs) * r0;
                    acc[ai][bj][m][1] = (acc[ai][bj][m][1] * rs) * r1;
                }
                if (b + EB_RING < 8) EB_LOADB(b + EB_RING, p);
                __builtin_amdgcn_sched_barrier(0);
            }
#undef EB_LOADB
        }
#undef EB_OFF
#undef EB_CVT4
#undef EB_RCP4
    }
};
struct SchedTile256 {
    int G, c;
    __device__ __forceinline__ bool next(int i, pg8::Unit& u) const {
        const int L = i * G + c; if (L >= 256) return false;
        const int wgid = (L % 8) * 32 + L / 8; u.pm = wgid >> 2; u.pn = wgid & 3; return true;
    }
    __device__ __forceinline__ void a_ready(const pg8::Unit&) const {}
    __device__ __forceinline__ void done(const pg8::Unit&) const {}
};
struct EpiOut {
    static constexpr bool PERM = true, AFTER_DRAIN = false, WANTS_SCRATCH = false, MUT_ACC = false;
    const float* X; float* X2; unsigned char* ws; const float* ln_ffn; int tok0;
    __device__ __forceinline__ void operator()(const f32x4 (&acc)[2][2][4][2], const pg8::Unit& u, int wr, int wc, int fr, int fq) const {
        float* const XSS = (float*)(ws + WS_XSS);
        const int rbase = tok0 + u.pm * 256 + wr * 64 + fr;
        const int cbase = u.pn * 256 + wc * 32 + 8 * fq;
#pragma unroll
        for (int pr = 0; pr < 4; ++pr) {
            f32x4 xr[2][2][2];
#pragma unroll
            for (int q = 0; q < 2; ++q) { const int k = pr * 2 + q, ai = k >> 2, m = k & 3; const size_t off = (size_t)(rbase + ai * 128 + m * 16) * 1024 + cbase;
#pragma unroll
                for (int bj = 0; bj < 2; ++bj) { xr[q][bj][0] = *(const f32x4*)(X + off + bj * 128); xr[q][bj][1] = *(const f32x4*)(X + off + bj * 128 + 4); } }
#pragma unroll
            for (int q = 0; q < 2; ++q) { const int k = pr * 2 + q, ai = k >> 2, m = k & 3; const int gt = rbase + ai * 128 + m * 16; const size_t off = (size_t)gt * 1024 + cbase; float ss = 0.f;
#pragma unroll
                for (int bj = 0; bj < 2; ++bj) {
                    const f32x4 v0 = acc[ai][bj][m][0] + xr[q][bj][0], v1 = acc[ai][bj][m][1] + xr[q][bj][1];
                    { u32x4 wx; wx.x = pk2(v0.x, v0.y); wx.y = pk2(v0.z, v0.w); wx.z = pk2(v1.x, v1.y); wx.w = pk2(v1.z, v1.w); *(u32x4*)((bf16_t*)X2 + off + bj * 128) = wx; }
                    ss += (v0.x * v0.x + v0.y * v0.y) + (v0.z * v0.z + v0.w * v0.w) + (v1.x * v1.x + v1.y * v1.y) + (v1.z * v1.z + v1.w * v1.w);
                }
                ss += __shfl_xor(ss, 16); ss += __shfl_xor(ss, 32); if (fq == 0) XSS[(size_t)gt * 16 + u.pn * 4 + wc] = ss; }
            __builtin_amdgcn_sched_barrier(0);
        }
    }
};

struct SchedStatic {
    int nM, nN, nwg, G, c;
    __device__ __forceinline__ bool next(int i, pg8::Unit& u) const {
        const int L = i * G + c; if (L >= nwg) return false;
        int wgid = L; { const int q = nwg / 8, r = nwg % 8, xcd = wgid % 8, off = wgid / 8; wgid = (xcd < r ? xcd * (q + 1) : r * (q + 1) + (xcd - r) * q) + off; }
        const int nig = 8 * nN, gid = wgid / nig, fm = gid * 8, gsz = (nM - fm) < 8 ? (nM - fm) : 8;
        u.pm = fm + ((wgid % nig) % gsz); u.pn = (wgid % nig) / gsz; return true;
    }
    __device__ __forceinline__ void a_ready(const pg8::Unit&) const {}
    __device__ __forceinline__ void done(const pg8::Unit&) const {}
};
struct EpiQ {
    static constexpr bool PERM = true, AFTER_DRAIN = false, WANTS_SCRATCH = true, MUT_ACC = false;
    unsigned char* ws;
    __device__ __forceinline__ void operator()(const f32x4 (&acc)[2][2][4][2], const pg8::Unit& u, int wr, int wc, int fr, int fq, bf16x8 (&sa)[4][2], bf16x8 (&sb0)[2][2], bf16x8 (&sb1)[2][2]) const {
        bf16_t* const Q2 = (bf16_t*)(ws + WS_Q2); const float* const XSS = (const float*)(ws + WS_XSS);
        const int rbase = u.pm * 256 + wr * 64 + fr;
        const int cbase = u.pn * 256 + wc * 32 + 8 * fq;
#define EQ_SLOT(i) ((i) < 8 ? sa[(i) >> 1][(i) & 1] : ((i) < 12 ? sb0[((i) - 8) >> 1][(i) & 1] : sb1[((i) - 12) >> 1][(i) & 1]))
#pragma unroll
        for (int ai = 0; ai < 2; ++ai) {
#pragma unroll
            for (int i = 0; i < 16; ++i) EQ_SLOT(i) = *(const bf16x8*)(XSS + (size_t)(rbase + ai * 128 + (i >> 2) * 16) * 16 + (i & 3) * 4);
#pragma unroll
            for (int m = 0; m < 4; ++m) {
                const int gt = rbase + ai * 128 + m * 16;
                const f32x4 a = __builtin_bit_cast(f32x4, EQ_SLOT(4 * m)), b = __builtin_bit_cast(f32x4, EQ_SLOT(4 * m + 1)), c = __builtin_bit_cast(f32x4, EQ_SLOT(4 * m + 2)), d = __builtin_bit_cast(f32x4, EQ_SLOT(4 * m + 3));
                const float ssq = (((a.x + a.y) + (a.z + a.w)) + ((b.x + b.y) + (b.z + b.w))) + (((c.x + c.y) + (c.z + c.w)) + ((d.x + d.y) + (d.z + d.w)));
                const float rs = rsqrtf(ssq * (1.f / 1024.f) + EPS);
#pragma unroll
                for (int bj = 0; bj < 2; ++bj) {
                    const f32x4 v0 = acc[ai][bj][m][0] * rs, v1 = acc[ai][bj][m][1] * rs;
                    u32x4 w; w.x = pk2(v0.x, v0.y); w.y = pk2(v0.z, v0.w); w.z = pk2(v1.x, v1.y); w.w = pk2(v1.z, v1.w);
                    *(u32x4*)(Q2 + (size_t)((((gt >> 4) * 8 + u.pn) * 2 + bj) * 2048 + wc * 512 + fr * 32 + fq * 8)) = w;
                }
            }
            __builtin_amdgcn_sched_barrier(0);
        }
#undef EQ_SLOT
    }
};

struct P67Ptrs { const bf16_t *Q2, *KEYS, *XB; const unsigned char *PU, *PV; const float *SU, *SV; unsigned short* EID; float* GATE; const float* XSS; float* X2; const float* ln_final; float *PD; bf16_t* PW; float* SS3; unsigned* q; };

__device__ __forceinline__ void p67_tile(const Ctx& C, const P67Ptrs& P, int tile) {
    LAS unsigned char* L = C.lds;
    const int tid = C.tid, lane = C.lane, wid = C.wid, fr = lane & 15, fq = lane >> 4;
    const int gt0 = tile * 128;
    constexpr int O_SC = 0, O_MG = 0, O_FK = 16384, O_WL = 135168, O_EL = 139264;
#ifndef REP_P6
#define REP_P6 1
#endif
#ifndef REP_U
#define REP_U 1
#endif
#ifndef REP_V
#define REP_V 1
#endif
    const int sci = wid >> 2, sctq = wid & 3;
    bf16x8 qf[2][4], kfa[4], kfb[4];
#define P6_LOADQ(H) do { _Pragma("unroll") for (int tt_ = 0; tt_ < 2; ++tt_) { _Pragma("unroll") for (int ks = 0; ks < 4; ++ks) \
        qf[tt_][ks] = *(const bf16x8*)(P.Q2 + (size_t)((((tile * 8 + 2 * sctq + tt_) * 8 + (H)) * 2 + sci) * 2048 + ks * 512 + fr * 32 + fq * 8)); } } while (0)
#define P6_LOADK(DST, H, JT) do { _Pragma("unroll") for (int ks = 0; ks < 4; ++ks) DST[ks] = *(const bf16x8*)(P.KEYS + (size_t)((H) * 2 + sci) * 16384 + (((JT) * 4 + ks) * 16 + fr) * 32 + fq * 8); } while (0)
#define P6_MMA(KF, JT) do { _Pragma("unroll") for (int tt_ = 0; tt_ < 2; ++tt_) { f32x4 a_ = {0.f, 0.f, 0.f, 0.f}; \
        _Pragma("unroll") for (int ks = 0; ks < 4; ++ks) a_ = mfma16(KF[ks], qf[tt_][ks], a_); \
        *(LAS f32x4*)(L + O_SC + ((sci * 128 + 32 * sctq + 16 * tt_ + fr) * 132 + 16 * (JT) + 4 * fq) * 4) = a_; } } while (0)
    u32x4 pe[2] = {{0u, 0u, 0u, 0u}, {0u, 0u, 0u, 0u}}; f32x4 pg[4] = {{0.f, 0.f, 0.f, 0.f}, {0.f, 0.f, 0.f, 0.f}, {0.f, 0.f, 0.f, 0.f}, {0.f, 0.f, 0.f, 0.f}};
#define P6_STORE_RES(H) do { unsigned short* ep_ = P.EID + (size_t)(gt0 + tid) * 128 + (H) * 16; float* gp_ = P.GATE + (size_t)(gt0 + tid) * 128 + (H) * 16; \
        *(u32x4*)ep_ = pe[0]; *(u32x4*)(ep_ + 8) = pe[1]; *(f32x4*)gp_ = pg[0]; *(f32x4*)(gp_ + 4) = pg[1]; *(f32x4*)(gp_ + 8) = pg[2]; *(f32x4*)(gp_ + 12) = pg[3]; } while (0)
    P6_LOADQ(0); P6_LOADK(kfa, 0, 0);
    for (int h6 = 0; h6 < 8 * REP_P6; ++h6) {
        const int h = h6 & 7;
        {
#pragma unroll
            for (int jt = 0; jt < 8; jt += 2) {
                P6_LOADK(kfb, h, jt + 1);
                P6_MMA(kfa, jt);
                __builtin_amdgcn_sched_barrier(0);
                if (jt + 2 < 8) P6_LOADK(kfa, h, jt + 2);
                P6_MMA(kfb, jt + 1);
                __builtin_amdgcn_sched_barrier(0);
            }
            if (tid < 128 && h6 > 0) P6_STORE_RES((h6 - 1) & 7);
            const int hn = (h6 + 1) & 7;
            if (h6 + 1 < 8 * REP_P6) { P6_LOADQ(hn); P6_LOADK(kfa, hn, 0); }
        }
        __syncthreads();
        const int tt = tid & 127, ii = (tid >> 7) & 1, hf = tid >> 8;
        unsigned list[16];
        {
            const LAS unsigned char* row = L + O_SC + ((ii * 128 + tt) * 132 + hf * 64) * 4;
#pragma unroll
            for (int e4 = 0; e4 < 4; ++e4) {
                const f32x4 v = *(const LAS f32x4*)(row + e4 * 16);
#pragma unroll
                for (int q = 0; q < 4; ++q) list[e4 * 4 + q] = (ord_key(v[q]) & ~127u) | (unsigned)(127 - (hf * 64 + e4 * 4 + q));
            }
            sort16(list);
#pragma unroll 1
            for (int gq = 1; gq < 4; ++gq) {
                unsigned grp[16];
#pragma unroll
                for (int e4 = 0; e4 < 4; ++e4) {
                    const f32x4 v = *(const LAS f32x4*)(row + (gq * 4 + e4) * 16);
#pragma unroll
                    for (int q = 0; q < 4; ++q) grp[e4 * 4 + q] = (ord_key(v[q]) & ~127u) | (unsigned)(127 - (hf * 64 + gq * 16 + e4 * 4 + q));
                }
                sort16(grp);
                merge16(list, grp);
            }
        }
        __syncthreads();
        if (hf == 1) {
#pragma unroll
            for (int j = 0; j < 16; ++j) *(LAS unsigned*)(L + O_MG + (j * 256 + (tid & 255)) * 4) = list[j];
        }
        __syncthreads();
        if (hf == 0) {
            unsigned other[16];
#pragma unroll
            for (int j = 0; j < 16; ++j) other[j] = *(const LAS unsigned*)(L + O_MG + (j * 256 + tid) * 4);
            merge16(list, other);
#pragma unroll
            for (int j = 0; j < 16; ++j) *(LAS unsigned*)(L + O_FK + ((ii * 16 + j) * 128 + tt) * 4) = list[j];
        }
        __syncthreads();
        unsigned cl[16];
        if (tid < 256) {
            const int tk = tid & 127, role = tid >> 7;
            float v1[16], v2[16];
#pragma unroll
            for (int a = 0; a < 16; ++a) { v1[a] = unord_key(*(const LAS unsigned*)(L + O_FK + ((0 * 16 + a) * 128 + tk) * 4) & ~127u); v2[a] = unord_key(*(const LAS unsigned*)(L + O_FK + ((1 * 16 + a) * 128 + tk) * 4) & ~127u); }
#define P6_KEY(a, b) ((ord_key(v1[a] + v2[b]) & ~255u) | (unsigned)(255 - ((a) * 16 + (b))))
            if (role == 0) {
                unsigned lb[16];
#pragma unroll
                for (int b = 0; b < 16; ++b) cl[b] = P6_KEY(0, b);
#pragma unroll
                for (int b = 0; b < 8; ++b) lb[b] = P6_KEY(1, b);
#pragma unroll
                for (int b = 0; b < 5; ++b) lb[8 + b] = P6_KEY(2, b);
#pragma unroll
                for (int b = 0; b < 3; ++b) lb[13 + b] = P6_KEY(3, b);
                sort16(lb);
                merge16(cl, lb);
                ins16(cl, P6_KEY(3, 3));
            } else {
                cl[0] = P6_KEY(4, 0); cl[1] = P6_KEY(4, 1); cl[2] = P6_KEY(4, 2); cl[3] = P6_KEY(5, 0); cl[4] = P6_KEY(5, 1); cl[5] = P6_KEY(6, 0); cl[6] = P6_KEY(6, 1); cl[7] = P6_KEY(7, 0);
                cl[8] = P6_KEY(7, 1); cl[9] = P6_KEY(8, 0); cl[10] = P6_KEY(9, 0); cl[11] = P6_KEY(10, 0); cl[12] = P6_KEY(11, 0); cl[13] = P6_KEY(12, 0); cl[14] = P6_KEY(13, 0); cl[15] = P6_KEY(14, 0);
                sort16(cl);
                ins16(cl, P6_KEY(15, 0));
#pragma unroll
                for (int j = 0; j < 16; ++j) *(LAS unsigned*)(L + O_MG + (j * 128 + tk) * 4) = cl[j];
            }
        }
        __syncthreads();
        if (tid < 128) {
            unsigned other[16];
#pragma unroll
            for (int j = 0; j < 16; ++j) other[j] = *(const LAS unsigned*)(L + O_MG + (j * 128 + tid) * 4);
            merge16(cl, other);
            float val[16]; int eid[16]; float mx = -3.0e38f;
#pragma unroll
            for (int j = 0; j < 16; ++j) {
                const int pos = 255 - (int)(cl[j] & 255u), a = pos >> 4, b = pos & 15;
                const unsigned ka = *(const LAS unsigned*)(L + O_FK + ((0 * 16 + a) * 128 + tid) * 4), kb = *(const LAS unsigned*)(L + O_FK + ((1 * 16 + b) * 128 + tid) * 4);
                val[j] = unord_key(ka & ~127u) + unord_key(kb & ~127u);
                eid[j] = (127 - (int)(ka & 127u)) * 128 + (127 - (int)(kb & 127u));
                mx = fmaxf(mx, val[j]);
            }
            float sum = 0.f;
#pragma unroll
            for (int j = 0; j < 16; ++j) { val[j] = __expf(val[j] - mx); sum += val[j]; }
            const float inv = 1.f / sum;
#pragma unroll
            for (int j = 0; j < 16; j += 8) pe[j >> 3] = (u32x4){(unsigned)eid[j] | ((unsigned)eid[j + 1] << 16), (unsigned)eid[j + 2] | ((unsigned)eid[j + 3] << 16), (unsigned)eid[j + 4] | ((unsigned)eid[j + 5] << 16), (unsigned)eid[j + 6] | ((unsigned)eid[j + 7] << 16)};
#pragma unroll
            for (int j = 0; j < 16; j += 4) pg[j >> 2] = (f32x4){val[j] * inv, val[j + 1] * inv, val[j + 2] * inv, val[j + 3] * inv};
        }
        __syncthreads();
    }
    if (tid < 128) P6_STORE_RES(7);
#undef P6_STORE_RES
}

#undef P6_LOADK
#undef P6_LOADQ
#undef P6_MMA
template <class F>
__device__ __forceinline__ void sliced_items(const Ctx& C, unsigned* q8, F&& item) {
    LAS int* slot = (LAS int*)(C.lds + LDS_BYTES - 16);
    const int x0 = (int)(xb_xcc_id() & 7u);
    for (int k = 0; k < 8; ++k) {
        const int x = (x0 + k) & 7;
        for (;;) {
            __syncthreads();
            if (C.tid == 0) *slot = (int)atomicAdd(q8 + x * 16, 1u);
            __syncthreads();
            const int it = *slot;
            if (it >= 128) break;
            item(x, it);
        }
    }
}
__device__ __forceinline__ void peer_u_item(const Ctx& C, const P67Ptrs& P, int x, int tile) {
    LAS unsigned char* L = C.lds;
    const int tid = C.tid, lane = C.lane, wid = C.wid, g8 = lane >> 3, s8 = lane & 7;
    const int gt0 = tile * 256;
    {
        const u32x4* src = (const u32x4*)(P.EID + (size_t)gt0 * 128);
#pragma unroll
        for (int i = 0; i < 8; ++i) *(LAS u32x4*)(L + (size_t)(tid + i * NTHR) * 16) = src[tid + i * NTHR];
    }
    __syncthreads();
    const int c0 = 128 * x + 16 * s8;
    for (int batch = 0; batch < 4; ++batch) {
        const int t = 32 * wid + 8 * batch + g8, gt = gt0 + t;
        f2v xf[8];
        { const bf16_t* x2h = (const bf16_t*)P.X2; const u32x4 a = *(const u32x4*)(x2h + (size_t)gt * 1024 + c0), b = *(const u32x4*)(x2h + (size_t)gt * 1024 + c0 + 8);
          xf[0] = (f2v){bf_lo(a.x), bf_hi(a.x)}; xf[1] = (f2v){bf_lo(a.y), bf_hi(a.y)}; xf[2] = (f2v){bf_lo(a.z), bf_hi(a.z)}; xf[3] = (f2v){bf_lo(a.w), bf_hi(a.w)};
          xf[4] = (f2v){bf_lo(b.x), bf_hi(b.x)}; xf[5] = (f2v){bf_lo(b.y), bf_hi(b.y)}; xf[6] = (f2v){bf_lo(b.z), bf_hi(b.z)}; xf[7] = (f2v){bf_lo(b.w), bf_hi(b.w)}; }
        unsigned* pd = (unsigned*)P.PD + ((size_t)x * T_ALL + gt) * 64 + s8;
        float plo = 0.f;
#pragma unroll 2
        for (int p8 = 0; p8 < 16; ++p8) {
            const u32x4 ew = *(const LAS u32x4*)(L + (t * 128 + 8 * p8) * 2);
            const unsigned e[8] = {ew.x & 0xffffu, ew.x >> 16, ew.y & 0xffffu, ew.y >> 16, ew.z & 0xffffu, ew.z >> 16, ew.w & 0xffffu, ew.w >> 16};
            u32x4 q[8];
#pragma unroll
            for (int k = 0; k < 8; ++k) q[k] = *(const u32x4*)(P.PU + (size_t)x * (16384 * 128) + (size_t)e[k] * 128 + 16 * s8);
            float d[8];
#pragma unroll
            for (int k = 0; k < 8; ++k) { f2v a2 = {0.f, 0.f};
#pragma unroll
                for (int j = 0; j < 4; ++j) { a2 = __builtin_amdgcn_cvt_pk_f32_fp8((int)q[k][j], false) * xf[2 * j] + a2; a2 = __builtin_amdgcn_cvt_pk_f32_fp8((int)q[k][j], true) * xf[2 * j + 1] + a2; }
                d[k] = a2.x + a2.y; }
            float r4[4], r2[2];
#pragma unroll
            for (int i = 0; i < 4; ++i) { const float keep = (s8 & 4) ? d[i + 4] : d[i], send = (s8 & 4) ? d[i] : d[i + 4]; r4[i] = keep + dpp_xor4(send); }
#pragma unroll
            for (int i = 0; i < 2; ++i) { const float keep = (s8 & 2) ? r4[i + 2] : r4[i], send = (s8 & 2) ? r4[i] : r4[i + 2]; r2[i] = keep + dpp_xor2(send); }
            { const float keep = (s8 & 1) ? r2[1] : r2[0], send = (s8 & 1) ? r2[0] : r2[1]; const float tot = keep + dpp_xor1(send);
              if (p8 & 1) pd[8 * (p8 >> 1)] = pk2(plo, tot); else plo = tot; }
        }
    }
}
__device__ __forceinline__ void peer_w_phase(const Ctx& C, const P67Ptrs& P) {
    const int gw = C.bid * 8 + C.wid, NGW = C.G * 8, lane = C.lane;
    const int p0 = 16 * (lane >> 3) + (lane & 7), p1 = p0 + 8;
    const unsigned* PDw = (const unsigned*)P.PD;
    for (int g0 = gw; g0 < T_ALL; g0 += 4 * NGW) {
        f32x4 xs[4][4]; unsigned w[4][8]; int e0[4], e1[4]; float ga0[4], ga1[4];
#pragma unroll
        for (int u = 0; u < 4; ++u) {
            const int gt = (g0 + u * NGW < T_ALL) ? g0 + u * NGW : g0;
            const float* xp = P.XSS + (size_t)gt * 16;
            xs[u][0] = *(const f32x4*)xp; xs[u][1] = *(const f32x4*)(xp + 4); xs[u][2] = *(const f32x4*)(xp + 8); xs[u][3] = *(const f32x4*)(xp + 12);
#pragma unroll
            for (int x = 0; x < 8; ++x) w[u][x] = PDw[((size_t)x * T_ALL + gt) * 64 + lane];
            e0[u] = P.EID[(size_t)gt * 128 + p0]; e1[u] = P.EID[(size_t)gt * 128 + p1];
            ga0[u] = P.GATE[(size_t)gt * 128 + p0]; ga1[u] = P.GATE[(size_t)gt * 128 + p1];
        }
        float sv0[4], sv1[4], su0[4], su1[4];
#pragma unroll
        for (int u = 0; u < 4; ++u) { sv0[u] = P.SV[e0[u]]; sv1[u] = P.SV[e1[u]]; su0[u] = P.SU[e0[u]]; su1[u] = P.SU[e1[u]]; }
#pragma unroll
        for (int u = 0; u < 4; ++u) {
            if (g0 + u * NGW < T_ALL) {
                const int gt = g0 + u * NGW;
                const f32x4 a = xs[u][0], b = xs[u][1], c = xs[u][2], d = xs[u][3];
                const float ssq = (((a.x + a.y) + (a.z + a.w)) + ((b.x + b.y) + (b.z + b.w))) + (((c.x + c.y) + (c.z + c.w)) + ((d.x + d.y) + (d.z + d.w)));
                const float rstd = rsqrtf(ssq * (1.f / 1024.f) + EPS);
                float s0 = 0.f, s1 = 0.f;
#pragma unroll
                for (int x = 0; x < 8; ++x) { s0 += bf_lo(w[u][x]); s1 += bf_hi(w[u][x]); }
                const size_t i0 = (size_t)gt * 128 + p0, i1 = (size_t)gt * 128 + p1;
                P.PW[i0] = (bf16_t)(pk2(ga0[u] * sv0[u] * gelu_f(s0 * su0[u] * rstd), 0.f) & 0xffffu);
                P.PW[i1] = (bf16_t)(pk2(ga1[u] * sv1[u] * gelu_f(s1 * su1[u] * rstd), 0.f) & 0xffffu);
            }
        }
    }
}
__device__ __forceinline__ void peer_v_item(const Ctx& C, const P67Ptrs& P, int x, int tile) {
    LAS unsigned char* L = C.lds;
    const int tid = C.tid, lane = C.lane, wid = C.wid, g8 = lane >> 3, s8 = lane & 7;
    const int gt0 = tile * 256;
    {
        const u32x4* se = (const u32x4*)(P.EID + (size_t)gt0 * 128); const u32x4* sw = (const u32x4*)(P.PW + (size_t)gt0 * 128);
#pragma unroll
        for (int i = 0; i < 8; ++i) { *(LAS u32x4*)(L + (size_t)(tid + i * NTHR) * 16) = se[tid + i * NTHR]; *(LAS u32x4*)(L + 65536 + (size_t)(tid + i * NTHR) * 16) = sw[tid + i * NTHR]; }
    }
    __syncthreads();
    const int c0 = 128 * x + 16 * s8;
    for (int batch = 0; batch < 4; ++batch) {
        const int t = 32 * wid + 8 * batch + g8, gt = gt0 + t;
        f2v acc[8];
#pragma unroll
        for (int j = 0; j < 8; ++j) acc[j] = (f2v){0.f, 0.f};
#pragma unroll 2
        for (int p8 = 0; p8 < 16; ++p8) {
            const u32x4 ew = *(const LAS u32x4*)(L + (t * 128 + 8 * p8) * 2), ww = *(const LAS u32x4*)(L + 65536 + (t * 128 + 8 * p8) * 2);
            const unsigned e[8] = {ew.x & 0xffffu, ew.x >> 16, ew.y & 0xffffu, ew.y >> 16, ew.z & 0xffffu, ew.z >> 16, ew.w & 0xffffu, ew.w >> 16};
            const float w[8] = {bf_lo(ww.x), bf_hi(ww.x), bf_lo(ww.y), bf_hi(ww.y), bf_lo(ww.z), bf_hi(ww.z), bf_lo(ww.w), bf_hi(ww.w)};
            u32x4 q[8];
#pragma unroll
            for (int k = 0; k < 8; ++k) q[k] = *(const u32x4*)(P.PV + (size_t)x * (16384 * 128) + (size_t)e[k] * 128 + 16 * s8);
#pragma unroll
            for (int k = 0; k < 8; ++k) { const f2v w2 = {w[k], w[k]};
#pragma unroll
                for (int j = 0; j < 4; ++j) { acc[2 * j] = __builtin_amdgcn_cvt_pk_f32_fp8((int)q[k][j], false) * w2 + acc[2 * j]; acc[2 * j + 1] = __builtin_amdgcn_cvt_pk_f32_fp8((int)q[k][j], true) * w2 + acc[2 * j + 1]; } }
        }
        const bf16_t* xi = (const bf16_t*)P.X2 + (size_t)gt * 1024 + c0; bf16_t* so = (bf16_t*)P.XB + (size_t)gt * 1024 + c0; float ss = 0.f;
        const u32x4 xa = *(const u32x4*)xi, xb = *(const u32x4*)(xi + 8);
        const unsigned xw[8] = {xa.x, xa.y, xa.z, xa.w, xb.x, xb.y, xb.z, xb.w};
        unsigned ow[8];
#pragma unroll
        for (int i = 0; i < 8; ++i) { const float s0 = bf_lo(xw[i]) + acc[i].x, s1 = bf_hi(xw[i]) + acc[i].y; ss += s0 * s0 + s1 * s1; ow[i] = pk2(s0, s1); }
        *(u32x4*)so = (u32x4){ow[0], ow[1], ow[2], ow[3]}; *(u32x4*)(so + 8) = (u32x4){ow[4], ow[5], ow[6], ow[7]};
        ss += dpp_xor1(ss); ss += dpp_xor2(ss); ss += dpp_xor4(ss);
        if (s8 == 0) P.SS3[(size_t)gt * 8 + x] = ss;
    }
}
__device__ __forceinline__ void peer_final_phase(const Ctx& C, const P67Ptrs& P) {
    const int gw = C.bid * 8 + C.wid, NGW = C.G * 8, lane = C.lane;
    const f32x4* gr = (const f32x4*)P.ln_final;
    for (int g0 = gw; g0 < T_ALL; g0 += 2 * NGW) {
        const int gtA = g0, gtB = (g0 + NGW < T_ALL) ? g0 + NGW : g0;
        const f32x4 saA = *(const f32x4*)(P.SS3 + (size_t)gtA * 8), sbA = *(const f32x4*)(P.SS3 + (size_t)gtA * 8 + 4), saB = *(const f32x4*)(P.SS3 + (size_t)gtB * 8), sbB = *(const f32x4*)(P.SS3 + (size_t)gtB * 8 + 4);
        const bf16_t* srcA = P.XB + (size_t)gtA * 1024 + lane * 4; const bf16_t* srcB = P.XB + (size_t)gtB * 1024 + lane * 4;
        f32x4* rowA = (f32x4*)(P.X2 + (size_t)gtA * 1024); f32x4* rowB = (f32x4*)(P.X2 + (size_t)gtB * 1024);
        u32x2 vA[4], vB[4];
#pragma unroll
        for (int j = 0; j < 4; ++j) { vA[j] = *(const u32x2*)(srcA + 256 * j); vB[j] = *(const u32x2*)(srcB + 256 * j); }
        const float rA = rsqrtf((((saA.x + saA.y) + (saA.z + saA.w)) + ((sbA.x + sbA.y) + (sbA.z + sbA.w))) * (1.f / 1024.f) + EPS);
        const float rB = rsqrtf((((saB.x + saB.y) + (saB.z + saB.w)) + ((sbB.x + sbB.y) + (sbB.z + sbB.w))) * (1.f / 1024.f) + EPS);
#pragma unroll
        for (int j = 0; j < 4; ++j) { const f32x4 g = gr[lane + 64 * j]; rowA[lane + 64 * j] = (f32x4){bf_lo(vA[j].x) * rA * g.x, bf_hi(vA[j].x) * rA * g.y, bf_lo(vA[j].y) * rA * g.z, bf_hi(vA[j].y) * rA * g.w}; }
        if (g0 + NGW < T_ALL) {
#pragma unroll
            for (int j = 0; j < 4; ++j) { const f32x4 g = gr[lane + 64 * j]; rowB[lane + 64 * j] = (f32x4){bf_lo(vB[j].x) * rB * g.x, bf_hi(vB[j].x) * rB * g.y, bf_lo(vB[j].y) * rB * g.z, bf_hi(vB[j].y) * rB * g.w}; }
        }
    }
}

#ifndef MK_MULTI
#define MK_MULTI 0
#endif
constexpr int NSEG = 18;

__global__ void __launch_bounds__(NTHR, 2) fwd_megakernel(Params prm) {
    extern __shared__ __attribute__((aligned(16))) unsigned char lds_raw[];
    LAS unsigned char* const lds = (LAS unsigned char*)lds_raw;
    const int wv = __builtin_amdgcn_readfirstlane((int)(threadIdx.x >> 6));
    const int lo = prm.seg_lo, hi = prm.seg_hi;
#if MK_MULTI
#define GSYNC(k) do {} while (0)
#else
    cg::grid_group grid = cg::this_grid();
    volatile LAS unsigned* xb_st = (volatile LAS unsigned*)(lds + LDS_BYTES - 32);
    if (threadIdx.x == 0) { xb_st[0] = 0u; xb_st[1] = 0u; }
    __syncthreads();
    (void)xcd_barrier_post((unsigned)wv, (unsigned*)(prm.ws + WS_BAR), xb_st);
#define XBAR_NOW() XcdBarrier{(unsigned)wv, (unsigned*)(ka_ws(kargs()) + WS_BAR), xb_xcc_id(), (volatile LAS unsigned*)((LAS unsigned char*)lds_raw + LDS_BYTES - 32)}
#define GSYNC(k) do { if (lo <= (k) && (k) + 1 < hi) { const XcdBarrier xb_ = XBAR_NOW(); xcd_barrier(xb_); } } while (0)
    if (lo < -1000) { asm volatile("s_waitcnt vmcnt(0)" ::: "memory"); __builtin_amdgcn_fence(__ATOMIC_RELEASE, FSCOPE); grid.sync(); __builtin_amdgcn_fence(__ATOMIC_ACQUIRE, FSCOPE); }
#endif
#ifndef SEGMASK
#define SEGMASK 0x3ffff
#endif
#ifndef REP_G1
#define REP_G1 1
#endif
#ifndef STAG1
#define STAG1 0
#endif
#ifndef REP_G3
#define REP_G3 1
#endif
#ifndef REP_NOOP
#define REP_NOOP 0
#endif
#ifndef REP_G4
#define REP_G4 1
#endif
#ifndef REP_G5
#define REP_G5 1
#endif
#ifndef REP_P0
#define REP_P0 1
#endif
#define SEG(k) if (((SEGMASK >> (k)) & 1) && lo <= (k) && (k) < hi)

    SEG(0) { const Ctx C = fresh_ctx(lds, wv); for (int rep = 0; rep < REP_P0; ++rep) { p0_prep(C); __syncthreads(); } }
    GSYNC(0);
#define MAKE_P2PTRS() const Ctx C = fresh_ctx(lds, wv); const kaptr_t ka = kargs(); unsigned char* ws = ka_ws(ka); unsigned char* sl = ws + WS_SLAB; \
                P2Ptrs P{(bf16_t*)(sl + SL_YB), (bf16_t*)(sl + SL_XBC), (bf16_t*)(ka_out(ka) + (size_t)TS * 1024), (bf16_t*)(ws + WS_KB), (bf16_t*)(ws + WS_VT), (bf16_t*)(ws + WS_WSP), \
                         (float*)(ws + WS_DT), (float*)(ws + WS_VSS), (float*)(ws + WS_SSS), \
                         (bf16_t*)(ws + WS_H) + (size_t)slab * TS * 1024, (bf16_t*)(ka_out(ka) + (size_t)TS * 1024) + (size_t)TS * 1024, (float*)(ws + WS_CTL + 8192), \
                         ka_in(ka, I_CONV_W), ka_in(ka, I_CONV_B), ka_in(ka, I_A_LOG), ka_in(ka, I_D_SKIP), ka_in(ka, I_SSD_NORM), ka_in(ka, I_GMLP_NORM), ka_in(ka, I_B_SPATIAL), slab * TS, slab}
    {
        constexpr int slab = 0;
        const int sb = 1 + 5 * slab;
        SEG(sb) {
            if (slab > 0) {
                const Ctx C = fresh_ctx(lds, wv); const kaptr_t ka = kargs(); unsigned char* ws = ka_ws(ka);
                const int ps = slab - 1;
                pg8::Gemm g{(bf16_t*)(ws + WS_H) + (size_t)ps * TS * 1024, (bf16_t*)(ws + WS_WO), 0, 0, 1024};
                SchedTile256 S{C.G, C.bid};
                EpiOut E{ka_in(ka, I_X), ka_out(ka), ws, ka_in(ka, I_LN_FFN), ps * TS};
                for (int rep = 0; rep < REP_G4; ++rep) pg8::gemm_phase<EpiOut, SchedTile256>(C.lds, g, S, E, nullptr, wv);
            }
            if (slab < 2) {
                const Ctx C = fresh_ctx(lds, wv); const kaptr_t ka = kargs(); unsigned char* ws = ka_ws(ka);
                pg8::Gemm g{(bf16_t*)(ws + WS_H), (bf16_t*)(ws + WS_WINKV), 0, 0, 1024};
                SchedInProj S{slab, C.G, C.bid};
                EpiInProj E{ws, (bf16_t*)(ka_out(ka) + (size_t)TS * 1024), ka_in(ka, I_DT_BIAS), slab * TS};
                for (int sl_ = 0; sl_ < STAG1 * ((C.bid >> 5) & 1); ++sl_) __builtin_amdgcn_s_sleep(127);
                for (int rep = 0; rep < REP_G1; ++rep) pg8::gemm_phase<EpiInProj, SchedInProj>(C.lds, g, S, E, nullptr, wv);
            }
        }
        GSYNC(sb);
        if (slab < 2) {
            SEG(sb + 1) { MAKE_P2PTRS(); p2_mixers(C, P, (unsigned*)(ws + WS_CTL) + slab); }
            GSYNC(sb + 1);
            SEG(sb + 2) { MAKE_P2PTRS(); p2_scan(C, P); }
            GSYNC(sb + 2);
            SEG(sb + 3) { MAKE_P2PTRS(); p2_pass_c(C, P); }
            GSYNC(sb + 3);
            SEG(sb + 4) {
                const Ctx C = fresh_ctx(lds, wv); const kaptr_t ka = kargs(); unsigned char* ws = ka_ws(ka); unsigned char* sl = ws + WS_SLAB;
                pg8::Gemm g{(bf16_t*)(sl + SL_YB), (bf16_t*)(ws + WS_WB), 0, 0, 1024};
                SchedBranch S{C.G, C.bid};
                EpiBranch E{ws, slab * TS, 0};
#ifndef STAG3
#define STAG3 0
#endif
                for (int sl_ = 0; sl_ < STAG3 * ((C.bid >> 3) & 3); ++sl_) __builtin_amdgcn_s_sleep(127);
                for (int rep = 0; rep < REP_G3; ++rep) { E.noop = (rep > 0) ? REP_NOOP : 0; pg8::gemm_phase<EpiBranch, SchedBranch>(C.lds, g, S, E, nullptr, wv); }
            }
            GSYNC(sb + 4);
        }
    }
    {
        constexpr int slab = 1;
        const int sb = 1 + 5 * slab;
        SEG(sb) {
            if (slab > 0) {
                const Ctx C = fresh_ctx(lds, wv); const kaptr_t ka = kargs(); unsigned char* ws = ka_ws(ka);
                const int ps = slab - 1;
                pg8::Gemm g{(bf16_t*)(ws + WS_H) + (size_t)ps * TS * 1024, (bf16_t*)(ws + WS_WO), 0, 0, 1024};
                SchedTile256 S{C.G, C.bid};
                EpiOut E{ka_in(ka, I_X), ka_out(ka), ws, ka_in(ka, I_LN_FFN), ps * TS};
                for (int rep = 0; rep < REP_G4; ++rep) pg8::gemm_phase<EpiOut, SchedTile256>(C.lds, g, S, E, nullptr, wv);
            }
            if (slab < 2) {
                const Ctx C = fresh_ctx(lds, wv); const kaptr_t ka = kargs(); unsigned char* ws = ka_ws(ka);
                pg8::Gemm g{(bf16_t*)(ws + WS_H), (bf16_t*)(ws + WS_WINKV), 0, 0, 1024};
                SchedInProj S{slab, C.G, C.bid};
                EpiInProj E{ws, (bf16_t*)(ka_out(ka) + (size_t)TS * 1024), ka_in(ka, I_DT_BIAS), slab * TS};
                for (int sl_ = 0; sl_ < STAG1 * ((C.bid >> 5) & 1); ++sl_) __builtin_amdgcn_s_sleep(127);
                for (int rep = 0; rep < REP_G1; ++rep) pg8::gemm_phase<EpiInProj, SchedInProj>(C.lds, g, S, E, nullptr, wv);
            }
        }
        GSYNC(sb);
        if (slab < 2) {
            SEG(sb + 1) { MAKE_P2PTRS(); p2_mixers(C, P, (unsigned*)(ws + WS_CTL) + slab); }
            GSYNC(sb + 1);
            SEG(sb + 2) { MAKE_P2PTRS(); p2_scan(C, P); }
            GSYNC(sb + 2);
            SEG(sb + 3) { MAKE_P2PTRS(); p2_pass_c(C, P); }
            GSYNC(sb + 3);
            SEG(sb + 4) {
                const Ctx C = fresh_ctx(lds, wv); const kaptr_t ka = kargs(); unsigned char* ws = ka_ws(ka); unsigned char* sl = ws + WS_SLAB;
                pg8::Gemm g{(bf16_t*)(sl + SL_YB), (bf16_t*)(ws + WS_WB), 0, 0, 1024};
                SchedBranch S{C.G, C.bid};
                EpiBranch E{ws, slab * TS, 0};
#ifndef STAG3
#define STAG3 0
#endif
                for (int sl_ = 0; sl_ < STAG3 * ((C.bid >> 3) & 3); ++sl_) __builtin_amdgcn_s_sleep(127);
                for (int rep = 0; rep < REP_G3; ++rep) { E.noop = (rep > 0) ? REP_NOOP : 0; pg8::gemm_phase<EpiBranch, SchedBranch>(C.lds, g, S, E, nullptr, wv); }
            }
            GSYNC(sb + 4);
        }
    }
    {
        constexpr int slab = 2;
        const int sb = 1 + 5 * slab;
        SEG(sb) {
            if (slab > 0) {
                const Ctx C = fresh_ctx(lds, wv); const kaptr_t ka = kargs(); unsigned char* ws = ka_ws(ka);
                const int ps = slab - 1;
                pg8::Gemm g{(bf16_t*)(ws + WS_H) + (size_t)ps * TS * 1024, (bf16_t*)(ws + WS_WO), 0, 0, 1024};
                SchedTile256 S{C.G, C.bid};
                EpiOut E{ka_in(ka, I_X), ka_out(ka), ws, ka_in(ka, I_LN_FFN), ps * TS};
                for (int rep = 0; rep < REP_G4; ++rep) pg8::gemm_phase<EpiOut, SchedTile256>(C.lds, g, S, E, nullptr, wv);
            }
            if (slab < 2) {
                const Ctx C = fresh_ctx(lds, wv); const kaptr_t ka = kargs(); unsigned char* ws = ka_ws(ka);
                pg8::Gemm g{(bf16_t*)(ws + WS_H), (bf16_t*)(ws + WS_WINKV), 0, 0, 1024};
                SchedInProj S{slab, C.G, C.bid};
                EpiInProj E{ws, (bf16_t*)(ka_out(ka) + (size_t)TS * 1024), ka_in(ka, I_DT_BIAS), slab * TS};
                for (int sl_ = 0; sl_ < STAG1 * ((C.bid >> 5) & 1); ++sl_) __builtin_amdgcn_s_sleep(127);
                for (int rep = 0; rep < REP_G1; ++rep) pg8::gemm_phase<EpiInProj, SchedInProj>(C.lds, g, S, E, nullptr, wv);
            }
        }
        GSYNC(sb);
        if (slab < 2) {
            SEG(sb + 1) { MAKE_P2PTRS(); p2_mixers(C, P, (unsigned*)(ws + WS_CTL) + slab); }
            GSYNC(sb + 1);
            SEG(sb + 2) { MAKE_P2PTRS(); p2_scan(C, P); }
            GSYNC(sb + 2);
            SEG(sb + 3) { MAKE_P2PTRS(); p2_pass_c(C, P); }
            GSYNC(sb + 3);
            SEG(sb + 4) {
                const Ctx C = fresh_ctx(lds, wv); const kaptr_t ka = kargs(); unsigned char* ws = ka_ws(ka); unsigned char* sl = ws + WS_SLAB;
                pg8::Gemm g{(bf16_t*)(sl + SL_YB), (bf16_t*)(ws + WS_WB), 0, 0, 1024};
                SchedBranch S{C.G, C.bid};
                EpiBranch E{ws, slab * TS, 0};
#ifndef STAG3
#define STAG3 0
#endif
                for (int sl_ = 0; sl_ < STAG3 * ((C.bid >> 3) & 3); ++sl_) __builtin_amdgcn_s_sleep(127);
                for (int rep = 0; rep < REP_G3; ++rep) { E.noop = (rep > 0) ? REP_NOOP : 0; pg8::gemm_phase<EpiBranch, SchedBranch>(C.lds, g, S, E, nullptr, wv); }
            }
            GSYNC(sb + 4);
        }
    }
    SEG(12) {
        const Ctx C = fresh_ctx(lds, wv); const kaptr_t ka = kargs(); unsigned char* ws = ka_ws(ka);
        pg8::Gemm g{(bf16_t*)ka_out(ka), (bf16_t*)(ws + WS_WQ), 0, 0, 1024};
        SchedStatic S{128, 8, 1024, C.G, C.bid};
        EpiQ E{ws};
        for (int rep = 0; rep < REP_G5; ++rep) pg8::gemm_phase<EpiQ, SchedStatic>(C.lds, g, S, E, nullptr, wv);
    }
    GSYNC(12);
#define MAKE_P67() const Ctx C = fresh_ctx(lds, wv); const kaptr_t ka = kargs(); unsigned char* ws = ka_ws(ka); \
        P67Ptrs P{(bf16_t*)(ws + WS_Q2), (bf16_t*)(ws + WS_KEYS), (bf16_t*)(ws + WS_XB), ws + WS_PU, ws + WS_PV, (float*)(ws + WS_SU), (float*)(ws + WS_SV), \
                  (unsigned short*)(ws + WS_EID), (float*)(ws + WS_GATE), (float*)(ws + WS_XSS), ka_out(ka), ka_in(ka, I_LN_FINAL), (float*)(ws + WS_PD), (bf16_t*)(ws + WS_PW), (float*)(ws + WS_SS3), (unsigned*)(ws + WS_CTL)}
    SEG(13) { MAKE_P67(); for (int tile = C.bid; tile < 256; tile += C.G) { p67_tile(C, P, tile); __syncthreads(); } }
    GSYNC(13);
    SEG(14) { MAKE_P67(); sliced_items(C, P.q + 128, [&](int x, int it) { peer_u_item(C, P, x, it); }); }
    GSYNC(14);
    SEG(15) { MAKE_P67(); peer_w_phase(C, P); }
    GSYNC(15);
    SEG(16) { MAKE_P67(); sliced_items(C, P.q + 256, [&](int x, int it) { peer_v_item(C, P, x, it); }); }
    GSYNC(16);
    SEG(17) { MAKE_P67(); peer_final_phase(C, P); }
#ifdef DBG_STOP
    {
        asm volatile("s_waitcnt vmcnt(0)" ::: "memory"); __builtin_amdgcn_fence(__ATOMIC_RELEASE, FSCOPE); asm volatile("s_waitcnt vmcnt(0)" ::: "memory");
        grid.sync(); __builtin_amdgcn_fence(__ATOMIC_ACQUIRE, FSCOPE); asm volatile("s_waitcnt vmcnt(0)" ::: "memory");
        const kaptr_t ka = kargs(); unsigned char* ws = ka_ws(ka); float* out = ka_out(ka); unsigned char* sl = ws + WS_SLAB;
        const size_t n = (size_t)TS * 1024;
        const bf16_t* YB = (const bf16_t*)(sl + SL_YB); const bf16_t* XBC = (const bf16_t*)(sl + SL_XBC); const bf16_t* SG = (const bf16_t*)(sl + SL_SG);
        const bf16_t* KB = (const bf16_t*)(ws + WS_KB); const bf16_t* VT = (const bf16_t*)(ws + WS_VT); const bf16_t* MB = (const bf16_t*)(ws + WS_H); const bf16_t* XB = (const bf16_t*)(ws + WS_XB);
        const float* DT = (const float*)(ws + WS_DT); const float* VSS = (const float*)(ws + WS_VSS); const float* SSS = (const float*)(ws + WS_SSS); const float* XSS = (const float*)(ws + WS_XSS);
        float cnt_val = 0.f;
#ifdef CNT_TEST
        { const unsigned* q = (const unsigned*)(ws + WS_CTL) + 64; int bad = 0; for (int k = 0; k < 1664; ++k) bad += (q[k] != 1u) ? 1 : 0; cnt_val = 1.f + (float)bad; }
#endif
        for (size_t i = (size_t)blockIdx.x * NTHR + threadIdx.x; i < n; i += (size_t)gridDim.x * NTHR) {
            float v = 0.f;
#define BFV(p, idx) __uint_as_float(((unsigned)(p)[idx]) << 16)
#ifndef DUMPMASK
#define DUMPMASK 7
#endif
#ifdef XCOPY
            if (DUMPMASK & 16) v += BFV(XBC, i);
#endif
            if (DUMPMASK & 32) v += BFV(VT, i % ((size_t)2048 * 1024));
            if (DUMPMASK & 64) v += BFV(KB, i % ((size_t)2048 * 1024));
            if (DBG_STOP <= 3) { if (DUMPMASK & 1) v += BFV(YB, i); if (DUMPMASK & 2) v += BFV(YB, i + n); if (DUMPMASK & 4) v += BFV(YB, i + 2 * n); }
            if (DBG_STOP <= 2 && !(DUMPMASK & 8)) { v += BFV(XBC, i) + BFV(XBC, i + n / 2) + BFV(SG, i) + BFV(SG, i + n) + BFV(SG, i + 2 * n) + BFV(KB, i % ((size_t)2048 * 1024)) + BFV(VT, i % ((size_t)2048 * 1024))
                                     + DT[i % ((size_t)TS * 16)] + 1e-3f * VSS[i % ((size_t)TS * 16)]; }
            if (DBG_STOP == 2 && !(DUMPMASK & 8)) v += 1e-3f * SSS[i % ((size_t)TS * 16)];
            if (DBG_STOP == 3) v += BFV(MB, i);
            if (DBG_STOP >= 4) v = out[i] + BFV(XB, i) + 1e-3f * XSS[i % ((size_t)TS * 16)];
#ifdef CNT_TEST
            v = cnt_val; out[i + n] = v;
#endif
            out[i] = v;
        }
    }
#endif
}

extern "C" void kernel_launch(void* const* d_in, const int* in_sizes, int n_in, void* d_out, int out_size, void* d_ws, size_t ws_size, hipStream_t stream) {
    static int grid_blocks = 0;
    if (grid_blocks == 0) {
        if (n_in != 23 || out_size != T_ALL * DM || ws_size < WS_END) { fprintf(stderr, "kernel_launch: unexpected problem (n_in %d out %d ws %zu, need %zu)\n", n_in, out_size, ws_size, (size_t)WS_END); grid_blocks = -1; return; }
        int dev = 0, cus = 0, per_cu = 0;
        (void)hipGetDevice(&dev);
        (void)hipDeviceGetAttribute(&cus, hipDeviceAttributeMultiprocessorCount, dev);
        (void)hipFuncSetAttribute((const void*)fwd_megakernel, hipFuncAttributeMaxDynamicSharedMemorySize, LDS_BYTES);
        (void)hipOccupancyMaxActiveBlocksPerMultiprocessor(&per_cu, fwd_megakernel, NTHR, LDS_BYTES);
        if (per_cu < 1) { fprintf(stderr, "kernel_launch: occupancy query says 0 blocks per CU\n"); per_cu = 1; }
        grid_blocks = cus;
    }
    if (grid_blocks < 0) return;
    (void)hipMemsetAsync((unsigned char*)d_ws + WS_BAR, 0, 16384, stream);
    Params p{};
    for (int i = 0; i < 23; ++i) p.in[i] = (const float*)d_in[i];
    p.out = (float*)d_out; p.ws = (unsigned char*)d_ws;
#if MK_MULTI
    for (int s = 0; s < NSEG; ++s) { p.seg_lo = s; p.seg_hi = s + 1; hipLaunchKernelGGL(fwd_megakernel, dim3(grid_blocks), dim3(NTHR), LDS_BYTES, stream, p); }
#else
#ifdef DBG_STOP
    p.seg_lo = 0; p.seg_hi = DBG_STOP + 1;
#else
    p.seg_lo = 0; p.seg_hi = NSEG;
#endif
    void* args[] = {&p};
    hipError_t e = hipLaunchCooperativeKernel((void*)fwd_megakernel, dim3(grid_blocks), dim3(NTHR), args, LDS_BYTES, stream);
    if (e != hipSuccess) fprintf(stderr, "cooperative launch failed: %s (grid %d)\n", hipGetErrorString(e), grid_blocks);
#endif
}
```

```cpp
#include <hip/hip_runtime.h>
#include <hip/hip_cooperative_groups.h>
#include <cstdio>
#include <cstdint>
namespace cg = cooperative_groups;
namespace pg8 {
#define PG8_LAS __attribute__((address_space(3)))
typedef unsigned short bf16_t;
typedef short bf16x8 __attribute__((ext_vector_type(8)));
typedef float f32x4 __attribute__((ext_vector_type(4)));
typedef unsigned u32x4 __attribute__((ext_vector_type(4)));
constexpr int BM = 256, BK = 64, HALF = 128, HTB = HALF * BK * 2  , STAGE_BYTES = 8 * HTB, NXCD = 8, WGM = 8;

__host__ __device__ __forceinline__ int lds_byte(int r, int c) { const int st = (r >> 4) * 2 + (c >> 5), rr = r & 15, cc = c & 31, ob = rr * 64 + cc * 2; return st * 1024 + (ob ^ (((ob >> 9) & 1) << 5)); }
__host__ __device__ __forceinline__ void stage_rc(int b, int& R, int& C) { const int st = b / 1024, sb = b % 1024, swz = sb ^ (((sb >> 9) & 1) << 5); R = (st >> 1) * 16 + swz / 64; C = (st & 1) * 32 + (swz % 64) / 2; }
__host__ __device__ __forceinline__ int perm32(int rho) { const int n = rho >> 4, i = rho & 15; return 8 * (i >> 2) + 4 * n + (i & 3); }

struct Unit { int pm, pn; };
struct Gemm { const bf16_t* A; const bf16_t* Bt; int M, N, K; };

template <class Epi, class Sched, bool STAMP = false>
__device__ __forceinline__ void gemm_phase(PG8_LAS unsigned char* lds, const Gemm g, const Sched& S, const Epi& E, unsigned long long* stamps, int wave_s) {
    int tid_ = (wave_s << 6) | (int)__builtin_amdgcn_mbcnt_hi(~0u, __builtin_amdgcn_mbcnt_lo(~0u, 0u)); asm volatile("" : "+v"(tid_)); const int tid = tid_, wid = __builtin_amdgcn_readfirstlane(tid >> 6), lane = tid & 63, wr = wid >> 2, wc = wid & 3, fr = lane & 15, fq = lane >> 4;
    const int K = g.K, nt = K / BK;
    int ts_lo = 0, ts_hi = 0, nts = 0; const unsigned long long rt_entry = STAMP ? (unsigned long long)wall_clock64() : 0ull;
#define PG8_STAMP() do { if (STAMP && wid == 0 && nts < 64) { const unsigned long long _c = (unsigned long long)clock64(); \
        ts_lo = (lane == nts) ? (int)(unsigned)_c : ts_lo; ts_hi = (lane == nts) ? (int)(unsigned)(_c >> 32) : ts_hi; ++nts; } } while (0)
    PG8_STAMP();
    unsigned voffA[2], voffB[2];
#pragma unroll
    for (int i = 0; i < 2; ++i) { int R, C; stage_rc(tid * 16 + i * 8192, R, C); const int Rb = Epi::PERM ? ((R & ~31) + perm32(R & 31)) : R;
        voffA[i] = (unsigned)(R * K + C) * 2u; voffB[i] = (unsigned)(Rb * K + C) * 2u; }
    const size_t kstep = (size_t)(BK * 2);
    const size_t hstep = (size_t)HALF * K * 2;
    const size_t tstep = 2 * hstep;
    const unsigned ldsw = (unsigned)wid * 1024u;
    const int aoff = lds_byte(wr * 64 + fr, fq * 8), boff = lds_byte(wc * 32 + fr, fq * 8);
#define PG8_SA(b, h) (((b) * 2 + (h)) * HTB)
#define PG8_SB(b, h) ((4 + (b) * 2 + (h)) * HTB)
#define PG8_STAGE(bufoff, gbase, voff) do { _Pragma("unroll") for (int _i = 0; _i < 2; ++_i) \
        __builtin_amdgcn_global_load_lds((const unsigned*)((const char*)(gbase) + (voff)[_i]), (PG8_LAS unsigned*)(lds + (bufoff) + ldsw + _i * 8192), 16, 0, 0); } while (0)
#define PG8_LDA(dst, b, h) do { _Pragma("unroll") for (int m = 0; m < 4; ++m) _Pragma("unroll") for (int k = 0; k < 2; ++k) dst[m][k] = *(const PG8_LAS bf16x8*)(lds + PG8_SA(b, h) + aoff + m * 2048 + k * 1024); } while (0)
#define PG8_LDB(dst, b, h) do { _Pragma("unroll") for (int n = 0; n < 2; ++n) _Pragma("unroll") for (int k = 0; k < 2; ++k) dst[n][k] = *(const PG8_LAS bf16x8*)(lds + PG8_SB(b, h) + boff + n * 2048 + k * 1024); } while (0)
#define PG8_MMA(ai, bj, At, Bt) do { __builtin_amdgcn_s_setprio(1); _Pragma("unroll") for (int m = 0; m < 4; ++m) _Pragma("unroll") for (int n = 0; n < 2; ++n) _Pragma("unroll") for (int k = 0; k < 2; ++k) \
        acc[ai][bj][m][n] = __builtin_amdgcn_mfma_f32_16x16x32_bf16(Bt[n][k], At[m][k], acc[ai][bj][m][n], 0, 0, 0); __builtin_amdgcn_s_setprio(0); } while (0)
#define PG8_WAIT_V(n) asm volatile("s_waitcnt vmcnt(" #n ")" ::: "memory")
#define PG8_WAIT_L(n) asm volatile("s_waitcnt lgkmcnt(" #n ")" ::: "memory")
#define PG8_BAR __builtin_amdgcn_s_barrier()
#define PG8_SCHED __builtin_amdgcn_sched_barrier(0)
    Unit cur, nxt; int ui = 0;
    if (!S.next(0, cur)) return;
    f32x4 acc[2][2][4][2];
#pragma unroll
    for (int a = 0; a < 2; ++a)
#pragma unroll
        for (int b = 0; b < 2; ++b)
#pragma unroll
            for (int m = 0; m < 4; ++m)
#pragma unroll
                for (int n = 0; n < 2; ++n) acc[a][b][m][n] = (f32x4){0.f, 0.f, 0.f, 0.f};
    bf16x8 At[4][2], B0[2][2], B1[2][2];
    const char* cA = (const char*)g.A + (size_t)cur.pm * tstep; const char* cB = (const char*)g.Bt + (size_t)cur.pn * tstep;
    S.a_ready(cur);
    PG8_STAGE(PG8_SB(0, 0), cB, voffB); PG8_STAGE(PG8_SA(0, 0), cA, voffA); PG8_STAGE(PG8_SB(0, 1), cB + hstep, voffB); PG8_STAGE(PG8_SA(0, 1), cA + hstep, voffA);
    if (wr == 1) PG8_BAR;
    PG8_WAIT_V(4); PG8_BAR;
    PG8_STAGE(PG8_SB(1, 0), cB + kstep, voffB); PG8_STAGE(PG8_SA(1, 0), cA + kstep, voffA); PG8_STAGE(PG8_SB(1, 1), cB + hstep + kstep, voffB);
    PG8_WAIT_V(6); PG8_BAR;
    PG8_STAMP();
    for (;;) {
        const bool has_next = S.next(ui + 1, nxt);
        const char* nA = has_next ? (const char*)g.A + (size_t)nxt.pm * tstep : cA; const char* nB = has_next ? (const char*)g.Bt + (size_t)nxt.pn * tstep : cB;
        for (int t = 0; t < nt; t += 2) {
            const bool last = (t == nt - 2);
            const char* a1 = cA + (size_t)(t + 1) * kstep;
            const char* a2 = last ? nA : cA + (size_t)(t + 2) * kstep; const char* b2 = last ? nB : cB + (size_t)(t + 2) * kstep;
            const char* a3 = a2 + kstep; const char* b3 = b2 + kstep;
            if (last && has_next) S.a_ready(nxt);
            PG8_LDB(B0, 0, 0); PG8_SCHED; PG8_LDA(At, 0, 0); PG8_STAGE(PG8_SA(1, 1), a1 + hstep, voffA);
            PG8_WAIT_L(8); PG8_BAR; PG8_WAIT_L(0); PG8_MMA(0, 0, At, B0); PG8_BAR; PG8_SCHED;
            PG8_LDB(B1, 0, 1); PG8_STAGE(PG8_SB(0, 0), b2, voffB);
            PG8_BAR; PG8_WAIT_L(0); PG8_MMA(0, 1, At, B1); PG8_BAR;
            PG8_LDA(At, 0, 1); PG8_STAGE(PG8_SA(0, 0), a2, voffA);
            PG8_BAR; PG8_WAIT_L(0); PG8_MMA(1, 0, At, B0); PG8_BAR; PG8_SCHED;
            PG8_STAGE(PG8_SB(0, 1), b2 + hstep, voffB);
            PG8_WAIT_V(6); PG8_BAR; PG8_MMA(1, 1, At, B1); PG8_BAR;
            PG8_LDB(B0, 1, 0); PG8_SCHED; PG8_LDA(At, 1, 0); PG8_STAGE(PG8_SA(0, 1), a2 + hstep, voffA);
            PG8_WAIT_L(8); PG8_BAR; PG8_WAIT_L(0); PG8_MMA(0, 0, At, B0); PG8_BAR; PG8_SCHED;
            PG8_LDB(B1, 1, 1); PG8_STAGE(PG8_SB(1, 0), b3, voffB);
            PG8_BAR; PG8_WAIT_L(0); PG8_MMA(0, 1, At, B1); PG8_BAR;
            PG8_LDA(At, 1, 1); PG8_STAGE(PG8_SA(1, 0), a3, voffA);
            PG8_BAR; PG8_WAIT_L(0); PG8_MMA(1, 0, At, B0); PG8_BAR; PG8_SCHED;
            PG8_STAGE(PG8_SB(1, 1), b3 + hstep, voffB);
            PG8_WAIT_V(6); PG8_BAR; PG8_MMA(1, 1, At, B1); PG8_BAR;
        }
        PG8_STAMP();
        if constexpr (!Epi::AFTER_DRAIN) { if constexpr (Epi::WANTS_SCRATCH) E(acc, cur, wr, wc, fr, fq, At, B0, B1); else E(acc, cur, wr, wc, fr, fq); S.done(cur); }
        PG8_STAMP();
        if (!has_next) break;
        if constexpr (!Epi::MUT_ACC)
#pragma unroll
        for (int a = 0; a < 2; ++a)
#pragma unroll
            for (int b = 0; b < 2; ++b)
#pragma unroll
                for (int m = 0; m < 4; ++m)
#pragma unroll
                    for (int n = 0; n < 2; ++n) acc[a][b][m][n] = (f32x4){0.f, 0.f, 0.f, 0.f};
        cur = nxt; cA = nA; cB = nB; ++ui;
    }
    PG8_WAIT_V(0);
    if (wr == 0) PG8_BAR;
    PG8_BAR;
    if constexpr (Epi::AFTER_DRAIN) { E.fused(acc, cur, wr, wc, fr, fq, lds, wid, lane); S.done(cur); }
    PG8_STAMP();
    if (STAMP && wid == 0) { stamps[lane] = lane < nts ? (((unsigned long long)(unsigned)ts_hi << 32) | (unsigned)ts_lo) : 0ull;
        if (lane == 62) stamps[62] = rt_entry; if (lane == 63) stamps[63] = (unsigned long long)wall_clock64(); }
#undef PG8_STAMP
#undef PG8_SA
#undef PG8_SB
#undef PG8_STAGE
#undef PG8_LDA
#undef PG8_LDB
#undef PG8_MMA
#undef PG8_WAIT_V
#undef PG8_WAIT_L
#undef PG8_BAR
#undef PG8_SCHED
}
}

#define LAS __attribute__((address_space(3)))
#ifndef FSCOPE
#define FSCOPE "agent"
#endif
typedef pg8::bf16_t bf16_t;
typedef pg8::bf16x8 bf16x8;
typedef pg8::f32x4 f32x4;
typedef pg8::u32x4 u32x4;
typedef unsigned u32x2 __attribute__((ext_vector_type(2)));

constexpr int T_ALL = 32768, DM = 1024, TS = 16384, SEQ = 2048, NSLAB = 2;
constexpr int IN_DIM = 8720;
constexpr float EPS = 1e-6f;
constexpr int LDS_BYTES = 160 * 1024;
constexpr int NTHR = 512;

constexpr size_t al256(size_t x) { return (x + 255) & ~(size_t)255; }
constexpr size_t WS_CTL   = 0;
constexpr size_t WS_BAR   = 16384;
constexpr size_t WS_WINKV = 32768;
constexpr size_t WS_WB    = WS_WINKV + (size_t)11008 * 1024 * 2;
constexpr size_t WS_WO    = WS_WB + (size_t)3 * 1024 * 1024 * 2;
constexpr size_t WS_WQ    = WS_WO + (size_t)1024 * 1024 * 2;
constexpr size_t WS_KEYS  = WS_WQ + (size_t)2048 * 1024 * 2;
constexpr size_t WS_WSP   = WS_KEYS + (size_t)8 * 2 * 128 * 128 * 2;
constexpr size_t WS_PU    = WS_WSP + (size_t)8 * 128 * 128 * 2;
constexpr size_t WS_PV    = WS_PU + (size_t)16384 * 1024;
constexpr size_t WS_SU    = WS_PV + (size_t)16384 * 1024;
constexpr size_t WS_SV    = WS_SU + (size_t)16384 * 4;
constexpr size_t WS_KB    = WS_SV + (size_t)16384 * 4;
constexpr size_t WS_VT    = WS_KB + (size_t)4096 * 1024 * 2;
constexpr size_t WS_XB    = WS_VT + (size_t)4096 * 1024 * 2;
constexpr size_t WS_VSS   = WS_XB + (size_t)T_ALL * 1024 * 2;
constexpr size_t WS_SSS   = WS_VSS + (size_t)T_ALL * 16 * 4;
constexpr size_t WS_XSS   = WS_SSS + (size_t)T_ALL * 16 * 4;
constexpr size_t WS_DT    = WS_XSS + (size_t)T_ALL * 16 * 4;
constexpr size_t WS_H     = WS_DT + (size_t)T_ALL * 16 * 4;
constexpr size_t WS_SLAB  = WS_H + (size_t)(T_ALL + 4096) * 1024 * 2;
constexpr size_t SL_YB    = 0;
constexpr size_t SL_XBC   = SL_YB + (size_t)3 * TS * 1024 * 2;
constexpr size_t SL_SG    = SL_XBC + (size_t)TS * 1536 * 2;
constexpr size_t SL_END   = SL_SG + (size_t)TS * 3072 * 2;
constexpr size_t WS_Q2    = WS_SLAB;
constexpr size_t WS_EID   = WS_Q2 + (size_t)T_ALL * 2048 * 2;
constexpr size_t WS_GATE  = WS_EID + (size_t)T_ALL * 128 * 4;
constexpr size_t WS_PD    = WS_Q2;
constexpr size_t WS_PW    = WS_GATE + (size_t)T_ALL * 128 * 4;
constexpr size_t WS_SS3   = WS_PW + (size_t)T_ALL * 128 * 4;
constexpr size_t WS_PEND  = WS_SS3 + (size_t)T_ALL * 8 * 4;
constexpr size_t WS_END   = (WS_SLAB + SL_END) > WS_PEND ? (WS_SLAB + SL_END) : WS_PEND;
static_assert((size_t)8 * T_ALL * 128 * 4 <= (size_t)T_ALL * 2048 * 2, "partial dots must fit over Q2");
static_assert(WS_END <= (size_t)512 * 1024 * 1024, "workspace map exceeds 512 MiB");

struct Params { const float* in[23]; float* out; unsigned char* ws; int seg_lo, seg_hi; };
static_assert(sizeof(Params) == 25 * 8 + 8, "Params has padding");

enum { I_X = 0, I_MEM, I_LN_MIX, I_W_IN, I_CONV_W, I_CONV_B, I_DT_BIAS, I_A_LOG, I_D_SKIP, I_SSD_NORM, I_GMLP_NORM, I_W_SPATIAL, I_B_SPATIAL, I_LN_MEM,
       I_W_MEM_KV, I_W_BRANCH, I_W_OUT, I_LN_FFN, I_W_PEER_Q, I_PEER_KEYS, I_PEER_U, I_PEER_V, I_LN_FINAL };

typedef float f32x2_t __attribute__((ext_vector_type(2)));
typedef short s16x4 __attribute__((ext_vector_type(4)));
typedef short s16x8 __attribute__((ext_vector_type(8)));
typedef float f2v __attribute__((ext_vector_type(2)));
typedef __bf16 bf16x2_t __attribute__((ext_vector_type(2)));
__device__ __forceinline__ unsigned pk2(float lo, float hi) { const f32x2_t v = {lo, hi}; const bf16x2_t r = __builtin_convertvector(v, bf16x2_t); return __builtin_bit_cast(unsigned, r); }
__device__ __forceinline__ float bf_lo(unsigned w) { return __uint_as_float(w << 16); }
__device__ __forceinline__ float bf_hi(unsigned w) { return __uint_as_float(w & 0xffff0000u); }
__device__ __forceinline__ float sigmoid_f(float x) { return __builtin_amdgcn_rcpf(1.f + __expf(-x)); }
__device__ __forceinline__ float silu_f(float x) { return x * sigmoid_f(x); }
__device__ __forceinline__ float gelu_f(float x) { const float y = 1.5957691216f * (x + 0.044715f * x * x * x); return x * sigmoid_f(y); }
__device__ __forceinline__ f32x4 mfma16(bf16x8 a, bf16x8 b, f32x4 c) { return __builtin_amdgcn_mfma_f32_16x16x32_bf16(a, b, c, 0, 0, 0); }
__device__ __forceinline__ int swz(int row, int chunk) { return row * 256 + ((chunk ^ (row & 7)) << 4); }
__device__ __forceinline__ void lds_wait() { asm volatile("s_waitcnt lgkmcnt(0)" ::: "memory"); }
__device__ __forceinline__ float wave_sum64(float v) {
#pragma unroll
    for (int o = 1; o < 64; o <<= 1) v += __shfl_xor(v, o);
    return v;
}
__device__ __forceinline__ unsigned ord_key(float f) { const unsigned u = __float_as_uint(f); return u ^ ((unsigned)((int)u >> 31) | 0x80000000u); }
__device__ __forceinline__ float unord_key(unsigned k) { const unsigned u = (k & 0x80000000u) ? (k ^ 0x80000000u) : ~k; return __uint_as_float(u); }
__device__ __forceinline__ void ins16(unsigned (&l)[16], unsigned x) {
#pragma unroll
    for (int j = 0; j < 16; ++j) { const unsigned hi = l[j] > x ? l[j] : x; x = l[j] > x ? x : l[j]; l[j] = hi; }
}


#undef LAS
#define XB_TMO      128
#define XB_XCNT(j)  (256  + 64 * (j))
#define XB_XSUB(j)  (1280 + 64 * (j))
#define XB_XGEN(j)  (2304 + 64 * (j))
#define XB_TOP      3328
#define XB_TOPGEN   3392
#define XCD_BAR_WORDS 3456
#define XB_SPIN_CAP (1u << 23)
#define LAS __attribute__((address_space(3)))

__device__ __forceinline__ unsigned xb_ld(unsigned* p)              { return __hip_atomic_load(p, __ATOMIC_RELAXED, __HIP_MEMORY_SCOPE_AGENT); }
__device__ __forceinline__ unsigned xb_add(unsigned* p, unsigned v) { return __hip_atomic_fetch_add(p, v, __ATOMIC_RELAXED, __HIP_MEMORY_SCOPE_AGENT); }
__device__ __forceinline__ unsigned xb_xcc_id() { return (unsigned)__builtin_amdgcn_s_getreg((3 << 11) | 20) & 0xFu; }
#define XB_T0(b) ((b).wv == 0u && __builtin_amdgcn_mbcnt_hi(~0u, __builtin_amdgcn_mbcnt_lo(~0u, 0u)) == 0u)
#define XB_SPIN(cond, bar) do { unsigned _sp = 0; while (cond) { __builtin_amdgcn_s_sleep(1); \
    if ((++_sp & 255u) == 0u) { if (xb_ld(&(bar)[XB_TMO])) break; if (_sp > XB_SPIN_CAP) { atomicAdd(&(bar)[XB_TMO], 1u); break; } } } } while (0)

struct XcdBarrier {
    unsigned wv;
    unsigned* bar; unsigned x;
    volatile LAS unsigned* st;
};

__device__ __forceinline__ XcdBarrier xcd_barrier_post(unsigned wv, unsigned* bar, volatile LAS unsigned* st) {
    XcdBarrier b; b.wv = wv; b.bar = bar; b.x = xb_xcc_id(); b.st = st;
    if (XB_T0(b)) (void)xb_add(&bar[XB_XCNT(b.x)], 1u);
    return b;
}
__device__ __forceinline__ void xcd_barrier_complete(unsigned* bar, unsigned x, unsigned& nloc, unsigned& nx) {
    const unsigned G = gridDim.x * gridDim.y * gridDim.z;
    unsigned sum, cnt, mine, sp = 0u;
    for (;;) {
        sum = 0u; cnt = 0u; mine = 0u;
#pragma unroll
        for (unsigned j = 0; j < 16; ++j) { const unsigned c = xb_ld(&bar[XB_XCNT(j)]); sum += c; cnt += (c > 0u) ? 1u : 0u; mine = (j == x) ? c : mine; }
        if (sum == G) break;
        __builtin_amdgcn_s_sleep(1);
        if ((++sp & 255u) == 0u) { if (xb_ld(&bar[XB_TMO])) break; if (sp > XB_SPIN_CAP) { atomicAdd(&bar[XB_TMO], 1u); break; } }
    }
    nloc = mine > 0u ? mine : 1u; nx = cnt > 0u ? cnt : 1u;
}

__device__ __forceinline__ void xcd_barrier(const XcdBarrier& b) {
    asm volatile("s_waitcnt vmcnt(0)" ::: "memory");
    __syncthreads();
    if (XB_T0(b)) {
        unsigned* bar = b.bar;
        __builtin_amdgcn_s_waitcnt(0);
        unsigned nloc = b.st[0], nx = b.st[1];
        if (nloc == 0u) { xcd_barrier_complete(bar, b.x, nloc, nx); b.st[0] = nloc; b.st[1] = nx; }
        const unsigned old = xb_add(&bar[XB_XSUB(b.x)], 1u);
        const unsigned gen = old / nloc;
        if (old + 1u == (gen + 1u) * nloc) {
            __builtin_amdgcn_fence(__ATOMIC_RELEASE, "agent");
            asm volatile("s_waitcnt vmcnt(0)" ::: "memory");
            const unsigned og = xb_add(&bar[XB_TOP], 1u);
            const unsigned tg = og / nx;
            if (og + 1u == (tg + 1u) * nx) xb_add(&bar[XB_TOPGEN], 1u);
            else XB_SPIN(xb_ld(&bar[XB_TOPGEN]) == tg, bar);
            __builtin_amdgcn_fence(__ATOMIC_ACQUIRE, "agent");
            xb_add(&bar[XB_XGEN(b.x)], 1u);
            asm volatile("s_waitcnt vmcnt(0)" ::: "memory");
        } else {
            XB_SPIN(xb_ld(&bar[XB_XGEN(b.x)]) == gen, bar);
            __builtin_amdgcn_fence(__ATOMIC_ACQUIRE, "agent");
            asm volatile("s_waitcnt vmcnt(0)" ::: "memory");
        }
    }
    __syncthreads();
}

typedef const unsigned char __attribute__((address_space(4)))* kaptr_t;
__device__ __forceinline__ kaptr_t kargs() { kaptr_t ka = (kaptr_t)__builtin_amdgcn_kernarg_segment_ptr(); asm volatile("" : "+s"(ka)); return ka; }
__device__ __forceinline__ const float* ka_in(kaptr_t ka, int i) { return *(const float* const __attribute__((address_space(4)))*)(ka + 8 * i); }
__device__ __forceinline__ float* ka_out(kaptr_t ka) { return *(float* const __attribute__((address_space(4)))*)(ka + 184); }
__device__ __forceinline__ unsigned char* ka_ws(kaptr_t ka) { return *(unsigned char* const __attribute__((address_space(4)))*)(ka + 192); }

__device__ __forceinline__ float sum16(const float* p) {
    const f32x4 a = *(const f32x4*)p, b = *(const f32x4*)(p + 4), c = *(const f32x4*)(p + 8), d = *(const f32x4*)(p + 12);
    return (((a.x + a.y) + (a.z + a.w)) + ((b.x + b.y) + (b.z + b.w))) + (((c.x + c.y) + (c.z + c.w)) + ((d.x + d.y) + (d.z + d.w)));
}
__device__ __forceinline__ void merge16(unsigned (&a)[16], const unsigned (&b)[16]) {
#pragma unroll
    for (int i = 0; i < 16; ++i) a[i] = max(a[i], b[15 - i]);
#pragma unroll
    for (int ls = 3; ls >= 0; --ls)
#pragma unroll
        for (int i = 0; i < 16; ++i) {
            const int st = 1 << ls;
            if ((i & st) == 0) { const unsigned hi = max(a[i], a[i + st]), lo = min(a[i], a[i + st]); a[i] = hi; a[i + st] = lo; }
        }
}
__device__ __forceinline__ void sort16(unsigned (&a)[16]) {
#pragma unroll
    for (int lp = 0; lp < 4; ++lp)
#pragma unroll
        for (int lk = lp; lk >= 0; --lk)
#pragma unroll
            for (int i = 0; i < 16; ++i) {
                const int p = 1 << lp, k = 1 << lk, r = k % p, l = i + k;
                if (l < 16 && i >= r && ((i - r) % (2 * k)) < k && (i / (2 * p)) == (l / (2 * p))) { const unsigned hi = max(a[i], a[l]), lo = min(a[i], a[l]); a[i] = hi; a[l] = lo; }
            }
}
struct Ctx {
    LAS unsigned char* lds;
    int tid, lane, wid, G, bid;
};
__device__ __forceinline__ Ctx fresh_ctx(LAS unsigned char* lds, int wave_s) {
    Ctx C; C.lds = lds;
    int tid = (wave_s << 6) | (int)__builtin_amdgcn_mbcnt_hi(~0u, __builtin_amdgcn_mbcnt_lo(~0u, 0u)); asm volatile("" : "+v"(tid));
    int bid = blockIdx.x; asm volatile("" : "+s"(bid));
    C.tid = tid; C.lane = tid & 63; C.wid = wave_s; C.G = gridDim.x; C.bid = bid;
    return C;
}

template <class MapF>
__device__ __forceinline__ void transpose_item(const float* W, int K, int N, bf16_t* WT, MapF map, LAS float* scr, int item, int lane, const float* krow_scale = nullptr) {
    const int nblk = (N + 31) / 32, kb = item / nblk, nb = item % nblk, k0 = 64 * kb, n0 = 32 * nb;
    const int nl = n0 + (lane & 31);
    float tv[32];
#pragma unroll
    for (int i = 0; i < 32; ++i) { const int kk = 2 * i + (lane >> 5); tv[i] = (nl < N) ? W[(size_t)(k0 + kk) * N + nl] : 0.f; if (krow_scale) tv[i] *= krow_scale[k0 + kk]; }
#pragma unroll
    for (int i = 0; i < 32; ++i) { const int kk = 2 * i + (lane >> 5); scr[kk * 33 + (lane & 31)] = tv[i]; }
    lds_wait();
    const int c = lane & 7;
#pragma unroll
    for (int j = 0; j < 4; ++j) {
        const int n = (lane >> 3) + 8 * j; const LAS float* s = scr + (8 * c) * 33 + n;
        u32x4 o; o.x = pk2(s[0 * 33], s[1 * 33]); o.y = pk2(s[2 * 33], s[3 * 33]); o.z = pk2(s[4 * 33], s[5 * 33]); o.w = pk2(s[6 * 33], s[7 * 33]);
        if (n0 + n < N) *(u32x4*)(WT + (size_t)map(n0 + n) * K + k0 + 8 * c) = o;
    }
    lds_wait();
}
struct MapId { int off; __device__ __forceinline__ int operator()(int n) const { return n + off; } };
struct MapWin { __device__ __forceinline__ int operator()(int n) const { return n < 2560 ? n : (n < 2576 ? 8704 + (n - 2560) : n - 16); } };

__device__ __forceinline__ void rms_row_load(f32x4 (&v)[4], const float* xrow, int lane) {
    const f32x4* xr = (const f32x4*)xrow + lane;
#pragma unroll
    for (int j = 0; j < 4; ++j) v[j] = xr[64 * j];
}
__device__ __forceinline__ void rms_row_finish(const f32x4 (&v)[4], const float* gain, bf16_t* orow, int lane) {
    const f32x4* gr = (const f32x4*)gain + lane; float s = 0.f;
#pragma unroll
    for (int j = 0; j < 4; ++j) s += (v[j].x * v[j].x + v[j].y * v[j].y) + (v[j].z * v[j].z + v[j].w * v[j].w);
    const float rstd = rsqrtf(wave_sum64(s) * (1.f / 1024.f) + EPS);
    u32x2* o8 = (u32x2*)orow + lane;
#pragma unroll
    for (int j = 0; j < 4; ++j) { const f32x4 g = gr[64 * j]; u32x2 w; w.x = pk2(v[j].x * rstd * g.x, v[j].y * rstd * g.y); w.y = pk2(v[j].z * rstd * g.z, v[j].w * rstd * g.w); o8[64 * j] = w; }
}
__device__ __forceinline__ void cvt_row_bf16(const float* src, bf16_t* dst, int lane, bool tril, size_t ebase) {
#pragma unroll
    for (int j = 0; j < 2; ++j) {
        const int e = j * 512 + lane * 8;
        f32x4 a = *(const f32x4*)(src + e), b = *(const f32x4*)(src + e + 4);
        if (tril) { const int t = (int)(((ebase + e) >> 7) & 127), s0 = (int)((ebase + e) & 127);
            a.x = (s0 + 0 <= t) ? a.x : 0.f; a.y = (s0 + 1 <= t) ? a.y : 0.f; a.z = (s0 + 2 <= t) ? a.z : 0.f; a.w = (s0 + 3 <= t) ? a.w : 0.f;
            b.x = (s0 + 4 <= t) ? b.x : 0.f; b.y = (s0 + 5 <= t) ? b.y : 0.f; b.z = (s0 + 6 <= t) ? b.z : 0.f; b.w = (s0 + 7 <= t) ? b.w : 0.f; }
        u32x4 o; o.x = pk2(a.x, a.y); o.y = pk2(a.z, a.w); o.z = pk2(b.x, b.y); o.w = pk2(b.z, b.w);
        *(u32x4*)(dst + e) = o;
    }
}

__device__ __forceinline__ void fp8_row_load(f32x4 (&v)[4], const float* src, int lane) {
    const f32x4* p = (const f32x4*)(src + lane * 16);
#pragma unroll
    for (int j = 0; j < 4; ++j) v[j] = p[j];
}
__device__ __forceinline__ void fp8_row_finish(const f32x4 (&v_)[4], unsigned char* dst, float* inv_scale, int lane, const float* col_scale) {
    f32x4 v[4];
#pragma unroll
    for (int j = 0; j < 4; ++j) { v[j] = v_[j]; if (col_scale) v[j] = v[j] * *(const f32x4*)(col_scale + lane * 16 + 4 * j); }
    float m = 0.f;
#pragma unroll
    for (int j = 0; j < 4; ++j) m = fmaxf(m, fmaxf(fmaxf(fabsf(v[j].x), fabsf(v[j].y)), fmaxf(fabsf(v[j].z), fabsf(v[j].w))));
#pragma unroll
    for (int o = 1; o < 64; o <<= 1) m = fmaxf(m, __shfl_xor(m, o));
    const float sc = m > 0.f ? 440.f / m : 1.f;
    u32x4 w;
#pragma unroll
    for (int j = 0; j < 4; ++j) { int t = 0; t = __builtin_amdgcn_cvt_pk_fp8_f32(v[j].x * sc, v[j].y * sc, t, false); t = __builtin_amdgcn_cvt_pk_fp8_f32(v[j].z * sc, v[j].w * sc, t, true); w[j] = (unsigned)t; }
    *(u32x4*)(dst + (size_t)(lane >> 3) * (16384 * 128) + (lane & 7) * 16) = w;
    if (lane == 0) *inv_scale = m > 0.f ? m / 440.f : 1.f;
}
__device__ __forceinline__ void p0_prep(const Ctx& C) {
    LAS float* scr = (LAS float*)(C.lds + C.wid * 8448);
    const int gw = C.bid * 8 + C.wid, NGW = C.G * 8, lane = C.lane;
    const kaptr_t ka = kargs();
    unsigned char* ws = ka_ws(ka);
    bf16_t* WINKV = (bf16_t*)(ws + WS_WINKV);
    constexpr int I_IN = 16 * 273, I_KV = 16 * 64, I_BR = 16 * 32, I_O = 16 * 32, I_Q = 16 * 64;
    constexpr int NTR = I_IN + I_KV + 3 * I_BR + I_O + I_Q;
    for (int it = gw; it < NTR; it += NGW) {
        int r = it;
        if (r < I_IN) { transpose_item(ka_in(ka, I_W_IN), 1024, IN_DIM, WINKV, MapWin{}, scr, r, lane); continue; } r -= I_IN;
        if (r < I_KV) { transpose_item(ka_in(ka, I_W_MEM_KV), 1024, 2048, WINKV, MapId{8960}, scr, r, lane); continue; } r -= I_KV;
        if (r < 3 * I_BR) { const int n = r / I_BR; transpose_item(ka_in(ka, I_W_BRANCH) + (size_t)n * 1024 * 1024, 1024, 1024, (bf16_t*)(ws + WS_WB), MapId{n * 1024}, scr, r % I_BR, lane); continue; } r -= 3 * I_BR;
        if (r < I_O) { transpose_item(ka_in(ka, I_W_OUT), 1024, 1024, (bf16_t*)(ws + WS_WO), MapId{0}, scr, r, lane); continue; } r -= I_O;
        transpose_item(ka_in(ka, I_W_PEER_Q), 1024, 2048, (bf16_t*)(ws + WS_WQ), MapId{0}, scr, r, lane, ka_in(ka, I_LN_FFN));
    }
    for (int it = gw; it < 240; it += NGW) { u32x4 z = {0u, 0u, 0u, 0u}; u32x4* d = (u32x4*)(WINKV + (size_t)(8720 + it) * 1024); d[lane] = z; d[64 + lane] = z; }
    bf16_t* H = (bf16_t*)(ws + WS_H);
    {
        const float* X = ka_in(ka, I_X); const float* MEMP = ka_in(ka, I_MEM); const float* g0 = ka_in(ka, I_LN_MIX); const float* g1 = ka_in(ka, I_LN_MEM);
        f32x4 cur[4], nxt[4];
        if (gw < T_ALL + 4096) rms_row_load(cur, gw < T_ALL ? X + (size_t)gw * 1024 : MEMP + (size_t)(gw - T_ALL) * 1024, lane);
        for (int it = gw; it < T_ALL + 4096; it += NGW) {
            const int nit = it + NGW;
            if (nit < T_ALL + 4096) rms_row_load(nxt, nit < T_ALL ? X + (size_t)nit * 1024 : MEMP + (size_t)(nit - T_ALL) * 1024, lane);
            rms_row_finish(cur, it < T_ALL ? g0 : g1, H + (size_t)it * 1024, lane);
#pragma unroll
            for (int j = 0; j < 4; ++j) cur[j] = nxt[j];
        }
    }
    {
        const float* PUf = ka_in(ka, I_PEER_U); const float* PVf = ka_in(ka, I_PEER_V);
        f32x4 cur[4], nxt[4];
        if (gw < 32768) fp8_row_load(cur, gw < 16384 ? PUf + (size_t)gw * 1024 : PVf + (size_t)(gw - 16384) * 1024, lane);
        for (int it = gw; it < 32768; it += NGW) {
            const int nit = it + NGW;
            if (nit < 32768) fp8_row_load(nxt, nit < 16384 ? PUf + (size_t)nit * 1024 : PVf + (size_t)(nit - 16384) * 1024, lane);
            if (it < 16384) fp8_row_finish(cur, ws + WS_PU + (size_t)it * 128, (float*)(ws + WS_SU) + it, lane, ka_in(ka, I_LN_FFN));
            else fp8_row_finish(cur, ws + WS_PV + (size_t)(it - 16384) * 128, (float*)(ws + WS_SV) + (it - 16384), lane, nullptr);
#pragma unroll
            for (int j = 0; j < 4; ++j) cur[j] = nxt[j];
        }
    }
    for (int it = gw; it < 256 + 128; it += NGW) {
        int r = it;
        if (r < 256) {
            const float* src = ka_in(ka, I_PEER_KEYS) + (size_t)r * 1024; bf16_t* kt = (bf16_t*)(ws + WS_KEYS);
#pragma unroll
            for (int j = 0; j < 2; ++j) {
                const int e = j * 512 + lane * 8, E = r * 1024 + e, k = (E >> 7) & 127, d = E & 127;
                const f32x4 a = *(const f32x4*)(src + e), b = *(const f32x4*)(src + e + 4);
                u32x4 o; o.x = pk2(a.x, a.y); o.y = pk2(a.z, a.w); o.z = pk2(b.x, b.y); o.w = pk2(b.z, b.w);
                *(u32x4*)(kt + (size_t)(E >> 14) * 16384 + (((k >> 4) * 4 + (d >> 5)) * 16 + (k & 15)) * 32 + (d & 31)) = o;
            }
            continue; } r -= 256;
        {
            const float* src = ka_in(ka, I_W_SPATIAL) + (size_t)r * 1024; bf16_t* wt = (bf16_t*)(ws + WS_WSP);
#pragma unroll
            for (int j = 0; j < 2; ++j) {
                const int e = j * 512 + lane * 8, E = r * 1024 + e, t = (E >> 7) & 127, s0 = E & 127;
                f32x4 a = *(const f32x4*)(src + e), b = *(const f32x4*)(src + e + 4);
                a.x = (s0 + 0 <= t) ? a.x : 0.f; a.y = (s0 + 1 <= t) ? a.y : 0.f; a.z = (s0 + 2 <= t) ? a.z : 0.f; a.w = (s0 + 3 <= t) ? a.w : 0.f;
                b.x = (s0 + 4 <= t) ? b.x : 0.f; b.y = (s0 + 5 <= t) ? b.y : 0.f; b.z = (s0 + 6 <= t) ? b.z : 0.f; b.w = (s0 + 7 <= t) ? b.w : 0.f;
                u32x4 o; o.x = pk2(a.x, a.y); o.y = pk2(a.z, a.w); o.z = pk2(b.x, b.y); o.w = pk2(b.z, b.w);
                *(u32x4*)(wt + (size_t)(E >> 14) * 16384 + (((t >> 4) * 4 + (s0 >> 5)) * 16 + (t & 15)) * 32 + (s0 & 31)) = o;
            }
        }
    }
    if (C.bid == 0) for (int i = C.tid; i < 4096; i += NTHR) ((unsigned*)(ws + WS_CTL))[i] = 0u;
}

struct SchedInProj {
    int slab, G, c;
    __device__ __forceinline__ bool next(int i, pg8::Unit& u) const {
        const int L = i * G + c; if (L >= 2304) return false;
        const int wgid = (L % 8) * 288 + L / 8;
        if (wgid < 2240) { const int gid = wgid / 280, r = wgid % 280; u.pm = slab * 64 + gid * 8 + (r % 8); u.pn = r / 8; }
        else { const int r = wgid - 2240; u.pm = 128 + slab * 8 + (r % 8); u.pn = 35 + r / 8; }
        return true;
    }
    __device__ __forceinline__ void a_ready(const pg8::Unit&) const {}
    __device__ __forceinline__ void done(const pg8::Unit&) const {}
};
__device__ __forceinline__ f32x4 sigmoid4_of(f32x4 t) {
    f32x4 e; e.x = __builtin_amdgcn_exp2f(t.x); e.y = __builtin_amdgcn_exp2f(t.y); e.z = __builtin_amdgcn_exp2f(t.z); e.w = __builtin_amdgcn_exp2f(t.w);
    const f32x4 d = e + 1.0f;
    f32x4 r; r.x = __builtin_amdgcn_rcpf(d.x); r.y = __builtin_amdgcn_rcpf(d.y); r.z = __builtin_amdgcn_rcpf(d.z); r.w = __builtin_amdgcn_rcpf(d.w);
    return r;
}
template <int mode>
__device__ __forceinline__ f32x4 act4(f32x4 v) {
    f32x4 r;
    if (mode == 0) r = v;
    else if (mode == 1) r = v * sigmoid4_of(v * (-1.4426950409f));
    else if (mode == 2) { const f32x4 y = v * ((v * v) * (0.044715f * -2.3022081914f) + (-2.3022081914f)); r = v * sigmoid4_of(y); }
    else if (mode == 3) r = sigmoid4_of(v * (-1.4426950409f));
    else r = v * 0.0625f;
    return r;
}
struct EpiInProj {
    static constexpr bool PERM = true, AFTER_DRAIN = false, WANTS_SCRATCH = false, MUT_ACC = false;
    unsigned char* ws; bf16_t* GV; const float* dt_bias; int tok0;
    template <int MODE>
    __device__ __forceinline__ void store_tile(const f32x4 (&acc)[2][2][4][2], bf16_t* rowp_run, int ld, int rbase, bool is_v, int pn, int wc, int fq) const {
        float* const VSS = (float*)(ws + WS_VSS);
#pragma unroll
        for (int ai = 0; ai < 2; ++ai)
#pragma unroll
            for (int m = 0; m < 4; ++m) {
                const int gt = rbase + ai * 128 + m * 16;
                asm volatile("" : "+v"(rowp_run));
                bf16_t* rowp = rowp_run; float ss = 0.f;
                rowp_run += (size_t)((m == 3) ? 80 : 16) * ld;
#pragma unroll
                for (int bj = 0; bj < 2; ++bj) {
                    const f32x4 v0 = act4<MODE>(acc[ai][bj][m][0]), v1 = act4<MODE>(acc[ai][bj][m][1]);
                    if (MODE == 2 && is_v) { const f32x4 q2 = v0 * v0 + v1 * v1; ss += (q2.x + q2.y) + (q2.z + q2.w); }
                    u32x4 w; w.x = pk2(v0.x, v0.y); w.y = pk2(v0.z, v0.w); w.z = pk2(v1.x, v1.y); w.w = pk2(v1.z, v1.w);
                    *(u32x4*)(rowp + bj * 128) = w;
                    __builtin_amdgcn_sched_barrier(0);
                }
                if (MODE == 2 && is_v) { ss += __shfl_xor(ss, 16); ss += __shfl_xor(ss, 32); if (fq == 0) VSS[(size_t)gt * 16 + (pn - 14) * 4 + wc] = ss; }
                __builtin_amdgcn_sched_barrier(0);
            }
    }
    __device__ __forceinline__ void operator()(const f32x4 (&acc)[2][2][4][2], const pg8::Unit& u, int wr, int wc, int fr, int fq) const {
        bf16_t* const YB = (bf16_t*)(ws + WS_SLAB + SL_YB); bf16_t* const XBC = (bf16_t*)(ws + WS_SLAB + SL_XBC); bf16_t* const SG = (bf16_t*)(ws + WS_SLAB + SL_SG);
        bf16_t* const KB = (bf16_t*)(ws + WS_KB); bf16_t* const VT = (bf16_t*)(ws + WS_VT); float* const DT = (float*)(ws + WS_DT); float* const VSS = (float*)(ws + WS_VSS);
        const int pn = u.pn;
        const int rbase = u.pm * 256 + wr * 64 + fr;
        const int cl = wc * 32 + 8 * fq;
        if (pn < 34) {
            bf16_t* dst; int ld, cofs, mode;
            if (pn < 4)       { dst = YB;                         ld = 1024; cofs = pn * 256;        mode = 1; }
            else if (pn < 10) { dst = XBC;                        ld = 1536; cofs = (pn - 4) * 256;  mode = 0; }
            else if (pn < 14) { dst = YB + (size_t)TS * 1024;     ld = 1024; cofs = (pn - 10) * 256; mode = 2; }
            else if (pn < 18) { dst = GV;                         ld = 1024; cofs = (pn - 14) * 256; mode = 2; }
            else if (pn < 22) { dst = YB + (size_t)2 * TS * 1024; ld = 1024; cofs = (pn - 18) * 256; mode = 4; }
            else              { dst = SG; ld = 0; cofs = 0; mode = 3; }
            const bool is_v = (pn >= 14 && pn < 18);
            if (pn >= 22) {
                unsigned char* gt8 = (unsigned char*)SG + (size_t)((u.pm - tok0 / 256) * 12 + (pn - 22)) * 65536 + (wr * 4 + wc) * 8192 + (fr + 16 * fq) * 8;
#pragma unroll
                for (int ai = 0; ai < 2; ++ai)
#pragma unroll
                    for (int m = 0; m < 4; ++m)
#pragma unroll
                        for (int bj = 0; bj < 2; ++bj) {
                            const f32x4 v0 = acc[ai][bj][m][0], v1 = acc[ai][bj][m][1];
                            f32x4 s0 = sigmoid4_of(v0 * (-1.4426950409f)) * 255.f + 0.5f, s1 = sigmoid4_of(v1 * (-1.4426950409f)) * 255.f + 0.5f;
                            s0.x = fmaxf(s0.x, 1.f); s0.y = fmaxf(s0.y, 1.f); s0.z = fmaxf(s0.z, 1.f); s0.w = fmaxf(s0.w, 1.f); s1.x = fmaxf(s1.x, 1.f); s1.y = fmaxf(s1.y, 1.f); s1.z = fmaxf(s1.z, 1.f); s1.w = fmaxf(s1.w, 1.f);
                            const unsigned b8[8] = {(unsigned)s0.x, (unsigned)s0.y, (unsigned)s0.z, (unsigned)s0.w, (unsigned)s1.x, (unsigned)s1.y, (unsigned)s1.z, (unsigned)s1.w};
                            u32x2 w; w.x = b8[0] | (b8[1] << 8) | (b8[2] << 16) | (b8[3] << 24); w.y = b8[4] | (b8[5] << 8) | (b8[6] << 16) | (b8[7] << 24);
                            *(u32x2*)(gt8 + (ai * 8 + m * 2 + bj) * 512) = w;
                            __builtin_amdgcn_sched_barrier(0);
                        }
                return;
            }
            bf16_t* rowp0 = dst + (size_t)(rbase - tok0) * ld + cofs + cl;
            switch (mode) {
                case 0: store_tile<0>(acc, rowp0, ld, rbase, false, pn, wc, fq); break;
                case 1: store_tile<1>(acc, rowp0, ld, rbase, false, pn, wc, fq); break;
                case 2: store_tile<2>(acc, rowp0, ld, rbase, is_v, pn, wc, fq); break;
                default: store_tile<4>(acc, rowp0, ld, rbase, false, pn, wc, fq); break;
            }
        } else if (pn == 34) {
            if (wc == 0 && fq < 2) {
                const f32x4 b0 = *(const f32x4*)(dt_bias + 8 * fq), b1 = *(const f32x4*)(dt_bias + 8 * fq + 4);
#pragma unroll
                for (int ai = 0; ai < 2; ++ai)
#pragma unroll
                    for (int m = 0; m < 4; ++m) {
                        const int gt = rbase + ai * 128 + m * 16;
                        f32x4 v0 = acc[ai][0][m][0] + b0, v1 = acc[ai][0][m][1] + b1;
#pragma unroll
                        for (int j = 0; j < 4; ++j) { v0[j] = fmaxf(v0[j], 0.f) + __logf(1.f + __expf(-fabsf(v0[j]))); v1[j] = fmaxf(v1[j], 0.f) + __logf(1.f + __expf(-fabsf(v1[j]))); }
                        *(f32x4*)(DT + (size_t)gt * 16 + 8 * fq) = v0; *(f32x4*)(DT + (size_t)gt * 16 + 8 * fq + 4) = v1;
                        __builtin_amdgcn_sched_barrier(0);
                    }
            }
        } else {
            const int pk = pn - 35;
#pragma unroll
            for (int ai = 0; ai < 2; ++ai)
#pragma unroll
                for (int m = 0; m < 4; ++m) {
                    const int mrow = rbase + ai * 128 + m * 16 - T_ALL;
#pragma unroll
                    for (int bj = 0; bj < 2; ++bj) {
                        const f32x4 v0 = acc[ai][bj][m][0], v1 = acc[ai][bj][m][1];
                        if (pk < 4) {
                            u32x4 w; w.x = pk2(v0.x, v0.y); w.y = pk2(v0.z, v0.w); w.z = pk2(v1.x, v1.y); w.w = pk2(v1.z, v1.w);
                            *(u32x4*)(KB + (size_t)mrow * 1024 + pk * 256 + bj * 128 + cl) = w;
                        } else {
                            u32x4 w; w.x = pk2(v0.x, v0.y); w.y = pk2(v0.z, v0.w); w.z = pk2(v1.x, v1.y); w.w = pk2(v1.z, v1.w);
                            *(u32x4*)(VT + (size_t)((((u.pm - T_ALL / 256) * 4 + (pk - 4)) * 2 + bj) * 32768) + (mrow & 255) * 128 + cl) = w;
                        }
                    }
                    __builtin_amdgcn_sched_barrier(0);
                }
        }
    }
};

struct P2Ptrs {
    bf16_t *YB, *XBC, *GV, *KB, *VT, *WSP; float *DT, *VSS, *SSS;
    bf16_t *YD, *ST; float* CD;
    const float *conv_w, *conv_b, *a_log, *d_skip, *ssd_norm, *gmlp_norm, *b_spatial;
    int tok0, slab;
};

constexpr int RP = 272;
__device__ __forceinline__ void conv_w8(const float* conv_w, const float* conv_b, int ch, float (&w)[4][8], float (&bb)[8]) {
#pragma unroll
    for (int k = 0; k < 4; ++k) { const f32x4 a = *(const f32x4*)(conv_w + k * 1536 + ch), b = *(const f32x4*)(conv_w + k * 1536 + ch + 4);
        w[k][0] = a.x; w[k][1] = a.y; w[k][2] = a.z; w[k][3] = a.w; w[k][4] = b.x; w[k][5] = b.y; w[k][6] = b.z; w[k][7] = b.w; }
    const f32x4 a = *(const f32x4*)(conv_b + ch), b = *(const f32x4*)(conv_b + ch + 4); bb[0] = a.x; bb[1] = a.y; bb[2] = a.z; bb[3] = a.w; bb[4] = b.x; bb[5] = b.y; bb[6] = b.z; bb[7] = b.w;
}
__device__ __forceinline__ void unpack8(const u32x4 raw, float (&x)[8]) {
    x[0] = bf_lo(raw.x); x[1] = bf_hi(raw.x); x[2] = bf_lo(raw.y); x[3] = bf_hi(raw.y); x[4] = bf_lo(raw.z); x[5] = bf_hi(raw.z); x[6] = bf_lo(raw.w); x[7] = bf_hi(raw.w);
}
template <int NR>
__device__ __forceinline__ void conv_load(u32x4 (&raw)[NR + 3], const bf16_t* xsrc  , int r0, bool at_seq_start) {
#pragma unroll
    for (int q = 0; q < NR + 3; ++q) { raw[q] = (u32x4){0u, 0u, 0u, 0u}; if (!at_seq_start || r0 + q - 3 >= 0) raw[q] = *(const u32x4*)(xsrc + (q - 3) * 1536); }
}
template <int NR, class F>
__device__ __forceinline__ void conv_compute(const u32x4 (&raw)[NR + 3], const float (&w)[4][8], const float (&bb)[8], F&& emit) {
    float xm[3][8];
    unpack8(raw[0], xm[0]); unpack8(raw[1], xm[1]); unpack8(raw[2], xm[2]);
#pragma unroll
    for (int rr = 0; rr < NR; ++rr) {
        float cur[8], o[8]; unpack8(raw[rr + 3], cur);
#pragma unroll
        for (int j = 0; j < 8; ++j) { const float v = bb[j] + w[0][j] * xm[0][j] + w[1][j] * xm[1][j] + w[2][j] * xm[2][j] + w[3][j] * cur[j]; o[j] = silu_f(v);
            xm[0][j] = xm[1][j]; xm[1][j] = xm[2][j]; xm[2][j] = cur[j]; }
        emit(rr, o);
    }
}
template <int NR, class F>
__device__ __forceinline__ void conv_rows(const bf16_t* xsrc, int r0, bool at_seq_start, const float (&w)[4][8], const float (&bb)[8], F&& emit) {
    u32x4 raw[NR + 3]; conv_load<NR>(raw, xsrc, r0, at_seq_start); conv_compute<NR>(raw, w, bb, emit);
}
__device__ __forceinline__ float dt_scan(const float* DT, size_t tok, int h, float a_h, LAS float* dtv, LAS float* acs, int lane) {
    const float d0 = DT[(tok + 2 * lane) * 16 + h], d1 = DT[(tok + 2 * lane + 1) * 16 + h];
    const float s0 = d0 * a_h, s1 = s0 + d1 * a_h;
    float inc = s1;
#pragma unroll
    for (int o = 1; o < 64; o <<= 1) { const float t = __shfl_up(inc, o); if (lane >= o) inc += t; }
    const float exc = inc - s1;
    if (dtv) { dtv[2 * lane] = d0; dtv[2 * lane + 1] = d1; }
    acs[2 * lane] = exc + s0; acs[2 * lane + 1] = inc;
    return __shfl(inc, 63);
}
__device__ __forceinline__ void ssd_a_item(const Ctx& C, const P2Ptrs& P, int idx) {
    LAS unsigned char* L = C.lds;
    constexpr int O_C = 0, O_B = 34816, O_BT = 69632, O_XT = 104448, O_XW = 121856, O_DT = 139264, O_ACS = 143360, O_CW = 147456;
    constexpr int XSP = 144;
    const int tid = C.tid, lane = C.lane, wid = C.wid, fr = lane & 15, fq = lane >> 4;
    const int bl = idx >> 5, c = (idx >> 1) & 15, g = idx & 1;
    const int lt0 = bl * SEQ + c * 128;
    const bool seq_start = (c == 0);
    LAS float* dtv = (LAS float*)(L + O_DT); LAS float* acs = (LAS float*)(L + O_ACS);
    const int bcc = tid & 31, bseg = tid >> 5, br0 = bseg * 8;
    const int bch = (bcc < 16) ? 1024 + g * 128 + bcc * 8 : 1280 + g * 128 + (bcc - 16) * 8;
    u32x4 braw[11]; conv_load<8>(braw, P.XBC + (size_t)(lt0 + br0) * 1536 + bch, br0, seq_start);
    float bw[4][8], bbb[8]; conv_w8(P.conv_w, P.conv_b, bch, bw, bbb);
    {
        float cwv[5];
#pragma unroll
        for (int k = 0; k < 5; ++k) cwv[k] = (k < 4) ? P.conv_w[k * 1536 + g * 512 + tid] : P.conv_b[g * 512 + tid];
#pragma unroll
        for (int k = 0; k < 5; ++k) ((LAS float*)(L + O_CW))[k * 512 + tid] = cwv[k];
    }
    {
        const int h = g * 8 + wid;
        const float tot = dt_scan(P.DT, (size_t)(P.tok0 + lt0), h, -__expf(P.a_log[h]), dtv + wid * 128, acs + wid * 128, lane);
        if (lane == 0) P.CD[(bl * 16 + c) * 16 + h] = __expf(tot);
    }
    {
        const int cc = bcc, r0 = br0;
        const int rm = (cc < 16 ? O_B : O_C) + (cc & 15) * 16, tr = O_BT + (cc & 15) * 8 * RP;
        conv_compute<8>(braw, bw, bbb, [&](int rr, const float (&o)[8]) {
            const int r = r0 + rr;
            u32x4 pk; pk.x = pk2(o[0], o[1]); pk.y = pk2(o[2], o[3]); pk.z = pk2(o[4], o[5]); pk.w = pk2(o[6], o[7]);
            *(LAS u32x4*)(L + rm + r * RP) = pk;
            if (cc < 16) {
                *(LAS unsigned short*)(L + tr + 0 * RP + r * 2) = (unsigned short)(pk.x & 0xffffu); *(LAS unsigned short*)(L + tr + 1 * RP + r * 2) = (unsigned short)(pk.x >> 16);
                *(LAS unsigned short*)(L + tr + 2 * RP + r * 2) = (unsigned short)(pk.y & 0xffffu); *(LAS unsigned short*)(L + tr + 3 * RP + r * 2) = (unsigned short)(pk.y >> 16);
                *(LAS unsigned short*)(L + tr + 4 * RP + r * 2) = (unsigned short)(pk.z & 0xffffu); *(LAS unsigned short*)(L + tr + 5 * RP + r * 2) = (unsigned short)(pk.z >> 16);
                *(LAS unsigned short*)(L + tr + 6 * RP + r * 2) = (unsigned short)(pk.w & 0xffffu); *(LAS unsigned short*)(L + tr + 7 * RP + r * 2) = (unsigned short)(pk.w >> 16);
            }
        });
    }
    __syncthreads();
    const int l0 = 16 * wid, fb = fr * RP + fq * 16, fbw = fb + l0 * RP, l = l0 + fr;
    f32x4 cb[8];
    {
        bf16x8 cf[4];
#pragma unroll
        for (int ks = 0; ks < 4; ++ks) cf[ks] = *(const LAS bf16x8*)(L + O_C + fbw + ks * 64);
#pragma unroll
        for (int j = 0; j < 8; ++j) {
            cb[j] = (f32x4){0.f, 0.f, 0.f, 0.f};
            if (j <= wid) {
#pragma unroll
                for (int ks = 0; ks < 4; ++ks) { const bf16x8 bf = *(const LAS bf16x8*)(L + O_B + fb + j * 16 * RP + ks * 64); cb[j] = mfma16(bf, cf[ks], cb[j]); }
            }
        }
    }
    __syncthreads();
    const int xcc = tid & 7, xseg = tid >> 3, xr0 = xseg * 2;
    u32x4 xraw[5];
    conv_load<2>(xraw, P.XBC + (size_t)(lt0 + xr0) * 1536 + (g * 8) * 64 + xcc * 8, xr0, seq_start);
    for (int hh = 0; hh < 8; ++hh) {
        const int h = g * 8 + hh;
        const float d_h = P.d_skip[h];
        LAS float* acsh = acs + hh * 128; LAS float* dth = dtv + hh * 128;
        {
            float w[4][8], bb[8];
#pragma unroll
            for (int k = 0; k < 4; ++k) { const f32x4 a4 = *(const LAS f32x4*)(L + O_CW + (k * 512 + hh * 64 + xcc * 8) * 4), b4 = *(const LAS f32x4*)(L + O_CW + (k * 512 + hh * 64 + xcc * 8 + 4) * 4);
                w[k][0] = a4.x; w[k][1] = a4.y; w[k][2] = a4.z; w[k][3] = a4.w; w[k][4] = b4.x; w[k][5] = b4.y; w[k][6] = b4.z; w[k][7] = b4.w; }
            { const f32x4 a4 = *(const LAS f32x4*)(L + O_CW + (4 * 512 + hh * 64 + xcc * 8) * 4), b4 = *(const LAS f32x4*)(L + O_CW + (4 * 512 + hh * 64 + xcc * 8 + 4) * 4);
                bb[0] = a4.x; bb[1] = a4.y; bb[2] = a4.z; bb[3] = a4.w; bb[4] = b4.x; bb[5] = b4.y; bb[6] = b4.z; bb[7] = b4.w; }
            const float acs_last = acsh[127];
            const int cc = xcc, r0 = xr0;
            conv_compute<2>(xraw, w, bb, [&](int rr, const float (&o)[8]) {
                const int r = r0 + rr;
                u32x4 pk; pk.x = pk2(o[0], o[1]); pk.y = pk2(o[2], o[3]); pk.z = pk2(o[4], o[5]); pk.w = pk2(o[6], o[7]);
                *(LAS u32x4*)(L + O_B + r * XSP + cc * 16) = pk;
                const float dtr = dth[r], wd = dtr * __expf(acs_last - acsh[r]);
#pragma unroll
                for (int j = 0; j < 8; ++j) {
                    *(LAS unsigned short*)(L + O_XT + (cc * 8 + j) * RP + r * 2) = (unsigned short)(pk2(o[j] * dtr, 0.f) & 0xffffu);
                    *(LAS unsigned short*)(L + O_XW + (cc * 8 + j) * RP + r * 2) = (unsigned short)(pk2(o[j] * wd, 0.f) & 0xffffu);
                }
            });
            if (hh + 1 < 8) conv_load<2>(xraw, P.XBC + (size_t)(lt0 + xr0) * 1536 + (h + 1) * 64 + xcc * 8, xr0, seq_start);
        }
        {
            const float al = acsh[l];
#pragma unroll
            for (int j = 0; j < 8; ++j) {
                u32x2 wv = {0u, 0u};
                if (j <= wid) {
                    const f32x4 as = *(const LAS f32x4*)(L + O_ACS + (hh * 128 + 16 * j + 4 * fq) * 4);
                    float mv[4];
#pragma unroll
                    for (int r = 0; r < 4; ++r) { const int sidx = 16 * j + 4 * fq + r; mv[r] = (sidx <= l) ? cb[j][r] * __expf(al - as[r]) : 0.f; }
                    wv.x = pk2(mv[0], mv[1]); wv.y = pk2(mv[2], mv[3]);
                }
                *(LAS u32x2*)(L + O_C + l * RP + fq * 8 + j * 32) = wv;
            }
        }
        __syncthreads();
        {
            bf16x8 mf[4];
#pragma unroll
            for (int ks = 0; ks < 4; ++ks) mf[ks] = *(const LAS bf16x8*)(L + O_C + fbw + ks * 64);
            bf16_t* yblk = P.YD + (size_t)((((lt0 + l0) >> 4) * 16 + h) * 2) * 512 + lane * 8;
            u32x2 yo4[4];
#pragma unroll
            for (int jj = 0; jj < 4; ++jj) {
                f32x4 yd = {0.f, 0.f, 0.f, 0.f};
#pragma unroll
                for (int ks = 0; ks < 4; ++ks) { const bf16x8 xf = *(const LAS bf16x8*)(L + O_XT + fb + jj * 16 * RP + ks * 64); yd = mfma16(xf, mf[ks], yd); }
                const u32x2 xs4 = *(const LAS u32x2*)(L + O_B + l * XSP + fq * 8 + jj * 32);
                yo4[jj].x = pk2(yd[0] + d_h * bf_lo(xs4.x), yd[1] + d_h * bf_hi(xs4.x)); yo4[jj].y = pk2(yd[2] + d_h * bf_lo(xs4.y), yd[3] + d_h * bf_hi(xs4.y));
            }
            *(u32x4*)yblk = (u32x4){yo4[0].x, yo4[0].y, yo4[1].x, yo4[1].y}; *(u32x4*)(yblk + 512) = (u32x4){yo4[2].x, yo4[2].y, yo4[3].x, yo4[3].y};
        }
        {
            const int pt = wid & 3, nh = wid >> 2;
            bf16x8 xw[4];
#pragma unroll
            for (int ks = 0; ks < 4; ++ks) xw[ks] = *(const LAS bf16x8*)(L + O_XW + fb + pt * 16 * RP + ks * 64);
            bf16_t* sp = P.ST + (size_t)((bl * 16 + c) * 16 + h) * 8192 + pt * 2048 + fr * 32 + 4 * fq;
#pragma unroll
            for (int jj = 0; jj < 4; ++jj) {
                f32x4 st = {0.f, 0.f, 0.f, 0.f};
#pragma unroll
                for (int ks = 0; ks < 4; ++ks) { const bf16x8 bt = *(const LAS bf16x8*)(L + O_BT + fb + (nh * 4 + jj) * 16 * RP + ks * 64); st = mfma16(bt, xw[ks], st); }
                u32x2 o; o.x = pk2(st[0], st[1]); o.y = pk2(st[2], st[3]);
                *(u32x2*)(sp + ((nh * 4 + jj) >> 1) * 512 + ((nh * 4 + jj) & 1) * 16) = o;
            }
        }
        __syncthreads();
    }
}
__device__ __forceinline__ void ssd_scan_item(const Ctx& C, const P2Ptrs& P, int idx) {
    const int bh = idx >> 2, part = idx & 3, bl = bh >> 4, h = bh & 15;
    const size_t e0 = (size_t)part * 2048 + C.tid * 4;
    u32x2 v[16]; float dec[16];
#pragma unroll
    for (int c = 0; c < 16; ++c) { v[c] = *(const u32x2*)(P.ST + (size_t)((bl * 16 + c) * 16 + h) * 8192 + e0); dec[c] = P.CD[(bl * 16 + c) * 16 + h]; }
    float run[4] = {0.f, 0.f, 0.f, 0.f};
#pragma unroll
    for (int c = 0; c < 16; ++c) {
        u32x2 o; o.x = pk2(run[0], run[1]); o.y = pk2(run[2], run[3]);
        *(u32x2*)(P.ST + (size_t)((bl * 16 + c) * 16 + h) * 8192 + e0) = o;
        run[0] = run[0] * dec[c] + bf_lo(v[c].x); run[1] = run[1] * dec[c] + bf_hi(v[c].x); run[2] = run[2] * dec[c] + bf_lo(v[c].y); run[3] = run[3] * dec[c] + bf_hi(v[c].y);
    }
}
__device__ __forceinline__ void ssd_c_item(const Ctx& C, const P2Ptrs& P, int idx) {
    LAS unsigned char* L = C.lds;
    constexpr int O_C = 0, O_ACS = 34816;
    const int tid = C.tid, lane = C.lane, wid = C.wid, fr = lane & 15, fq = lane >> 4;
    const int bl = idx >> 5, c = (idx >> 1) & 15, g = idx & 1;
    const int lt0 = bl * SEQ + c * 128;
    LAS float* acs = (LAS float*)(L + O_ACS);
    {
        const int cc = tid & 15, seg = tid >> 4, r0 = seg * 4;
        const int ch = 1280 + g * 128 + cc * 8;
        u32x4 craw[7]; conv_load<4>(craw, P.XBC + (size_t)(lt0 + r0) * 1536 + ch, r0, c == 0);
        float w[4][8], bb[8]; conv_w8(P.conv_w, P.conv_b, ch, w, bb);
        { const int h = g * 8 + wid; (void)dt_scan(P.DT, (size_t)(P.tok0 + lt0), h, -__expf(P.a_log[h]), (LAS float*)nullptr, acs + wid * 128, lane); }
        conv_compute<4>(craw, w, bb, [&](int rr, const float (&o)[8]) {
            u32x4 pk; pk.x = pk2(o[0], o[1]); pk.y = pk2(o[2], o[3]); pk.z = pk2(o[4], o[5]); pk.w = pk2(o[6], o[7]);
            *(LAS u32x4*)(L + O_C + (r0 + rr) * RP + cc * 16) = pk;
        });
    }
    __syncthreads();
    const int l0 = 16 * wid, l = l0 + fr;
    bf16x8 cf[4];
#pragma unroll
    for (int ks = 0; ks < 4; ++ks) cf[ks] = *(const LAS bf16x8*)(L + O_C + (l0 + fr) * RP + fq * 16 + ks * 64);
    bf16_t* ZS = P.YB;
    float ssg = 0.f;
    constexpr int O_ST = 38912;
    u32x4 stA, stB;
#define PC_LD(HH) do { const bf16_t* sp_ = P.ST + (size_t)((bl * 16 + c) * 16 + g * 8 + (HH)) * 8192 + tid * 16; stA = *(const u32x4*)sp_; stB = *(const u32x4*)(sp_ + 8); } while (0)
#define PC_ST(HH) do { *(LAS u32x4*)(L + O_ST + ((HH) & 1) * 16384 + tid * 32) = stA; *(LAS u32x4*)(L + O_ST + ((HH) & 1) * 16384 + tid * 32 + 16) = stB; } while (0)
    PC_LD(0); PC_ST(0);
    __syncthreads();
#pragma unroll 1
    for (int hh = 0; hh < 8; ++hh) {
        const int h = g * 8 + hh;
        if (hh + 1 < 8) PC_LD(hh + 1);
        const float el = __expf(acs[hh * 128 + l]);
        const LAS unsigned char* sp = L + O_ST + (hh & 1) * 16384 + fr * 64 + fq * 16;
        bf16_t* zrow = ZS + (size_t)(lt0 + l) * 1024 + h * 64 + 4 * fq;
        const bf16_t* yblk = P.YD + (size_t)((((lt0 + l0) >> 4) * 16 + h) * 2) * 512 + lane * 8;
        const u32x4 ydv0 = *(const u32x4*)yblk, ydv1 = *(const u32x4*)(yblk + 512);
        const float* nwp = P.ssd_norm + h * 64 + 4 * fq;
        float ss = 0.f;
#pragma unroll
        for (int jj = 0; jj < 4; ++jj) {
            f32x4 yo = {0.f, 0.f, 0.f, 0.f};
#pragma unroll
            for (int ks = 0; ks < 4; ++ks) { const bf16x8 sf = *(const LAS bf16x8*)(sp + jj * 4096 + ks * 1024); yo = mfma16(sf, cf[ks], yo); }
            const u32x4 ydv = (jj < 2) ? ydv0 : ydv1; const u32x2 yd4 = (jj & 1) ? (u32x2){ydv.z, ydv.w} : (u32x2){ydv.x, ydv.y}, zs4 = *(const u32x2*)(zrow + 16 * jj);
            const f32x4 nw = *(const f32x4*)(nwp + 16 * jj);
            float v[4];
            v[0] = (bf_lo(yd4.x) + el * yo[0]) * bf_lo(zs4.x); v[1] = (bf_hi(yd4.x) + el * yo[1]) * bf_hi(zs4.x);
            v[2] = (bf_lo(yd4.y) + el * yo[2]) * bf_lo(zs4.y); v[3] = (bf_hi(yd4.y) + el * yo[3]) * bf_hi(zs4.y);
            ss += (v[0] * v[0] + v[1] * v[1]) + (v[2] * v[2] + v[3] * v[3]);
            u32x2 o; o.x = pk2(v[0] * nw.x, v[1] * nw.y); o.y = pk2(v[2] * nw.z, v[3] * nw.w);
            *(u32x2*)(zrow + 16 * jj) = o;
        }
        ssg += ss;
        if (hh + 1 < 8) PC_ST(hh + 1);
        __syncthreads();
    }
#undef PC_LD
#undef PC_ST
    ssg += __shfl_xor(ssg, 16); ssg += __shfl_xor(ssg, 32);
    if (fq == 0) P.SSS[(size_t)(P.tok0 + lt0 + l) * 2 + g] = ssg;
}

__device__ __forceinline__ void gmlp_item(const Ctx& C, const P2Ptrs& P, int idx) {
    LAS unsigned char* L = C.lds;
    const int tid = C.tid, lane = C.lane, wid = C.wid, fr = lane & 15, fq = lane >> 4;
    const int bl = idx >> 7, c = (idx >> 3) & 15, g = idx & 7;
    const int lt0 = bl * SEQ + c * 128;
    bf16_t* GU = P.YB + (size_t)TS * 1024;
    const int s = tid >> 2, qd = tid & 3;
    u32x4 raw[4];
#pragma unroll
    for (int k = 0; k < 4; ++k) raw[k] = *(const u32x4*)(P.GV + (size_t)(lt0 + s) * 1024 + g * 128 + k * 32 + qd * 8);
    const float ssq = sum16(P.VSS + (size_t)(P.tok0 + lt0 + s) * 16);
    const int t0 = 16 * wid, nks = (t0 + 15) / 32 + 1, t = t0 + fr;
    bf16x8 wf[4];
#pragma unroll
    for (int ks = 0; ks < 4; ++ks) { wf[ks] = (bf16x8){0, 0, 0, 0, 0, 0, 0, 0}; if (ks < nks) wf[ks] = *(const bf16x8*)(P.WSP + (size_t)g * 16384 + ((wid * 4 + ks) * 16 + fr) * 32 + fq * 8); }
    bf16_t* gp0 = GU + (size_t)(lt0 + t) * 1024 + g * 128 + 8 * fq;
    u32x4 gu[4];
#pragma unroll
    for (int j = 0; j < 4; ++j) gu[j] = *(const u32x4*)(gp0 + 32 * j);
    const float bias = P.b_spatial[g * 128 + t];
    {
        const float rstd = rsqrtf(ssq * (1.f / 1024.f) + EPS);
#pragma unroll
        for (int k = 0; k < 4; ++k) {
            const int ch0 = k * 32 + qd * 8;
            const f32x4 n0 = *(const f32x4*)(P.gmlp_norm + g * 128 + ch0), n1 = *(const f32x4*)(P.gmlp_norm + g * 128 + ch0 + 4);
            float v[8]; v[0] = bf_lo(raw[k].x) * n0.x; v[1] = bf_hi(raw[k].x) * n0.y; v[2] = bf_lo(raw[k].y) * n0.z; v[3] = bf_hi(raw[k].y) * n0.w;
            v[4] = bf_lo(raw[k].z) * n1.x; v[5] = bf_hi(raw[k].z) * n1.y; v[6] = bf_lo(raw[k].w) * n1.z; v[7] = bf_hi(raw[k].w) * n1.w;
#pragma unroll
            for (int j = 0; j < 8; ++j) *(LAS unsigned short*)(L + (32 * k + 16 * (j >> 2) + 4 * qd + (j & 3)) * RP + s * 2) = (unsigned short)(pk2(v[j] * rstd, 0.f) & 0xffffu);
        }
    }
    __syncthreads();
    const int fb = fr * RP + fq * 16;
    f32x4 acc[8];
#pragma unroll
    for (int j = 0; j < 8; ++j) acc[j] = (f32x4){0.f, 0.f, 0.f, 0.f};
#pragma unroll
    for (int ks = 0; ks < 4; ++ks) {
        if (ks < nks) {
#pragma unroll
            for (int j = 0; j < 8; ++j) { const bf16x8 vf = *(const LAS bf16x8*)(L + fb + j * 16 * RP + ks * 64); acc[j] = mfma16(vf, wf[ks], acc[j]); }
        }
    }
#pragma unroll
    for (int j = 0; j < 4; ++j) {
        u32x4 o; o.x = pk2(bf_lo(gu[j].x) * (acc[2 * j][0] + bias), bf_hi(gu[j].x) * (acc[2 * j][1] + bias)); o.y = pk2(bf_lo(gu[j].y) * (acc[2 * j][2] + bias), bf_hi(gu[j].y) * (acc[2 * j][3] + bias));
        o.z = pk2(bf_lo(gu[j].z) * (acc[2 * j + 1][0] + bias), bf_hi(gu[j].z) * (acc[2 * j + 1][1] + bias)); o.w = pk2(bf_lo(gu[j].w) * (acc[2 * j + 1][2] + bias), bf_hi(gu[j].w) * (acc[2 * j + 1][3] + bias));
        *(u32x4*)(gp0 + 32 * j) = o;
    }
}

__device__ __forceinline__ void xattn_item(const Ctx& C, const P2Ptrs& P, int idx) {
    LAS unsigned char* L = C.lds;
    constexpr int VP = 288, O_A = 0, O_B = 73728;
    const int tid = C.tid, lane = C.lane, wid = C.wid, fr = lane & 15, fq = lane >> 4;
    const int bl = idx >> 5, h = (idx >> 3) & 3, qt = idx & 7;
    const int b = P.slab * 8 + bl;
    const int lt = bl * SEQ + qt * 256 + 32 * wid + fr;
    bf16_t* QX = P.YB + (size_t)2 * TS * 1024;
    bf16_t* qrow = QX + (size_t)lt * 1024 + h * 256;
    const int srow = tid >> 4, sc16 = tid & 15;
    const int fb = fr * RP + fq * 16;
    const int trb = (4 * fq + ((lane & 15) >> 2)) * VP + (lane & 3) * 8;
    u32x4 stg[8];
    const bf16_t* kg = P.KB + (size_t)(b * 256 + srow) * 1024 + h * 256 + sc16 * 8;
    const bf16_t* vg = P.VT + ((size_t)((b * 4 + h) * 2) * 256 + srow) * 128 + sc16 * 8;
#define XA_LOADK(half) do { unsigned ko_ = (half) * 256u; _Pragma("unroll") for (int q = 0; q < 8; ++q) { stg[q] = *(const u32x4*)((const unsigned char*)kg + ko_); ko_ += 32u * 2048u; asm volatile("" : "+v"(ko_)); } } while (0)
#define XA_LOADV(half) do { unsigned vo_ = (half) * 65536u; _Pragma("unroll") for (int q = 0; q < 8; ++q) { stg[q] = *(const u32x4*)((const unsigned char*)vg + vo_); vo_ += 32u * 256u; asm volatile("" : "+v"(vo_)); } } while (0)
#define XA_STOREK(buf) do { _Pragma("unroll") for (int q = 0; q < 8; ++q) *(LAS u32x4*)(L + (buf) + (srow + 32 * q) * RP + sc16 * 16) = stg[q]; } while (0)
#define XA_STOREV(buf) do { _Pragma("unroll") for (int q = 0; q < 8; ++q) *(LAS u32x4*)(L + (buf) + (srow + 32 * q) * VP + sc16 * 16) = stg[q]; } while (0)
#define XA_QK(buf, half) do { _Pragma("unroll") for (int j = 0; j < 16; ++j) { _Pragma("unroll") for (int ks = 0; ks < 4; ++ks) { const bf16x8 kf = *(const LAS bf16x8*)(L + (buf) + fb + j * 16 * RP + ks * 64); \
        s0[j] = mfma16(kf, qf[0][ks], s0[j]); s1[j] = mfma16(kf, qf[1][ks], s1[j]); } if ((j & 1) == 1) __builtin_amdgcn_sched_barrier(0); } } while (0)
    XA_LOADK(0);
    bf16x8 qf[2][4];
#define XA_LOADQ(half) do { _Pragma("unroll") for (int rb = 0; rb < 2; ++rb) { _Pragma("unroll") for (int ks = 0; ks < 4; ++ks) qf[rb][ks] = *(const bf16x8*)(qrow + rb * 16 * 1024 + (half) * 128 + ks * 32 + fq * 8); } } while (0)
    XA_LOADQ(0);
    f32x4 s0[16], s1[16];
#pragma unroll
    for (int j = 0; j < 16; ++j) { s0[j] = (f32x4){0.f, 0.f, 0.f, 0.f}; s1[j] = (f32x4){0.f, 0.f, 0.f, 0.f}; }
    XA_STOREK(O_A);
    __syncthreads();
    XA_LOADK(1);
    XA_QK(O_A, 0);
    XA_LOADQ(1);
    XA_STOREK(O_B);
    __syncthreads();
    XA_QK(O_B, 1);
    u32x2 p0r[16], p1r[16]; float inv0, inv1;
#define XA_SOFTMAX(S, PR, INV) do { float mx = -3.0e38f; _Pragma("unroll") for (int j = 0; j < 16; ++j) mx = fmaxf(fmaxf(fmaxf(S[j][0], S[j][1]), fmaxf(S[j][2], S[j][3])), mx); \
        mx = fmaxf(mx, __shfl_xor(mx, 16)); mx = fmaxf(mx, __shfl_xor(mx, 32)); float sum = 0.f; \
        _Pragma("unroll") for (int j = 0; j < 16; ++j) { const float e0 = __expf(S[j][0] - mx), e1 = __expf(S[j][1] - mx), e2 = __expf(S[j][2] - mx), e3 = __expf(S[j][3] - mx); sum += (e0 + e1) + (e2 + e3); PR[j].x = pk2(e0, e1); PR[j].y = pk2(e2, e3); } \
        sum += __shfl_xor(sum, 16); sum += __shfl_xor(sum, 32); INV = 1.f / sum; } while (0)
    __builtin_amdgcn_sched_barrier(0);
    XA_SOFTMAX(s0, p0r, inv0);
    __builtin_amdgcn_sched_barrier(0);
    XA_LOADV(0);
    XA_SOFTMAX(s1, p1r, inv1);
    __builtin_amdgcn_sched_barrier(0);
    XA_STOREV(O_A);
    __syncthreads();
    XA_LOADV(1);
#define XA_PV(buf, dh) do { _Pragma("unroll") for (int jd = 0; jd < 8; ++jd) { f32x4 o0 = {0.f, 0.f, 0.f, 0.f}, o1 = {0.f, 0.f, 0.f, 0.f}; \
        _Pragma("unroll") for (int ks = 0; ks < 8; ++ks) { const s16x4 vlo = __builtin_amdgcn_ds_read_tr16_b64_v4i16((LAS s16x4*)(L + (buf) + trb + ks * 32 * VP + jd * 32)), vhi = __builtin_amdgcn_ds_read_tr16_b64_v4i16((LAS s16x4*)(L + (buf) + trb + (ks * 32 + 16) * VP + jd * 32)); \
            const s16x8 v8 = {vlo.x, vlo.y, vlo.z, vlo.w, vhi.x, vhi.y, vhi.z, vhi.w}; const bf16x8 vf = __builtin_bit_cast(bf16x8, v8); \
            const u32x4 a0 = {p0r[2 * ks].x, p0r[2 * ks].y, p0r[2 * ks + 1].x, p0r[2 * ks + 1].y}, a1 = {p1r[2 * ks].x, p1r[2 * ks].y, p1r[2 * ks + 1].x, p1r[2 * ks + 1].y}; \
            o0 = mfma16(vf, __builtin_bit_cast(bf16x8, a0), o0); o1 = mfma16(vf, __builtin_bit_cast(bf16x8, a1), o1); } \
        u32x2 w0, w1; w0.x = pk2(o0[0] * inv0, o0[1] * inv0); w0.y = pk2(o0[2] * inv0, o0[3] * inv0); w1.x = pk2(o1[0] * inv1, o1[1] * inv1); w1.y = pk2(o1[2] * inv1, o1[3] * inv1); \
        *(u32x2*)(qrow + (dh) * 128 + 16 * jd + 4 * fq) = w0; *(u32x2*)(qrow + 16 * 1024 + (dh) * 128 + 16 * jd + 4 * fq) = w1; __builtin_amdgcn_sched_barrier(0); } } while (0)
    XA_PV(O_A, 0);
    XA_STOREV(O_B);
    __syncthreads();
    XA_PV(O_B, 1);
#undef XA_LOADK
#undef XA_LOADQ
#undef XA_LOADV
#undef XA_STOREK
#undef XA_STOREV
#undef XA_QK
#undef XA_SOFTMAX
#undef XA_PV
}

__device__ __forceinline__ void p2_mixers(const Ctx& C, const P2Ptrs& P, unsigned* queue) {
    LAS int* slot = (LAS int*)(C.lds + LDS_BYTES - 16);
    for (;;) {
        __syncthreads();
        if (C.tid == 0) *slot = (int)atomicAdd(queue, 1u);
        __syncthreads();
        const int item = *slot;
        if (item >= 256 + 256 + 1024) break;
        Ctx Ci = C; { int t_ = C.tid; asm volatile("" : "+v"(t_)); Ci.tid = t_; Ci.lane = t_ & 63; }
        if (item < 768) { const int k = item / 3, r = item - 3 * k; if (r == 0) ssd_a_item(Ci, P, k); else if (r == 1) xattn_item(Ci, P, k); else gmlp_item(Ci, P, k); }
        else gmlp_item(Ci, P, 256 + (item - 768));
    }
}
__device__ __forceinline__ void p2_scan(const Ctx& C, const P2Ptrs& P) { for (int it = C.bid; it < 512; it += C.G) ssd_scan_item(C, P, it); }
__device__ __forceinline__ void p2_pass_c(const Ctx& C, const P2Ptrs& P) { for (int it = C.bid; it < 256; it += C.G) { ssd_c_item(C, P, it); __syncthreads(); } }

struct SchedBranch {
    int G, c;
    __device__ __forceinline__ bool next(int i, pg8::Unit& u) const {
        const int tile = i / 3, n = i - 3 * tile; const int L = tile * G + c; if (L >= 256) return false;
        const int wgid = (L % 8) * 32 + L / 8;
        u.pm = n * 64 + (wgid >> 2); u.pn = n * 4 + (wgid & 3); return true;
    }
    __device__ __forceinline__ void a_ready(const pg8::Unit&) const {}
    __device__ __forceinline__ void done(const pg8::Unit&) const {}
};
struct EpiBranch {
    static constexpr bool PERM = true, AFTER_DRAIN = false, WANTS_SCRATCH = false, MUT_ACC = true;
    unsigned char* ws; int tok0; int noop;
    __device__ __forceinline__ void operator()(f32x4 (&acc)[2][2][4][2], const pg8::Unit& u, int wr, int wc, int fr, int fq) const {
        const int n = u.pn >> 2, pn = u.pn & 3, pm = u.pm & 63;
        if (noop == 1) { asm volatile("" :: "v"(acc[0][0][0][0][0]), "v"(acc[1][1][3][1][3])); return; }
        const unsigned char* const SG = ws + WS_SLAB + SL_SG; unsigned char* const MB = ws + WS_H + (size_t)tok0 * 2048; const float* const SSS = (const float*)(ws + WS_SSS) + (size_t)tok0 * 2;
        const unsigned lg = (unsigned)(fr + 16 * fq) * 8u;
        const unsigned lm = (unsigned)(fr * 1024 + 8 * fq) * 2u;
        const unsigned ls = (unsigned)fr * 8u;
        const unsigned char* const rg = SG + (size_t)((pm * 12 + n * 4 + pn) * 65536 + (wr * 4 + wc) * 8192);
        unsigned char* const rm = MB + (size_t)((pm * 256 + wr * 64) * 1024 + pn * 256 + wc * 32) * 2;
        const unsigned char* const rs_ = (const unsigned char*)SSS + (size_t)(pm * 256 + wr * 64) * 8;
#define EB_OFF(k) ((k) * 512)
#define EB_CVT4(w) (f32x4){(float)((w) & 0xffu), (float)(((w) >> 8) & 0xffu), (float)(((w) >> 16) & 0xffu), (float)((w) >> 24)}
#define EB_RCP4(w) (f32x4){__builtin_amdgcn_rcpf((float)((w) & 0xffu)), __builtin_amdgcn_rcpf((float)(((w) >> 8) & 0xffu)), __builtin_amdgcn_rcpf((float)(((w) >> 16) & 0xffu)), __builtin_amdgcn_rcpf((float)((w) >> 24))}
        if (n == 2) {
            u32x2 g[16];
#pragma unroll
            for (int k = 0; k < 16; ++k) g[k] = *(const u32x2*)(rg + (EB_OFF(k)) + lg);
#pragma unroll
            for (int k = 0; k < 16; ++k) {
                const int ai = k >> 3, m = (k >> 1) & 3, bj = k & 1;
                const f32x4 v0 = (acc[ai][bj][m][0] * (1.f / 255.f)) * EB_CVT4(g[k].x), v1 = (acc[ai][bj][m][1] * (1.f / 255.f)) * EB_CVT4(g[k].y);
                u32x4 w; w.x = pk2(v0.x, v0.y); w.y = pk2(v0.z, v0.w); w.z = pk2(v1.x, v1.y); w.w = pk2(v1.z, v1.w);
                *(u32x4*)(rm + ((ai * 128 + m * 16) * 1024 + bj * 128) * 2 + lm) = w;
                if ((k & 3) == 3) __builtin_amdgcn_sched_barrier(0);
            }
        }
        {
            constexpr int EB_RING = 4;
            u32x2 g[EB_RING][2], h[EB_RING][2], sq[EB_RING];
            const int hoff = (n < 2) ? 4 * 65536 : 0;
#define EB_LOADB(b, p) do { if (n < 2) { _Pragma("unroll") for (int j = 0; j < 2; ++j) { g[p][j] = *(const u32x2*)(rg + (EB_OFF((b) * 2 + j)) + lg); h[p][j] = *(const u32x2*)(rg + (hoff + EB_OFF((b) * 2 + j)) + lg); } \
            sq[p] = *(const u32x2*)(rs_ + ((((b) >> 2) * 128 + ((b) & 3) * 16) * 8) + ls); } \
            else { _Pragma("unroll") for (int j = 0; j < 2; ++j) { g[p][j] = (u32x2){0x01010101u, 0x01010101u}; h[p][j] = (u32x2){0x01010101u, 0x01010101u}; } sq[p] = (u32x2){0x3f800000u, 0x3f800000u}; } } while (0)
#pragma unroll
            for (int b = 0; b < EB_RING; ++b) EB_LOADB(b, b);
#pragma unroll
            for (int b = 0; b < 8; ++b) {
                const int p = b % EB_RING;
                const unsigned sqx = sq[p].x, sqy = sq[p].y;
                const float rsn = rsqrtf((__builtin_bit_cast(float, sqx) + __builtin_bit_cast(float, sqy)) * (1.f / 1024.f) + EPS);
                const float rs = (n == 0) ? rsn : (n == 1) ? 1.f : 0.f;
#pragma unroll
                for (int j = 0; j < 2; ++j) {
                    const int k = b * 2 + j, ai = k >> 3, m = (k >> 1) & 3, bj = k & 1;
                    const f32x4 r0 = EB_CVT4(g[p][j].x) * EB_RCP4(h[p][j].x), r1 = EB_CVT4(g[p][j].y) * EB_RCP4(h[p][j].y);
                    acc[ai][bj][m][0] = (acc[ai][bj][m][0] * rs) * r0;
                    acc[ai][bj][m][1] = (acc[ai][bj][m][1] * rs) * r1;
                }
                if (b + EB_RING < 8) EB_LOADB(b + EB_RING, p);
                __builtin_amdgcn_sched_barrier(0);
            }
#undef EB_LOADB
        }
#undef EB_OFF
#undef EB_CVT4
#undef EB_RCP4
    }
};
struct SchedTile256 {
    int G, c;
    __device__ __forceinline__ bool next(int i, pg8::Unit& u) const {
        const int L = i * G + c; if (L >= 256) return false;
        const int wgid = (L % 8) * 32 + L / 8; u.pm = wgid >> 2; u.pn = wgid & 3; return true;
    }
    __device__ __forceinline__ void a_ready(const pg8::Unit&) const {}
    __device__ __forceinline__ void done(const pg8::Unit&) const {}
};
struct EpiOut {
    static constexpr bool PERM = true, AFTER_DRAIN = false, WANTS_SCRATCH = false, MUT_ACC = false;
    const float* X; float* X2; unsigned char* ws; const float* ln_ffn; int tok0;
    __device__ __forceinline__ void operator()(const f32x4 (&acc)[2][2][4][2], const pg8::Unit& u, int wr, int wc, int fr, int fq) const {
        float* const XSS = (float*)(ws + WS_XSS);
        const int rbase = tok0 + u.pm * 256 + wr * 64 + fr;
        const int cbase = u.pn * 256 + wc * 32 + 8 * fq;
#pragma unroll
        for (int pr = 0; pr < 4; ++pr) {
            f32x4 xr[2][2][2];
#pragma unroll
            for (int q = 0; q < 2; ++q) { const int k = pr * 2 + q, ai = k >> 2, m = k & 3; const size_t off = (size_t)(rbase + ai * 128 + m * 16) * 1024 + cbase;
#pragma unroll
                for (int bj = 0; bj < 2; ++bj) { xr[q][bj][0] = *(const f32x4*)(X + off + bj * 128); xr[q][bj][1] = *(const f32x4*)(X + off + bj * 128 + 4); } }
#pragma unroll
            for (int q = 0; q < 2; ++q) { const int k = pr * 2 + q, ai = k >> 2, m = k & 3; const int gt = rbase + ai * 128 + m * 16; const size_t off = (size_t)gt * 1024 + cbase; float ss = 0.f;
#pragma unroll
                for (int bj = 0; bj < 2; ++bj) {
                    const f32x4 v0 = acc[ai][bj][m][0] + xr[q][bj][0], v1 = acc[ai][bj][m][1] + xr[q][bj][1];
                    { u32x4 wx; wx.x = pk2(v0.x, v0.y); wx.y = pk2(v0.z, v0.w); wx.z = pk2(v1.x, v1.y); wx.w = pk2(v1.z, v1.w); *(u32x4*)((bf16_t*)X2 + off + bj * 128) = wx; }
                    ss += (v0.x * v0.x + v0.y * v0.y) + (v0.z * v0.z + v0.w * v0.w) + (v1.x * v1.x + v1.y * v1.y) + (v1.z * v1.z + v1.w * v1.w);
                }
                ss += __shfl_xor(ss, 16); ss += __shfl_xor(ss, 32); if (fq == 0) XSS[(size_t)gt * 16 + u.pn * 4 + wc] = ss; }
            __builtin_amdgcn_sched_barrier(0);
        }
    }
};

struct SchedStatic {
    int nM, nN, nwg, G, c;
    __device__ __forceinline__ bool next(int i, pg8::Unit& u) const {
        const int L = i * G + c; if (L >= nwg) return false;
        int wgid = L; { const int q = nwg / 8, r = nwg % 8, xcd = wgid % 8, off = wgid / 8; wgid = (xcd < r ? xcd * (q + 1) : r * (q + 1) + (xcd - r) * q) + off; }
        const int nig = 8 * nN, gid = wgid / nig, fm = gid * 8, gsz = (nM - fm) < 8 ? (nM - fm) : 8;
        u.pm = fm + ((wgid % nig) % gsz); u.pn = (wgid % nig) / gsz; return true;
    }
    __device__ __forceinline__ void a_ready(const pg8::Unit&) const {}
    __device__ __forceinline__ void done(const pg8::Unit&) const {}
};
struct EpiQ {
    static constexpr bool PERM = true, AFTER_DRAIN = false, WANTS_SCRATCH = true, MUT_ACC = false;
    unsigned char* ws;
    __device__ __forceinline__ void operator()(const f32x4 (&acc)[2][2][4][2], const pg8::Unit& u, int wr, int wc, int fr, int fq, bf16x8 (&sa)[4][2], bf16x8 (&sb0)[2][2], bf16x8 (&sb1)[2][2]) const {
        bf16_t* const Q2 = (bf16_t*)(ws + WS_Q2); const float* const XSS = (const float*)(ws + WS_XSS);
        const int rbase = u.pm * 256 + wr * 64 + fr;
        const int cbase = u.pn * 256 + wc * 32 + 8 * fq;
#define EQ_SLOT(i) ((i) < 8 ? sa[(i) >> 1][(i) & 1] : ((i) < 12 ? sb0[((i) - 8) >> 1][(i) & 1] : sb1[((i) - 12) >> 1][(i) & 1]))
#pragma unroll
        for (int ai = 0; ai < 2; ++ai) {
#pragma unroll
            for (int i = 0; i < 16; ++i) EQ_SLOT(i) = *(const bf16x8*)(XSS + (size_t)(rbase + ai * 128 + (i >> 2) * 16) * 16 + (i & 3) * 4);
#pragma unroll
            for (int m = 0; m < 4; ++m) {
                const int gt = rbase + ai * 128 + m * 16;
                const f32x4 a = __builtin_bit_cast(f32x4, EQ_SLOT(4 * m)), b = __builtin_bit_cast(f32x4, EQ_SLOT(4 * m + 1)), c = __builtin_bit_cast(f32x4, EQ_SLOT(4 * m + 2)), d = __builtin_bit_cast(f32x4, EQ_SLOT(4 * m + 3));
                const float ssq = (((a.x + a.y) + (a.z + a.w)) + ((b.x + b.y) + (b.z + b.w))) + (((c.x + c.y) + (c.z + c.w)) + ((d.x + d.y) + (d.z + d.w)));
                const float rs = rsqrtf(ssq * (1.f / 1024.f) + EPS);
#pragma unroll
                for (int bj = 0; bj < 2; ++bj) {
                    const f32x4 v0 = acc[ai][bj][m][0] * rs, v1 = acc[ai][bj][m][1] * rs;
                    u32x4 w; w.x = pk2(v0.x, v0.y); w.y = pk2(v0.z, v0.w); w.z = pk2(v1.x, v1.y); w.w = pk2(v1.z, v1.w);
                    *(u32x4*)(Q2 + (size_t)((((gt >> 4) * 8 + u.pn) * 2 + bj) * 2048 + wc * 512 + fr * 32 + fq * 8)) = w;
                }
            }
            __builtin_amdgcn_sched_barrier(0);
        }
#undef EQ_SLOT
    }
};

struct P67Ptrs { const bf16_t *Q2, *KEYS, *XB; const unsigned char *PU, *PV; const float *SU, *SV; unsigned short* EID; float* GATE; const float* XSS; float* X2; const float* ln_final; float *PD; bf16_t* PW; float* SS3; unsigned* q; };

__device__ __forceinline__ void p67_tile(const Ctx& C, const P67Ptrs& P, int tile) {
    LAS unsigned char* L = C.lds;
    const int tid = C.tid, lane = C.lane, wid = C.wid, fr = lane & 15, fq = lane >> 4;
    const int gt0 = tile * 128;
    constexpr int O_SC = 0, O_MG = 0, O_FK = 16384, O_WL = 135168, O_EL = 139264;
#ifndef REP_P6
#define REP_P6 1
#endif
#ifndef REP_U
#define REP_U 1
#endif
#ifndef REP_V
#define REP_V 1
#endif
    const int sci = wid >> 2, sctq = wid & 3;
    bf16x8 qf[2][4], kfa[4], kfb[4];
#define P6_LOADQ(H) do { _Pragma("unroll") for (int tt_ = 0; tt_ < 2; ++tt_) { _Pragma("unroll") for (int ks = 0; ks < 4; ++ks) \
        qf[tt_][ks] = *(const bf16x8*)(P.Q2 + (size_t)((((tile * 8 + 2 * sctq + tt_) * 8 + (H)) * 2 + sci) * 2048 + ks * 512 + fr * 32 + fq * 8)); } } while (0)
#define P6_LOADK(DST, H, JT) do { _Pragma("unroll") for (int ks = 0; ks < 4; ++ks) DST[ks] = *(const bf16x8*)(P.KEYS + (size_t)((H) * 2 + sci) * 16384 + (((JT) * 4 + ks) * 16 + fr) * 32 + fq * 8); } while (0)
#define P6_MMA(KF, JT) do { _Pragma("unroll") for (int tt_ = 0; tt_ < 2; ++tt_) { f32x4 a_ = {0.f, 0.f, 0.f, 0.f}; \
        _Pragma("unroll") for (int ks = 0; ks < 4; ++ks) a_ = mfma16(KF[ks], qf[tt_][ks], a_); \
        *(LAS f32x4*)(L + O_SC + ((sci * 128 + 32 * sctq + 16 * tt_ + fr) * 132 + 16 * (JT) + 4 * fq) * 4) = a_; } } while (0)
    u32x4 pe[2] = {{0u, 0u, 0u, 0u}, {0u, 0u, 0u, 0u}}; f32x4 pg[4] = {{0.f, 0.f, 0.f, 0.f}, {0.f, 0.f, 0.f, 0.f}, {0.f, 0.f, 0.f, 0.f}, {0.f, 0.f, 0.f, 0.f}};
#define P6_STORE_RES(H) do { unsigned short* ep_ = P.EID + (size_t)(gt0 + tid) * 128 + (H) * 16; float* gp_ = P.GATE + (size_t)(gt0 + tid) * 128 + (H) * 16; \
        *(u32x4*)ep_ = pe[0]; *(u32x4*)(ep_ + 8) = pe[1]; *(f32x4*)gp_ = pg[0]; *(f32x4*)(gp_ + 4) = pg[1]; *(f32x4*)(gp_ + 8) = pg[2]; *(f32x4*)(gp_ + 12) = pg[3]; } while (0)
    P6_LOADQ(0); P6_LOADK(kfa, 0, 0);
    for (int h6 = 0; h6 < 8 * REP_P6; ++h6) {
        const int h = h6 & 7;
        {
#pragma unroll
            for (int jt = 0; jt < 8; jt += 2) {
                P6_LOADK(kfb, h, jt + 1);
                P6_MMA(kfa, jt);
                __builtin_amdgcn_sched_barrier(0);
                if (jt + 2 < 8) P6_LOADK(kfa, h, jt + 2);
                P6_MMA(kfb, jt + 1);
                __builtin_amdgcn_sched_barrier(0);
            }
            if (tid < 128 && h6 > 0) P6_STORE_RES((h6 - 1) & 7);
            const int hn = (h6 + 1) & 7;
            if (h6 + 1 < 8 * REP_P6) { P6_LOADQ(hn); P6_LOADK(kfa, hn, 0); }
        }
        __syncthreads();
        const int tt = tid & 127, ii = (tid >> 7) & 1, hf = tid >> 8;
        unsigned list[16];
        {
            const LAS unsigned char* row = L + O_SC + ((ii * 128 + tt) * 132 + hf * 64) * 4;
#pragma unroll
            for (int e4 = 0; e4 < 4; ++e4) {
                const f32x4 v = *(const LAS f32x4*)(row + e4 * 16);
#pragma unroll
                for (int q = 0; q < 4; ++q) list[e4 * 4 + q] = (ord_key(v[q]) & ~127u) | (unsigned)(127 - (hf * 64 + e4 * 4 + q));
            }
            sort16(list);
#pragma unroll 1
            for (int gq = 1; gq < 4; ++gq) {
                unsigned grp[16];
#pragma unroll
                for (int e4 = 0; e4 < 4; ++e4) {
                    const f32x4 v = *(const LAS f32x4*)(row + (gq * 4 + e4) * 16);
#pragma unroll
                    for (int q = 0; q < 4; ++q) grp[e4 * 4 + q] = (ord_key(v[q]) & ~127u) | (unsigned)(127 - (hf * 64 + gq * 16 + e4 * 4 + q));
                }
                sort16(grp);
                merge16(list, grp);
            }
        }
        __syncthreads();
        if (hf == 1) {
#pragma unroll
            for (int j = 0; j < 16; ++j) *(LAS unsigned*)(L + O_MG + (j * 256 + (tid & 255)) * 4) = list[j];
        }
        __syncthreads();
        if (hf == 0) {
            unsigned other[16];
#pragma unroll
            for (int j = 0; j < 16; ++j) other[j] = *(const LAS unsigned*)(L + O_MG + (j * 256 + tid) * 4);
            merge16(list, other);
#pragma unroll
            for (int j = 0; j < 16; ++j) *(LAS unsigned*)(L + O_FK + ((ii * 16 + j) * 128 + tt) * 4) = list[j];
        }
        __syncthreads();
        unsigned cl[16];
        if (tid < 256) {
            const int tk = tid & 127, role = tid >> 7;
            float v1[16], v2[16];
#pragma unroll
            for (int a = 0; a < 16; ++a) { v1[a] = unord_key(*(const LAS unsigned*)(L + O_FK + ((0 * 16 + a) * 128 + tk) * 4) & ~127u); v2[a] = unord_key(*(const LAS unsigned*)(L + O_FK + ((1 * 16 + a) * 128 + tk) * 4) & ~127u); }
#define P6_KEY(a, b) ((ord_key(v1[a] + v2[b]) & ~255u) | (unsigned)(255 - ((a) * 16 + (b))))
            if (role == 0) {
                unsigned lb[16];
#pragma unroll
                for (int b = 0; b < 16; ++b) cl[b] = P6_KEY(0, b);
#pragma unroll
                for (int b = 0; b < 8; ++b) lb[b] = P6_KEY(1, b);
#pragma unroll
                for (int b = 0; b < 5; ++b) lb[8 + b] = P6_KEY(2, b);
#pragma unroll
                for (int b = 0; b < 3; ++b) lb[13 + b] = P6_KEY(3, b);
                sort16(lb);
                merge16(cl, lb);
                ins16(cl, P6_KEY(3, 3));
            } else {
                cl[0] = P6_KEY(4, 0); cl[1] = P6_KEY(4, 1); cl[2] = P6_KEY(4, 2); cl[3] = P6_KEY(5, 0); cl[4] = P6_KEY(5, 1); cl[5] = P6_KEY(6, 0); cl[6] = P6_KEY(6, 1); cl[7] = P6_KEY(7, 0);
                cl[8] = P6_KEY(7, 1); cl[9] = P6_KEY(8, 0); cl[10] = P6_KEY(9, 0); cl[11] = P6_KEY(10, 0); cl[12] = P6_KEY(11, 0); cl[13] = P6_KEY(12, 0); cl[14] = P6_KEY(13, 0); cl[15] = P6_KEY(14, 0);
                sort16(cl);
                ins16(cl, P6_KEY(15, 0));
#pragma unroll
                for (int j = 0; j < 16; ++j) *(LAS unsigned*)(L + O_MG + (j * 128 + tk) * 4) = cl[j];
            }
        }
        __syncthreads();
        if (tid < 128) {
            unsigned other[16];
#pragma unroll
            for (int j = 0; j < 16; ++j) other[j] = *(const LAS unsigned*)(L + O_MG + (j * 128 + tid) * 4);
            merge16(cl, other);
            float val[16]; int eid[16]; float mx = -3.0e38f;
#pragma unroll
            for (int j = 0; j < 16; ++j) {
                const int pos = 255 - (int)(cl[j] & 255u), a = pos >> 4, b = pos & 15;
                const unsigned ka = *(const LAS unsigned*)(L + O_FK + ((0 * 16 + a) * 128 + tid) * 4), kb = *(const LAS unsigned*)(L + O_FK + ((1 * 16 + b) * 128 + tid) * 4);
                val[j] = unord_key(ka & ~127u) + unord_key(kb & ~127u);
                eid[j] = (127 - (int)(ka & 127u)) * 128 + (127 - (int)(kb & 127u));
                mx = fmaxf(mx, val[j]);
            }
            float sum = 0.f;
#pragma unroll
            for (int j = 0; j < 16; ++j) { val[j] = __expf(val[j] - mx); sum += val[j]; }
            const float inv = 1.f / sum;
#pragma unroll
            for (int j = 0; j < 16; j += 8) pe[j >> 3] = (u32x4){(unsigned)eid[j] | ((unsigned)eid[j + 1] << 16), (unsigned)eid[j + 2] | ((unsigned)eid[j + 3] << 16), (unsigned)eid[j + 4] | ((unsigned)eid[j + 5] << 16), (unsigned)eid[j + 6] | ((unsigned)eid[j + 7] << 16)};
#pragma unroll
            for (int j = 0; j < 16; j += 4) pg[j >> 2] = (f32x4){val[j] * inv, val[j + 1] * inv, val[j + 2] * inv, val[j + 3] * inv};
        }
        __syncthreads();
    }
    if (tid < 128) P6_STORE_RES(7);
#undef P6_STORE_RES
}

#undef P6_LOADK
#undef P6_LOADQ
#undef P6_MMA
template <class F>
__device__ __forceinline__ void sliced_items(const Ctx& C, unsigned* q8, F&& item) {
    LAS int* slot = (LAS int*)(C.lds + LDS_BYTES - 16);
    const int x0 = (int)(xb_xcc_id() & 7u);
    for (int k = 0; k < 8; ++k) {
        const int x = (x0 + k) & 7;
        for (;;) {
            __syncthreads();
            if (C.tid == 0) *slot = (int)atomicAdd(q8 + x * 16, 1u);
            __syncthreads();
            const int it = *slot;
            if (it >= 128) break;
            item(x, it);
        }
    }
}
__device__ __forceinline__ void peer_u_item(const Ctx& C, const P67Ptrs& P, int x, int tile) {
    LAS unsigned char* L = C.lds;
    const int tid = C.tid, lane = C.lane, wid = C.wid, g8 = lane >> 3, s8 = lane & 7;
    const int gt0 = tile * 256;
    {
        const u32x4* src = (const u32x4*)(P.EID + (size_t)gt0 * 128);
#pragma unroll
        for (int i = 0; i < 8; ++i) *(LAS u32x4*)(L + (size_t)(tid + i * NTHR) * 16) = src[tid + i * NTHR];
    }
    __syncthreads();
    const int c0 = 128 * x + 16 * s8;
    for (int batch = 0; batch < 4; ++batch) {
        const int t = 32 * wid + 8 * batch + g8, gt = gt0 + t;
        f2v xf[8];
        { const bf16_t* x2h = (const bf16_t*)P.X2; const u32x4 a = *(const u32x4*)(x2h + (size_t)gt * 1024 + c0), b = *(const u32x4*)(x2h + (size_t)gt * 1024 + c0 + 8);
          xf[0] = (f2v){bf_lo(a.x), bf_hi(a.x)}; xf[1] = (f2v){bf_lo(a.y), bf_hi(a.y)}; xf[2] = (f2v){bf_lo(a.z), bf_hi(a.z)}; xf[3] = (f2v){bf_lo(a.w), bf_hi(a.w)};
          xf[4] = (f2v){bf_lo(b.x), bf_hi(b.x)}; xf[5] = (f2v){bf_lo(b.y), bf_hi(b.y)}; xf[6] = (f2v){bf_lo(b.z), bf_hi(b.z)}; xf[7] = (f2v){bf_lo(b.w), bf_hi(b.w)}; }
        unsigned* pd = (unsigned*)P.PD + ((size_t)x * T_ALL + gt) * 64 + s8;
        float plo = 0.f;
#pragma unroll 2
        for (int p8 = 0; p8 < 16; ++p8) {
            const u32x4 ew = *(const LAS u32x4*)(L + (t * 128 + 8 * p8) * 2);
            const unsigned e[8] = {ew.x & 0xffffu, ew.x >> 16, ew.y & 0xffffu, ew.y >> 16, ew.z & 0xffffu, ew.z >> 16, ew.w & 0xffffu, ew.w >> 16};
            u32x4 q[8];
#pragma unroll
            for (int k = 0; k < 8; ++k) q[k] = *(const u32x4*)(P.PU + (size_t)x * (16384 * 128) + (size_t)e[k] * 128 + 16 * s8);
            float d[8];
#pragma unroll
            for (int k = 0; k < 8; ++k) { f2v a2 = {0.f, 0.f};
#pragma unroll
                for (int j = 0; j < 4; ++j) { a2 = __builtin_amdgcn_cvt_pk_f32_fp8((int)q[k][j], false) * xf[2 * j] + a2; a2 = __builtin_amdgcn_cvt_pk_f32_fp8((int)q[k][j], true) * xf[2 * j + 1] + a2; }
                d[k] = a2.x + a2.y; }
            float r4[4], r2[2];
#pragma unroll
            for (int i = 0; i < 4; ++i) { const float keep = (s8 & 4) ? d[i + 4] : d[i], send = (s8 & 4) ? d[i] : d[i + 4]; r4[i] = keep + __shfl_xor(send, 4); }
#pragma unroll
            for (int i = 0; i < 2; ++i) { const float keep = (s8 & 2) ? r4[i + 2] : r4[i], send = (s8 & 2) ? r4[i] : r4[i + 2]; r2[i] = keep + __shfl_xor(send, 2); }
            { const float keep = (s8 & 1) ? r2[1] : r2[0], send = (s8 & 1) ? r2[0] : r2[1]; const float tot = keep + __shfl_xor(send, 1);
              if (p8 & 1) pd[8 * (p8 >> 1)] = pk2(plo, tot); else plo = tot; }
        }
    }
}
__device__ __forceinline__ void peer_w_phase(const Ctx& C, const P67Ptrs& P) {
    const int gw = C.bid * 8 + C.wid, NGW = C.G * 8, lane = C.lane;
    const int p0 = 16 * (lane >> 3) + (lane & 7), p1 = p0 + 8;
    const unsigned* PDw = (const unsigned*)P.PD;
    for (int g0 = gw; g0 < T_ALL; g0 += 4 * NGW) {
        f32x4 xs[4][4]; unsigned w[4][8]; int e0[4], e1[4]; float ga0[4], ga1[4];
#pragma unroll
        for (int u = 0; u < 4; ++u) {
            const int gt = (g0 + u * NGW < T_ALL) ? g0 + u * NGW : g0;
            const float* xp = P.XSS + (size_t)gt * 16;
            xs[u][0] = *(const f32x4*)xp; xs[u][1] = *(const f32x4*)(xp + 4); xs[u][2] = *(const f32x4*)(xp + 8); xs[u][3] = *(const f32x4*)(xp + 12);
#pragma unroll
            for (int x = 0; x < 8; ++x) w[u][x] = PDw[((size_t)x * T_ALL + gt) * 64 + lane];
            e0[u] = P.EID[(size_t)gt * 128 + p0]; e1[u] = P.EID[(size_t)gt * 128 + p1];
            ga0[u] = P.GATE[(size_t)gt * 128 + p0]; ga1[u] = P.GATE[(size_t)gt * 128 + p1];
        }
        float sv0[4], sv1[4], su0[4], su1[4];
#pragma unroll
        for (int u = 0; u < 4; ++u) { sv0[u] = P.SV[e0[u]]; sv1[u] = P.SV[e1[u]]; su0[u] = P.SU[e0[u]]; su1[u] = P.SU[e1[u]]; }
#pragma unroll
        for (int u = 0; u < 4; ++u) {
            if (g0 + u * NGW < T_ALL) {
                const int gt = g0 + u * NGW;
                const f32x4 a = xs[u][0], b = xs[u][1], c = xs[u][2], d = xs[u][3];
                const float ssq = (((a.x + a.y) + (a.z + a.w)) + ((b.x + b.y) + (b.z + b.w))) + (((c.x + c.y) + (c.z + c.w)) + ((d.x + d.y) + (d.z + d.w)));
                const float rstd = rsqrtf(ssq * (1.f / 1024.f) + EPS);
                float s0 = 0.f, s1 = 0.f;
#pragma unroll
                for (int x = 0; x < 8; ++x) { s0 += bf_lo(w[u][x]); s1 += bf_hi(w[u][x]); }
                const size_t i0 = (size_t)gt * 128 + p0, i1 = (size_t)gt * 128 + p1;
                P.PW[i0] = (bf16_t)(pk2(ga0[u] * sv0[u] * gelu_f(s0 * su0[u] * rstd), 0.f) & 0xffffu);
                P.PW[i1] = (bf16_t)(pk2(ga1[u] * sv1[u] * gelu_f(s1 * su1[u] * rstd), 0.f) & 0xffffu);
            }
        }
    }
}
__device__ __forceinline__ void peer_v_item(const Ctx& C, const P67Ptrs& P, int x, int tile) {
    LAS unsigned char* L = C.lds;
    const int tid = C.tid, lane = C.lane, wid = C.wid, g8 = lane >> 3, s8 = lane & 7;
    const int gt0 = tile * 256;
    {
        const u32x4* se = (const u32x4*)(P.EID + (size_t)gt0 * 128); const u32x4* sw = (const u32x4*)(P.PW + (size_t)gt0 * 128);
#pragma unroll
        for (int i = 0; i < 8; ++i) { *(LAS u32x4*)(L + (size_t)(tid + i * NTHR) * 16) = se[tid + i * NTHR]; *(LAS u32x4*)(L + 65536 + (size_t)(tid + i * NTHR) * 16) = sw[tid + i * NTHR]; }
    }
    __syncthreads();
    const int c0 = 128 * x + 16 * s8;
    for (int batch = 0; batch < 4; ++batch) {
        const int t = 32 * wid + 8 * batch + g8, gt = gt0 + t;
        f2v acc[8];
#pragma unroll
        for (int j = 0; j < 8; ++j) acc[j] = (f2v){0.f, 0.f};
#pragma unroll 2
        for (int p8 = 0; p8 < 16; ++p8) {
            const u32x4 ew = *(const LAS u32x4*)(L + (t * 128 + 8 * p8) * 2), ww = *(const LAS u32x4*)(L + 65536 + (t * 128 + 8 * p8) * 2);
            const unsigned e[8] = {ew.x & 0xffffu, ew.x >> 16, ew.y & 0xffffu, ew.y >> 16, ew.z & 0xffffu, ew.z >> 16, ew.w & 0xffffu, ew.w >> 16};
            const float w[8] = {bf_lo(ww.x), bf_hi(ww.x), bf_lo(ww.y), bf_hi(ww.y), bf_lo(ww.z), bf_hi(ww.z), bf_lo(ww.w), bf_hi(ww.w)};
            u32x4 q[8];
#pragma unroll
            for (int k = 0; k < 8; ++k) q[k] = *(const u32x4*)(P.PV + (size_t)x * (16384 * 128) + (size_t)e[k] * 128 + 16 * s8);
#pragma unroll
            for (int k = 0; k < 8; ++k) { const f2v w2 = {w[k], w[k]};
#pragma unroll
                for (int j = 0; j < 4; ++j) { acc[2 * j] = __builtin_amdgcn_cvt_pk_f32_fp8((int)q[k][j], false) * w2 + acc[2 * j]; acc[2 * j + 1] = __builtin_amdgcn_cvt_pk_f32_fp8((int)q[k][j], true) * w2 + acc[2 * j + 1]; } }
        }
        const bf16_t* xi = (const bf16_t*)P.X2 + (size_t)gt * 1024 + c0; bf16_t* so = (bf16_t*)P.XB + (size_t)gt * 1024 + c0; float ss = 0.f;
        const u32x4 xa = *(const u32x4*)xi, xb = *(const u32x4*)(xi + 8);
        const unsigned xw[8] = {xa.x, xa.y, xa.z, xa.w, xb.x, xb.y, xb.z, xb.w};
        unsigned ow[8];
#pragma unroll
        for (int i = 0; i < 8; ++i) { const float s0 = bf_lo(xw[i]) + acc[i].x, s1 = bf_hi(xw[i]) + acc[i].y; ss += s0 * s0 + s1 * s1; ow[i] = pk2(s0, s1); }
        *(u32x4*)so = (u32x4){ow[0], ow[1], ow[2], ow[3]}; *(u32x4*)(so + 8) = (u32x4){ow[4], ow[5], ow[6], ow[7]};
        ss += __shfl_xor(ss, 1); ss += __shfl_xor(ss, 2); ss += __shfl_xor(ss, 4);
        if (s8 == 0) P.SS3[(size_t)gt * 8 + x] = ss;
    }
}
__device__ __forceinline__ void peer_final_phase(const Ctx& C, const P67Ptrs& P) {
    const int gw = C.bid * 8 + C.wid, NGW = C.G * 8, lane = C.lane;
    const f32x4* gr = (const f32x4*)P.ln_final;
    for (int g0 = gw; g0 < T_ALL; g0 += 2 * NGW) {
        const int gtA = g0, gtB = (g0 + NGW < T_ALL) ? g0 + NGW : g0;
        const f32x4 saA = *(const f32x4*)(P.SS3 + (size_t)gtA * 8), sbA = *(const f32x4*)(P.SS3 + (size_t)gtA * 8 + 4), saB = *(const f32x4*)(P.SS3 + (size_t)gtB * 8), sbB = *(const f32x4*)(P.SS3 + (size_t)gtB * 8 + 4);
        const bf16_t* srcA = P.XB + (size_t)gtA * 1024 + lane * 4; const bf16_t* srcB = P.XB + (size_t)gtB * 1024 + lane * 4;
        f32x4* rowA = (f32x4*)(P.X2 + (size_t)gtA * 1024); f32x4* rowB = (f32x4*)(P.X2 + (size_t)gtB * 1024);
        u32x2 vA[4], vB[4];
#pragma unroll
        for (int j = 0; j < 4; ++j) { vA[j] = *(const u32x2*)(srcA + 256 * j); vB[j] = *(const u32x2*)(srcB + 256 * j); }
        const float rA = rsqrtf((((saA.x + saA.y) + (saA.z + saA.w)) + ((sbA.x + sbA.y) + (sbA.z + sbA.w))) * (1.f / 1024.f) + EPS);
        const float rB = rsqrtf((((saB.x + saB.y) + (saB.z + saB.w)) + ((sbB.x + sbB.y) + (sbB.z + sbB.w))) * (1.f / 1024.f) + EPS);
#pragma unroll
        for (int j = 0; j < 4; ++j) { const f32x4 g = gr[lane + 64 * j]; rowA[lane + 64 * j] = (f32x4){bf_lo(vA[j].x) * rA * g.x, bf_hi(vA[j].x) * rA * g.y, bf_lo(vA[j].y) * rA * g.z, bf_hi(vA[j].y) * rA * g.w}; }
        if (g0 + NGW < T_ALL) {
#pragma unroll
            for (int j = 0; j < 4; ++j) { const f32x4 g = gr[lane + 64 * j]; rowB[lane + 64 * j] = (f32x4){bf_lo(vB[j].x) * rB * g.x, bf_hi(vB[j].x) * rB * g.y, bf_lo(vB[j].y) * rB * g.z, bf_hi(vB[j].y) * rB * g.w}; }
        }
    }
}

#ifndef MK_MULTI
#define MK_MULTI 0
#endif
constexpr int NSEG = 18;

__global__ void __launch_bounds__(NTHR, 2) fwd_megakernel(Params prm) {
    extern __shared__ __attribute__((aligned(16))) unsigned char lds_raw[];
    LAS unsigned char* const lds = (LAS unsigned char*)lds_raw;
    const int wv = __builtin_amdgcn_readfirstlane((int)(threadIdx.x >> 6));
    const int lo = prm.seg_lo, hi = prm.seg_hi;
#if MK_MULTI
#define GSYNC(k) do {} while (0)
#else
    cg::grid_group grid = cg::this_grid();
    volatile LAS unsigned* xb_st = (volatile LAS unsigned*)(lds + LDS_BYTES - 32);
    if (threadIdx.x == 0) { xb_st[0] = 0u; xb_st[1] = 0u; }
    __syncthreads();
    (void)xcd_barrier_post((unsigned)wv, (unsigned*)(prm.ws + WS_BAR), xb_st);
#define XBAR_NOW() XcdBarrier{(unsigned)wv, (unsigned*)(ka_ws(kargs()) + WS_BAR), xb_xcc_id(), (volatile LAS unsigned*)((LAS unsigned char*)lds_raw + LDS_BYTES - 32)}
#define GSYNC(k) do { if (lo <= (k) && (k) + 1 < hi) { const XcdBarrier xb_ = XBAR_NOW(); xcd_barrier(xb_); } } while (0)
    if (lo < -1000) { asm volatile("s_waitcnt vmcnt(0)" ::: "memory"); __builtin_amdgcn_fence(__ATOMIC_RELEASE, FSCOPE); grid.sync(); __builtin_amdgcn_fence(__ATOMIC_ACQUIRE, FSCOPE); }
#endif
#ifndef SEGMASK
#define SEGMASK 0x3ffff
#endif
#ifndef REP_G1
#define REP_G1 1
#endif
#ifndef STAG1
#define STAG1 0
#endif
#ifndef REP_G3
#define REP_G3 1
#endif
#ifndef REP_NOOP
#define REP_NOOP 0
#endif
#ifndef REP_G4
#define REP_G4 1
#endif
#ifndef REP_G5
#define REP_G5 1
#endif
#ifndef REP_P0
#define REP_P0 1
#endif
#define SEG(k) if (((SEGMASK >> (k)) & 1) && lo <= (k) && (k) < hi)

    SEG(0) { const Ctx C = fresh_ctx(lds, wv); for (int rep = 0; rep < REP_P0; ++rep) { p0_prep(C); __syncthreads(); } }
    GSYNC(0);
#define MAKE_P2PTRS() const Ctx C = fresh_ctx(lds, wv); const kaptr_t ka = kargs(); unsigned char* ws = ka_ws(ka); unsigned char* sl = ws + WS_SLAB; \
                P2Ptrs P{(bf16_t*)(sl + SL_YB), (bf16_t*)(sl + SL_XBC), (bf16_t*)(ka_out(ka) + (size_t)TS * 1024), (bf16_t*)(ws + WS_KB), (bf16_t*)(ws + WS_VT), (bf16_t*)(ws + WS_WSP), \
                         (float*)(ws + WS_DT), (float*)(ws + WS_VSS), (float*)(ws + WS_SSS), \
                         (bf16_t*)(ws + WS_H) + (size_t)slab * TS * 1024, (bf16_t*)(ka_out(ka) + (size_t)TS * 1024) + (size_t)TS * 1024, (float*)(ws + WS_CTL + 8192), \
                         ka_in(ka, I_CONV_W), ka_in(ka, I_CONV_B), ka_in(ka, I_A_LOG), ka_in(ka, I_D_SKIP), ka_in(ka, I_SSD_NORM), ka_in(ka, I_GMLP_NORM), ka_in(ka, I_B_SPATIAL), slab * TS, slab}
    {
        constexpr int slab = 0;
        const int sb = 1 + 5 * slab;
        SEG(sb) {
            if (slab > 0) {
                const Ctx C = fresh_ctx(lds, wv); const kaptr_t ka = kargs(); unsigned char* ws = ka_ws(ka);
                const int ps = slab - 1;
                pg8::Gemm g{(bf16_t*)(ws + WS_H) + (size_t)ps * TS * 1024, (bf16_t*)(ws + WS_WO), 0, 0, 1024};
                SchedTile256 S{C.G, C.bid};
                EpiOut E{ka_in(ka, I_X), ka_out(ka), ws, ka_in(ka, I_LN_FFN), ps * TS};
                for (int rep = 0; rep < REP_G4; ++rep) pg8::gemm_phase<EpiOut, SchedTile256>(C.lds, g, S, E, nullptr, wv);
            }
            if (slab < 2) {
                const Ctx C = fresh_ctx(lds, wv); const kaptr_t ka = kargs(); unsigned char* ws = ka_ws(ka);
                pg8::Gemm g{(bf16_t*)(ws + WS_H), (bf16_t*)(ws + WS_WINKV), 0, 0, 1024};
                SchedInProj S{slab, C.G, C.bid};
                EpiInProj E{ws, (bf16_t*)(ka_out(ka) + (size_t)TS * 1024), ka_in(ka, I_DT_BIAS), slab * TS};
                for (int sl_ = 0; sl_ < STAG1 * ((C.bid >> 5) & 1); ++sl_) __builtin_amdgcn_s_sleep(127);
                for (int rep = 0; rep < REP_G1; ++rep) pg8::gemm_phase<EpiInProj, SchedInProj>(C.lds, g, S, E, nullptr, wv);
            }
        }
        GSYNC(sb);
        if (slab < 2) {
            SEG(sb + 1) { MAKE_P2PTRS(); p2_mixers(C, P, (unsigned*)(ws + WS_CTL) + slab); }
            GSYNC(sb + 1);
            SEG(sb + 2) { MAKE_P2PTRS(); p2_scan(C, P); }
            GSYNC(sb + 2);
            SEG(sb + 3) { MAKE_P2PTRS(); p2_pass_c(C, P); }
            GSYNC(sb + 3);
            SEG(sb + 4) {
                const Ctx C = fresh_ctx(lds, wv); const kaptr_t ka = kargs(); unsigned char* ws = ka_ws(ka); unsigned char* sl = ws + WS_SLAB;
                pg8::Gemm g{(bf16_t*)(sl + SL_YB), (bf16_t*)(ws + WS_WB), 0, 0, 1024};
                SchedBranch S{C.G, C.bid};
                EpiBranch E{ws, slab * TS, 0};
#ifndef STAG3
#define STAG3 0
#endif
                for (int sl_ = 0; sl_ < STAG3 * ((C.bid >> 3) & 3); ++sl_) __builtin_amdgcn_s_sleep(127);
                for (int rep = 0; rep < REP_G3; ++rep) { E.noop = (rep > 0) ? REP_NOOP : 0; pg8::gemm_phase<EpiBranch, SchedBranch>(C.lds, g, S, E, nullptr, wv); }
            }
            GSYNC(sb + 4);
        }
    }
    {
        constexpr int slab = 1;
        const int sb = 1 + 5 * slab;
        SEG(sb) {
            if (slab > 0) {
                const Ctx C = fresh_ctx(lds, wv); const kaptr_t ka = kargs(); unsigned char* ws = ka_ws(ka);
                const int ps = slab - 1;
                pg8::Gemm g{(bf16_t*)(ws + WS_H) + (size_t)ps * TS * 1024, (bf16_t*)(ws + WS_WO), 0, 0, 1024};
                SchedTile256 S{C.G, C.bid};
                EpiOut E{ka_in(ka, I_X), ka_out(ka), ws, ka_in(ka, I_LN_FFN), ps * TS};
                for (int rep = 0; rep < REP_G4; ++rep) pg8::gemm_phase<EpiOut, SchedTile256>(C.lds, g, S, E, nullptr, wv);
            }
            if (slab < 2) {
                const Ctx C = fresh_ctx(lds, wv); const kaptr_t ka = kargs(); unsigned char* ws = ka_ws(ka);
                pg8::Gemm g{(bf16_t*)(ws + WS_H), (bf16_t*)(ws + WS_WINKV), 0, 0, 1024};
                SchedInProj S{slab, C.G, C.bid};
                EpiInProj E{ws, (bf16_t*)(ka_out(ka) + (size_t)TS * 1024), ka_in(ka, I_DT_BIAS), slab * TS};
                for (int sl_ = 0; sl_ < STAG1 * ((C.bid >> 5) & 1); ++sl_) __builtin_amdgcn_s_sleep(127);
                for (int rep = 0; rep < REP_G1; ++rep) pg8::gemm_phase<EpiInProj, SchedInProj>(C.lds, g, S, E, nullptr, wv);
            }
        }
        GSYNC(sb);
        if (slab < 2) {
            SEG(sb + 1) { MAKE_P2PTRS(); p2_mixers(C, P, (unsigned*)(ws + WS_CTL) + slab); }
            GSYNC(sb + 1);
            SEG(sb + 2) { MAKE_P2PTRS(); p2_scan(C, P); }
            GSYNC(sb + 2);
            SEG(sb + 3) { MAKE_P2PTRS(); p2_pass_c(C, P); }
            GSYNC(sb + 3);
            SEG(sb + 4) {
                const Ctx C = fresh_ctx(lds, wv); const kaptr_t ka = kargs(); unsigned char* ws = ka_ws(ka); unsigned char* sl = ws + WS_SLAB;
                pg8::Gemm g{(bf16_t*)(sl + SL_YB), (bf16_t*)(ws + WS_WB), 0, 0, 1024};
                SchedBranch S{C.G, C.bid};
                EpiBranch E{ws, slab * TS, 0};
#ifndef STAG3
#define STAG3 0
#endif
                for (int sl_ = 0; sl_ < STAG3 * ((C.bid >> 3) & 3); ++sl_) __builtin_amdgcn_s_sleep(127);
                for (int rep = 0; rep < REP_G3; ++rep) { E.noop = (rep > 0) ? REP_NOOP : 0; pg8::gemm_phase<EpiBranch, SchedBranch>(C.lds, g, S, E, nullptr, wv); }
            }
            GSYNC(sb + 4);
        }
    }
    {
        constexpr int slab = 2;
        const int sb = 1 + 5 * slab;
        SEG(sb) {
            if (slab > 0) {
                const Ctx C = fresh_ctx(lds, wv); const kaptr_t ka = kargs(); unsigned char* ws = ka_ws(ka);
                const int ps = slab - 1;
                pg8::Gemm g{(bf16_t*)(ws + WS_H) + (size_t)ps * TS * 1024, (bf16_t*)(ws + WS_WO), 0, 0, 1024};
                SchedTile256 S{C.G, C.bid};
                EpiOut E{ka_in(ka, I_X), ka_out(ka), ws, ka_in(ka, I_LN_FFN), ps * TS};
                for (int rep = 0; rep < REP_G4; ++rep) pg8::gemm_phase<EpiOut, SchedTile256>(C.lds, g, S, E, nullptr, wv);
            }
            if (slab < 2) {
                const Ctx C = fresh_ctx(lds, wv); const kaptr_t ka = kargs(); unsigned char* ws = ka_ws(ka);
                pg8::Gemm g{(bf16_t*)(ws + WS_H), (bf16_t*)(ws + WS_WINKV), 0, 0, 1024};
                SchedInProj S{slab, C.G, C.bid};
                EpiInProj E{ws, (bf16_t*)(ka_out(ka) + (size_t)TS * 1024), ka_in(ka, I_DT_BIAS), slab * TS};
                for (int sl_ = 0; sl_ < STAG1 * ((C.bid >> 5) & 1); ++sl_) __builtin_amdgcn_s_sleep(127);
                for (int rep = 0; rep < REP_G1; ++rep) pg8::gemm_phase<EpiInProj, SchedInProj>(C.lds, g, S, E, nullptr, wv);
            }
        }
        GSYNC(sb);
        if (slab < 2) {
            SEG(sb + 1) { MAKE_P2PTRS(); p2_mixers(C, P, (unsigned*)(ws + WS_CTL) + slab); }
            GSYNC(sb + 1);
            SEG(sb + 2) { MAKE_P2PTRS(); p2_scan(C, P); }
            GSYNC(sb + 2);
            SEG(sb + 3) { MAKE_P2PTRS(); p2_pass_c(C, P); }
            GSYNC(sb + 3);
            SEG(sb + 4) {
                const Ctx C = fresh_ctx(lds, wv); const kaptr_t ka = kargs(); unsigned char* ws = ka_ws(ka); unsigned char* sl = ws + WS_SLAB;
                pg8::Gemm g{(bf16_t*)(sl + SL_YB), (bf16_t*)(ws + WS_WB), 0, 0, 1024};
                SchedBranch S{C.G, C.bid};
                EpiBranch E{ws, slab * TS, 0};
#ifndef STAG3
#define STAG3 0
#endif
                for (int sl_ = 0; sl_ < STAG3 * ((C.bid >> 3) & 3); ++sl_) __builtin_amdgcn_s_sleep(127);
                for (int rep = 0; rep < REP_G3; ++rep) { E.noop = (rep > 0) ? REP_NOOP : 0; pg8::gemm_phase<EpiBranch, SchedBranch>(C.lds, g, S, E, nullptr, wv); }
            }
            GSYNC(sb + 4);
        }
    }
    SEG(12) {
        const Ctx C = fresh_ctx(lds, wv); const kaptr_t ka = kargs(); unsigned char* ws = ka_ws(ka);
        pg8::Gemm g{(bf16_t*)ka_out(ka), (bf16_t*)(ws + WS_WQ), 0, 0, 1024};
        SchedStatic S{128, 8, 1024, C.G, C.bid};
        EpiQ E{ws};
        for (int rep = 0; rep < REP_G5; ++rep) pg8::gemm_phase<EpiQ, SchedStatic>(C.lds, g, S, E, nullptr, wv);
    }
    GSYNC(12);
#define MAKE_P67() const Ctx C = fresh_ctx(lds, wv); const kaptr_t ka = kargs(); unsigned char* ws = ka_ws(ka); \
        P67Ptrs P{(bf16_t*)(ws + WS_Q2), (bf16_t*)(ws + WS_KEYS), (bf16_t*)(ws + WS_XB), ws + WS_PU, ws + WS_PV, (float*)(ws + WS_SU), (float*)(ws + WS_SV), \
                  (unsigned short*)(ws + WS_EID), (float*)(ws + WS_GATE), (float*)(ws + WS_XSS), ka_out(ka), ka_in(ka, I_LN_FINAL), (float*)(ws + WS_PD), (bf16_t*)(ws + WS_PW), (float*)(ws + WS_SS3), (unsigned*)(ws + WS_CTL)}
    SEG(13) { MAKE_P67(); for (int tile = C.bid; tile < 256; tile += C.G) { p67_tile(C, P, tile); __syncthreads(); } }
    GSYNC(13);
    SEG(14) { MAKE_P67(); sliced_items(C, P.q + 128, [&](int x, int it) { peer_u_item(C, P, x, it); }); }
    GSYNC(14);
    SEG(15) { MAKE_P67(); peer_w_phase(C, P); }
    GSYNC(15);
    SEG(16) { MAKE_P67(); sliced_items(C, P.q + 256, [&](int x, int it) { peer_v_item(C, P, x, it); }); }
    GSYNC(16);
    SEG(17) { MAKE_P67(); peer_final_phase(C, P); }
#ifdef DBG_STOP
    {
        asm volatile("s_waitcnt vmcnt(0)" ::: "memory"); __builtin_amdgcn_fence(__ATOMIC_RELEASE, FSCOPE); asm volatile("s_waitcnt vmcnt(0)" ::: "memory");
        grid.sync(); __builtin_amdgcn_fence(__ATOMIC_ACQUIRE, FSCOPE); asm volatile("s_waitcnt vmcnt(0)" ::: "memory");
        const kaptr_t ka = kargs(); unsigned char* ws = ka_ws(ka); float* out = ka_out(ka); unsigned char* sl = ws + WS_SLAB;
        const size_t n = (size_t)TS * 1024;
        const bf16_t* YB = (const bf16_t*)(sl + SL_YB); const bf16_t* XBC = (const bf16_t*)(sl + SL_XBC); const bf16_t* SG = (const bf16_t*)(sl + SL_SG);
        const bf16_t* KB = (const bf16_t*)(ws + WS_KB); const bf16_t* VT = (const bf16_t*)(ws + WS_VT); const bf16_t* MB = (const bf16_t*)(ws + WS_H); const bf16_t* XB = (const bf16_t*)(ws + WS_XB);
        const float* DT = (const float*)(ws + WS_DT); const float* VSS = (const float*)(ws + WS_VSS); const float* SSS = (const float*)(ws + WS_SSS); const float* XSS = (const float*)(ws + WS_XSS);
        float cnt_val = 0.f;
#ifdef CNT_TEST
        { const unsigned* q = (const unsigned*)(ws + WS_CTL) + 64; int bad = 0; for (int k = 0; k < 1664; ++k) bad += (q[k] != 1u) ? 1 : 0; cnt_val = 1.f + (float)bad; }
#endif
        for (size_t i = (size_t)blockIdx.x * NTHR + threadIdx.x; i < n; i += (size_t)gridDim.x * NTHR) {
            float v = 0.f;
#define BFV(p, idx) __uint_as_float(((unsigned)(p)[idx]) << 16)
#ifndef DUMPMASK
#define DUMPMASK 7
#endif
#ifdef XCOPY
            if (DUMPMASK & 16) v += BFV(XBC, i);
#endif
            if (DUMPMASK & 32) v += BFV(VT, i % ((size_t)2048 * 1024));
            if (DUMPMASK & 64) v += BFV(KB, i % ((size_t)2048 * 1024));
            if (DBG_STOP <= 3) { if (DUMPMASK & 1) v += BFV(YB, i); if (DUMPMASK & 2) v += BFV(YB, i + n); if (DUMPMASK & 4) v += BFV(YB, i + 2 * n); }
            if (DBG_STOP <= 2 && !(DUMPMASK & 8)) { v += BFV(XBC, i) + BFV(XBC, i + n / 2) + BFV(SG, i) + BFV(SG, i + n) + BFV(SG, i + 2 * n) + BFV(KB, i % ((size_t)2048 * 1024)) + BFV(VT, i % ((size_t)2048 * 1024))
                                     + DT[i % ((size_t)TS * 16)] + 1e-3f * VSS[i % ((size_t)TS * 16)]; }
            if (DBG_STOP == 2 && !(DUMPMASK & 8)) v += 1e-3f * SSS[i % ((size_t)TS * 16)];
            if (DBG_STOP == 3) v += BFV(MB, i);
            if (DBG_STOP >= 4) v = out[i] + BFV(XB, i) + 1e-3f * XSS[i % ((size_t)TS * 16)];
#ifdef CNT_TEST
            v = cnt_val; out[i + n] = v;
#endif
            out[i] = v;
        }
    }
#endif
}

extern "C" void kernel_launch(void* const* d_in, const int* in_sizes, int n_in, void* d_out, int out_size, void* d_ws, size_t ws_size, hipStream_t stream) {
    static int grid_blocks = 0;
    if (grid_blocks == 0) {
        if (n_in != 23 || out_size != T_ALL * DM || ws_size < WS_END) { fprintf(stderr, "kernel_launch: unexpected problem (n_in %d out %d ws %zu, need %zu)\n", n_in, out_size, ws_size, (size_t)WS_END); grid_blocks = -1; return; }
        int dev = 0, cus = 0, per_cu = 0;
        (void)hipGetDevice(&dev);
        (void)hipDeviceGetAttribute(&cus, hipDeviceAttributeMultiprocessorCount, dev);
        (void)hipFuncSetAttribute((const void*)fwd_megakernel, hipFuncAttributeMaxDynamicSharedMemorySize, LDS_BYTES);
        (void)hipOccupancyMaxActiveBlocksPerMultiprocessor(&per_cu, fwd_megakernel, NTHR, LDS_BYTES);
        if (per_cu < 1) { fprintf(stderr, "kernel_launch: occupancy query says 0 blocks per CU\n"); per_cu = 1; }
        grid_blocks = cus;
    }
    if (grid_blocks < 0) return;
    (void)hipMemsetAsync((unsigned char*)d_ws + WS_BAR, 0, 16384, stream);
    Params p{};
    for (int i = 0; i < 23; ++i) p.in[i] = (const float*)d_in[i];
    p.out = (float*)d_out; p.ws = (unsigned char*)d_ws;
#if MK_MULTI
    for (int s = 0; s < NSEG; ++s) { p.seg_lo = s; p.seg_hi = s + 1; hipLaunchKernelGGL(fwd_megakernel, dim3(grid_blocks), dim3(NTHR), LDS_BYTES, stream, p); }
#else
#ifdef DBG_STOP
    p.seg_lo = 0; p.seg_hi = DBG_STOP + 1;
#else
    p.seg_lo = 0; p.seg_hi = NSEG;
#endif
    void* args[] = {&p};
    hipError_t e = hipLaunchCooperativeKernel((void*)fwd_megakernel, dim3(grid_blocks), dim3(NTHR), args, LDS_BYTES, stream);
    if (e != hipSuccess) fprintf(stderr, "cooperative launch failed: %s (grid %d)\n", hipGetErrorString(e), grid_blocks);
#endif
}
```

```cpp
#include <hip/hip_runtime.h>
#include <hip/hip_cooperative_groups.h>
#include <cstdio>
#include <cstdint>
namespace cg = cooperative_groups;
namespace pg8 {
#define PG8_LAS __attribute__((address_space(3)))
typedef unsigned short bf16_t;
typedef short bf16x8 __attribute__((ext_vector_type(8)));
typedef float f32x4 __attribute__((ext_vector_type(4)));
typedef unsigned u32x4 __attribute__((ext_vector_type(4)));
constexpr int BM = 256, BK = 64, HALF = 128, HTB = HALF * BK * 2  , STAGE_BYTES = 8 * HTB, NXCD = 8, WGM = 8;

__host__ __device__ __forceinline__ int lds_byte(int r, int c) { const int st = (r >> 4) * 2 + (c >> 5), rr = r & 15, cc = c & 31, ob = rr * 64 + cc * 2; return st * 1024 + (ob ^ (((ob >> 9) & 1) << 5)); }
__host__ __device__ __forceinline__ void stage_rc(int b, int& R, int& C) { const int st = b / 1024, sb = b % 1024, swz = sb ^ (((sb >> 9) & 1) << 5); R = (st >> 1) * 16 + swz / 64; C = (st & 1) * 32 + (swz % 64) / 2; }
__host__ __device__ __forceinline__ int perm32(int rho) { const int n = rho >> 4, i = rho & 15; return 8 * (i >> 2) + 4 * n + (i & 3); }

struct Unit { int pm, pn; };
struct Gemm { const bf16_t* A; const bf16_t* Bt; int M, N, K; };

template <class Epi, class Sched, bool STAMP = false>
__device__ __forceinline__ void gemm_phase(PG8_LAS unsigned char* lds, const Gemm g, const Sched& S, const Epi& E, unsigned long long* stamps, int wave_s) {
    int tid_ = (wave_s << 6) | (int)__builtin_amdgcn_mbcnt_hi(~0u, __builtin_amdgcn_mbcnt_lo(~0u, 0u)); asm volatile("" : "+v"(tid_)); const int tid = tid_, wid = __builtin_amdgcn_readfirstlane(tid >> 6), lane = tid & 63, wr = wid >> 2, wc = wid & 3, fr = lane & 15, fq = lane >> 4;
    const int K = g.K, nt = K / BK;
    int ts_lo = 0, ts_hi = 0, nts = 0; const unsigned long long rt_entry = STAMP ? (unsigned long long)wall_clock64() : 0ull;
#define PG8_STAMP() do { if (STAMP && wid == 0 && nts < 64) { const unsigned long long _c = (unsigned long long)clock64(); \
        ts_lo = (lane == nts) ? (int)(unsigned)_c : ts_lo; ts_hi = (lane == nts) ? (int)(unsigned)(_c >> 32) : ts_hi; ++nts; } } while (0)
    PG8_STAMP();
    unsigned voffA[2], voffB[2];
#pragma unroll
    for (int i = 0; i < 2; ++i) { int R, C; stage_rc(tid * 16 + i * 8192, R, C); const int Rb = Epi::PERM ? ((R & ~31) + perm32(R & 31)) : R;
        voffA[i] = (unsigned)(R * K + C) * 2u; voffB[i] = (unsigned)(Rb * K + C) * 2u; }
    const size_t kstep = (size_t)(BK * 2);
    const size_t hstep = (size_t)HALF * K * 2;
    const size_t tstep = 2 * hstep;
    const unsigned ldsw = (unsigned)wid * 1024u;
    const int aoff = lds_byte(wr * 64 + fr, fq * 8), boff = lds_byte(wc * 32 + fr, fq * 8);
#define PG8_SA(b, h) (((b) * 2 + (h)) * HTB)
#define PG8_SB(b, h) ((4 + (b) * 2 + (h)) * HTB)
#define PG8_STAGE(bufoff, gbase, voff) do { _Pragma("unroll") for (int _i = 0; _i < 2; ++_i) \
        __builtin_amdgcn_global_load_lds((const unsigned*)((const char*)(gbase) + (voff)[_i]), (PG8_LAS unsigned*)(lds + (bufoff) + ldsw + _i * 8192), 16, 0, 0); } while (0)
#define PG8_LDA(dst, b, h) do { _Pragma("unroll") for (int m = 0; m < 4; ++m) _Pragma("unroll") for (int k = 0; k < 2; ++k) dst[m][k] = *(const PG8_LAS bf16x8*)(lds + PG8_SA(b, h) + aoff + m * 2048 + k * 1024); } while (0)
#define PG8_LDB(dst, b, h) do { _Pragma("unroll") for (int n = 0; n < 2; ++n) _Pragma("unroll") for (int k = 0; k < 2; ++k) dst[n][k] = *(const PG8_LAS bf16x8*)(lds + PG8_SB(b, h) + boff + n * 2048 + k * 1024); } while (0)
#define PG8_MMA(ai, bj, At, Bt) do { __builtin_amdgcn_s_setprio(1); _Pragma("unroll") for (int m = 0; m < 4; ++m) _Pragma("unroll") for (int n = 0; n < 2; ++n) _Pragma("unroll") for (int k = 0; k < 2; ++k) \
        acc[ai][bj][m][n] = __builtin_amdgcn_mfma_f32_16x16x32_bf16(Bt[n][k], At[m][k], acc[ai][bj][m][n], 0, 0, 0); __builtin_amdgcn_s_setprio(0); } while (0)
#define PG8_WAIT_V(n) asm volatile("s_waitcnt vmcnt(" #n ")" ::: "memory")
#define PG8_WAIT_L(n) asm volatile("s_waitcnt lgkmcnt(" #n ")" ::: "memory")
#define PG8_BAR __builtin_amdgcn_s_barrier()
#define PG8_SCHED __builtin_amdgcn_sched_barrier(0)
    Unit cur, nxt; int ui = 0;
    if (!S.next(0, cur)) return;
    f32x4 acc[2][2][4][2];
#pragma unroll
    for (int a = 0; a < 2; ++a)
#pragma unroll
        for (int b = 0; b < 2; ++b)
#pragma unroll
            for (int m = 0; m < 4; ++m)
#pragma unroll
                for (int n = 0; n < 2; ++n) acc[a][b][m][n] = (f32x4){0.f, 0.f, 0.f, 0.f};
    bf16x8 At[4][2], B0[2][2], B1[2][2];
    const char* cA = (const char*)g.A + (size_t)cur.pm * tstep; const char* cB = (const char*)g.Bt + (size_t)cur.pn * tstep;
    S.a_ready(cur);
    PG8_STAGE(PG8_SB(0, 0), cB, voffB); PG8_STAGE(PG8_SA(0, 0), cA, voffA); PG8_STAGE(PG8_SB(0, 1), cB + hstep, voffB); PG8_STAGE(PG8_SA(0, 1), cA + hstep, voffA);
    if (wr == 1) PG8_BAR;
    PG8_WAIT_V(4); PG8_BAR;
    PG8_STAGE(PG8_SB(1, 0), cB + kstep, voffB); PG8_STAGE(PG8_SA(1, 0), cA + kstep, voffA); PG8_STAGE(PG8_SB(1, 1), cB + hstep + kstep, voffB);
    PG8_WAIT_V(6); PG8_BAR;
    PG8_STAMP();
    for (;;) {
        const bool has_next = S.next(ui + 1, nxt);
        const char* nA = has_next ? (const char*)g.A + (size_t)nxt.pm * tstep : cA; const char* nB = has_next ? (const char*)g.Bt + (size_t)nxt.pn * tstep : cB;
        for (int t = 0; t < nt; t += 2) {
            const bool last = (t == nt - 2);
            const char* a1 = cA + (size_t)(t + 1) * kstep;
            const char* a2 = last ? nA : cA + (size_t)(t + 2) * kstep; const char* b2 = last ? nB : cB + (size_t)(t + 2) * kstep;
            const char* a3 = a2 + kstep; const char* b3 = b2 + kstep;
            if (last && has_next) S.a_ready(nxt);
            PG8_LDB(B0, 0, 0); PG8_SCHED; PG8_LDA(At, 0, 0); PG8_STAGE(PG8_SA(1, 1), a1 + hstep, voffA);
            PG8_WAIT_L(8); PG8_BAR; PG8_WAIT_L(0); PG8_MMA(0, 0, At, B0); PG8_BAR; PG8_SCHED;
            PG8_LDB(B1, 0, 1); PG8_STAGE(PG8_SB(0, 0), b2, voffB);
            PG8_BAR; PG8_WAIT_L(0); PG8_MMA(0, 1, At, B1); PG8_BAR;
            PG8_LDA(At, 0, 1); PG8_STAGE(PG8_SA(0, 0), a2, voffA);
            PG8_BAR; PG8_WAIT_L(0); PG8_MMA(1, 0, At, B0); PG8_BAR; PG8_SCHED;
            PG8_STAGE(PG8_SB(0, 1), b2 + hstep, voffB);
            PG8_WAIT_V(6); PG8_BAR; PG8_MMA(1, 1, At, B1); PG8_BAR;
            PG8_LDB(B0, 1, 0); PG8_SCHED; PG8_LDA(At, 1, 0); PG8_STAGE(PG8_SA(0, 1), a2 + hstep, voffA);
            PG8_WAIT_L(8); PG8_BAR; PG8_WAIT_L(0); PG8_MMA(0, 0, At, B0); PG8_BAR; PG8_SCHED;
            PG8_LDB(B1, 1, 1); PG8_STAGE(PG8_SB(1, 0), b3, voffB);
            PG8_BAR; PG8_WAIT_L(0); PG8_MMA(0, 1, At, B1); PG8_BAR;
            PG8_LDA(At, 1, 1); PG8_STAGE(PG8_SA(1, 0), a3, voffA);
            PG8_BAR; PG8_WAIT_L(0); PG8_MMA(1, 0, At, B0); PG8_BAR; PG8_SCHED;
            PG8_STAGE(PG8_SB(1, 1), b3 + hstep, voffB);
            PG8_WAIT_V(6); PG8_BAR; PG8_MMA(1, 1, At, B1); PG8_BAR;
        }
        PG8_STAMP();
        if constexpr (!Epi::AFTER_DRAIN) { if constexpr (Epi::WANTS_SCRATCH) E(acc, cur, wr, wc, fr, fq, At, B0, B1); else E(acc, cur, wr, wc, fr, fq); S.done(cur); }
        PG8_STAMP();
        if (!has_next) break;
        if constexpr (!Epi::MUT_ACC)
#pragma unroll
        for (int a = 0; a < 2; ++a)
#pragma unroll
            for (int b = 0; b < 2; ++b)
#pragma unroll
                for (int m = 0; m < 4; ++m)
#pragma unroll
                    for (int n = 0; n < 2; ++n) acc[a][b][m][n] = (f32x4){0.f, 0.f, 0.f, 0.f};
        cur = nxt; cA = nA; cB = nB; ++ui;
    }
    PG8_WAIT_V(0);
    if (wr == 0) PG8_BAR;
    PG8_BAR;
    if constexpr (Epi::AFTER_DRAIN) { E.fused(acc, cur, wr, wc, fr, fq, lds, wid, lane); S.done(cur); }
    PG8_STAMP();
    if (STAMP && wid == 0) { stamps[lane] = lane < nts ? (((unsigned long long)(unsigned)ts_hi << 32) | (unsigned)ts_lo) : 0ull;
        if (lane == 62) stamps[62] = rt_entry; if (lane == 63) stamps[63] = (unsigned long long)wall_clock64(); }
#undef PG8_STAMP
#undef PG8_SA
#undef PG8_SB
#undef PG8_STAGE
#undef PG8_LDA
#undef PG8_LDB
#undef PG8_MMA
#undef PG8_WAIT_V
#undef PG8_WAIT_L
#undef PG8_BAR
#undef PG8_SCHED
}
}

#define LAS __attribute__((address_space(3)))
#ifndef FSCOPE
#define FSCOPE "agent"
#endif
typedef pg8::bf16_t bf16_t;
typedef pg8::bf16x8 bf16x8;
typedef pg8::f32x4 f32x4;
typedef pg8::u32x4 u32x4;
typedef unsigned u32x2 __attribute__((ext_vector_type(2)));

constexpr int T_ALL = 32768, DM = 1024, TS = 16384, SEQ = 2048, NSLAB = 2;
constexpr int IN_DIM = 8720;
constexpr float EPS = 1e-6f;
constexpr int LDS_BYTES = 160 * 1024;
constexpr int NTHR = 512;

constexpr size_t al256(size_t x) { return (x + 255) & ~(size_t)255; }
constexpr size_t WS_CTL   = 0;
constexpr size_t WS_BAR   = 16384;
constexpr size_t WS_WINKV = 32768;
constexpr size_t WS_WB    = WS_WINKV + (size_t)11008 * 1024 * 2;
constexpr size_t WS_WO    = WS_WB + (size_t)3 * 1024 * 1024 * 2;
constexpr size_t WS_WQ    = WS_WO + (size_t)1024 * 1024 * 2;
constexpr size_t WS_KEYS  = WS_WQ + (size_t)2048 * 1024 * 2;
constexpr size_t WS_WSP   = WS_KEYS + (size_t)8 * 2 * 128 * 128 * 2;
constexpr size_t WS_PU    = WS_WSP + (size_t)8 * 128 * 128 * 2;
constexpr size_t WS_PV    = WS_PU + (size_t)16384 * 1024;
constexpr size_t WS_SU    = WS_PV + (size_t)16384 * 1024;
constexpr size_t WS_SV    = WS_SU + (size_t)16384 * 4;
constexpr size_t WS_KB    = WS_SV + (size_t)16384 * 4;
constexpr size_t WS_VT    = WS_KB + (size_t)4096 * 1024 * 2;
constexpr size_t WS_XB    = WS_VT + (size_t)4096 * 1024 * 2;
constexpr size_t WS_VSS   = WS_XB + (size_t)T_ALL * 1024 * 2;
constexpr size_t WS_SSS   = WS_VSS + (size_t)T_ALL * 16 * 4;
constexpr size_t WS_XSS   = WS_SSS + (size_t)T_ALL * 16 * 4;
constexpr size_t WS_DT    = WS_XSS + (size_t)T_ALL * 16 * 4;
constexpr size_t WS_H     = WS_DT + (size_t)T_ALL * 16 * 4;
constexpr size_t WS_SLAB  = WS_H + (size_t)(T_ALL + 4096) * 1024 * 2;
constexpr size_t SL_YB    = 0;
constexpr size_t SL_XBC   = SL_YB + (size_t)3 * TS * 1024 * 2;
constexpr size_t SL_SG    = SL_XBC + (size_t)TS * 1536 * 2;
constexpr size_t SL_END   = SL_SG + (size_t)TS * 3072 * 2;
constexpr size_t WS_Q2    = WS_SLAB;
constexpr size_t WS_EID   = WS_Q2 + (size_t)T_ALL * 2048 * 2;
constexpr size_t WS_GATE  = WS_EID + (size_t)T_ALL * 128 * 4;
constexpr size_t WS_PD    = WS_Q2;
constexpr size_t WS_PW    = WS_GATE + (size_t)T_ALL * 128 * 4;
constexpr size_t WS_SS3   = WS_PW + (size_t)T_ALL * 128 * 4;
constexpr size_t WS_PEND  = WS_SS3 + (size_t)T_ALL * 8 * 4;
constexpr size_t WS_END   = (WS_SLAB + SL_END) > WS_PEND ? (WS_SLAB + SL_END) : WS_PEND;
static_assert((size_t)8 * T_ALL * 128 * 4 <= (size_t)T_ALL * 2048 * 2, "partial dots must fit over Q2");
static_assert(WS_END <= (size_t)512 * 1024 * 1024, "workspace map exceeds 512 MiB");

struct Params { const float* in[23]; float* out; unsigned char* ws; int seg_lo, seg_hi; };
static_assert(sizeof(Params) == 25 * 8 + 8, "Params has padding");

enum { I_X = 0, I_MEM, I_LN_MIX, I_W_IN, I_CONV_W, I_CONV_B, I_DT_BIAS, I_A_LOG, I_D_SKIP, I_SSD_NORM, I_GMLP_NORM, I_W_SPATIAL, I_B_SPATIAL, I_LN_MEM,
       I_W_MEM_KV, I_W_BRANCH, I_W_OUT, I_LN_FFN, I_W_PEER_Q, I_PEER_KEYS, I_PEER_U, I_PEER_V, I_LN_FINAL };

typedef float f32x2_t __attribute__((ext_vector_type(2)));
typedef short s16x4 __attribute__((ext_vector_type(4)));
typedef short s16x8 __attribute__((ext_vector_type(8)));
typedef float f2v __attribute__((ext_vector_type(2)));
typedef __bf16 bf16x2_t __attribute__((ext_vector_type(2)));
__device__ __forceinline__ unsigned pk2(float lo, float hi) { const f32x2_t v = {lo, hi}; const bf16x2_t r = __builtin_convertvector(v, bf16x2_t); return __builtin_bit_cast(unsigned, r); }
__device__ __forceinline__ float bf_lo(unsigned w) { return __uint_as_float(w << 16); }
__device__ __forceinline__ float bf_hi(unsigned w) { return __uint_as_float(w & 0xffff0000u); }
__device__ __forceinline__ float sigmoid_f(float x) { return __builtin_amdgcn_rcpf(1.f + __expf(-x)); }
__device__ __forceinline__ float silu_f(float x) { return x * sigmoid_f(x); }
__device__ __forceinline__ float gelu_f(float x) { const float y = 1.5957691216f * (x + 0.044715f * x * x * x); return x * sigmoid_f(y); }
__device__ __forceinline__ f32x4 mfma16(bf16x8 a, bf16x8 b, f32x4 c) { return __builtin_amdgcn_mfma_f32_16x16x32_bf16(a, b, c, 0, 0, 0); }
__device__ __forceinline__ int swz(int row, int chunk) { return row * 256 + ((chunk ^ (row & 7)) << 4); }
__device__ __forceinline__ void lds_wait() { asm volatile("s_waitcnt lgkmcnt(0)" ::: "memory"); }
__device__ __forceinline__ float wave_sum64(float v) {
#pragma unroll
    for (int o = 1; o < 64; o <<= 1) v += __shfl_xor(v, o);
    return v;
}
__device__ __forceinline__ unsigned ord_key(float f) { const unsigned u = __float_as_uint(f); return u ^ ((unsigned)((int)u >> 31) | 0x80000000u); }
__device__ __forceinline__ float unord_key(unsigned k) { const unsigned u = (k & 0x80000000u) ? (k ^ 0x80000000u) : ~k; return __uint_as_float(u); }
__device__ __forceinline__ void ins16(unsigned (&l)[16], unsigned x) {
#pragma unroll
    for (int j = 0; j < 16; ++j) { const unsigned hi = l[j] > x ? l[j] : x; x = l[j] > x ? x : l[j]; l[j] = hi; }
}


#undef LAS
#define XB_TMO      128
#define XB_XCNT(j)  (256  + 64 * (j))
#define XB_XSUB(j)  (1280 + 64 * (j))
#define XB_XGEN(j)  (2304 + 64 * (j))
#define XB_TOP      3328
#define XB_TOPGEN   3392
#define XCD_BAR_WORDS 3456
#define XB_SPIN_CAP (1u << 23)
#define LAS __attribute__((address_space(3)))

__device__ __forceinline__ unsigned xb_ld(unsigned* p)              { return __hip_atomic_load(p, __ATOMIC_RELAXED, __HIP_MEMORY_SCOPE_AGENT); }
__device__ __forceinline__ unsigned xb_add(unsigned* p, unsigned v) { return __hip_atomic_fetch_add(p, v, __ATOMIC_RELAXED, __HIP_MEMORY_SCOPE_AGENT); }
__device__ __forceinline__ unsigned xb_xcc_id() { return (unsigned)__builtin_amdgcn_s_getreg((3 << 11) | 20) & 0xFu; }
#define XB_T0(b) ((b).wv == 0u && __builtin_amdgcn_mbcnt_hi(~0u, __builtin_amdgcn_mbcnt_lo(~0u, 0u)) == 0u)
#define XB_SPIN(cond, bar) do { unsigned _sp = 0; while (cond) { __builtin_amdgcn_s_sleep(1); \
    if ((++_sp & 255u) == 0u) { if (xb_ld(&(bar)[XB_TMO])) break; if (_sp > XB_SPIN_CAP) { atomicAdd(&(bar)[XB_TMO], 1u); break; } } } } while (0)

struct XcdBarrier {
    unsigned wv;
    unsigned* bar; unsigned x;
    volatile LAS unsigned* st;
};

__device__ __forceinline__ XcdBarrier xcd_barrier_post(unsigned wv, unsigned* bar, volatile LAS unsigned* st) {
    XcdBarrier b; b.wv = wv; b.bar = bar; b.x = xb_xcc_id(); b.st = st;
    if (XB_T0(b)) (void)xb_add(&bar[XB_XCNT(b.x)], 1u);
    return b;
}
__device__ __forceinline__ void xcd_barrier_complete(unsigned* bar, unsigned x, unsigned& nloc, unsigned& nx) {
    const unsigned G = gridDim.x * gridDim.y * gridDim.z;
    unsigned sum, cnt, mine, sp = 0u;
    for (;;) {
        sum = 0u; cnt = 0u; mine = 0u;
#pragma unroll
        for (unsigned j = 0; j < 16; ++j) { const unsigned c = xb_ld(&bar[XB_XCNT(j)]); sum += c; cnt += (c > 0u) ? 1u : 0u; mine = (j == x) ? c : mine; }
        if (sum == G) break;
        __builtin_amdgcn_s_sleep(1);
        if ((++sp & 255u) == 0u) { if (xb_ld(&bar[XB_TMO])) break; if (sp > XB_SPIN_CAP) { atomicAdd(&bar[XB_TMO], 1u); break; } }
    }
    nloc = mine > 0u ? mine : 1u; nx = cnt > 0u ? cnt : 1u;
}

__device__ __forceinline__ void xcd_barrier(const XcdBarrier& b) {
    asm volatile("s_waitcnt vmcnt(0)" ::: "memory");
    __syncthreads();
    if (XB_T0(b)) {
        unsigned* bar = b.bar;
        __builtin_amdgcn_s_waitcnt(0);
        unsigned nloc = b.st[0], nx = b.st[1];
        if (nloc == 0u) { xcd_barrier_complete(bar, b.x, nloc, nx); b.st[0] = nloc; b.st[1] = nx; }
        const unsigned old = xb_add(&bar[XB_XSUB(b.x)], 1u);
        const unsigned gen = old / nloc;
        if (old + 1u == (gen + 1u) * nloc) {
            __builtin_amdgcn_fence(__ATOMIC_RELEASE, "agent");
            asm volatile("s_waitcnt vmcnt(0)" ::: "memory");
            const unsigned og = xb_add(&bar[XB_TOP], 1u);
            const unsigned tg = og / nx;
            if (og + 1u == (tg + 1u) * nx) xb_add(&bar[XB_TOPGEN], 1u);
            else XB_SPIN(xb_ld(&bar[XB_TOPGEN]) == tg, bar);
            __builtin_amdgcn_fence(__ATOMIC_ACQUIRE, "agent");
            xb_add(&bar[XB_XGEN(b.x)], 1u);
            asm volatile("s_waitcnt vmcnt(0)" ::: "memory");
        } else {
            XB_SPIN(xb_ld(&bar[XB_XGEN(b.x)]) == gen, bar);
            __builtin_amdgcn_fence(__ATOMIC_ACQUIRE, "agent");
            asm volatile("s_waitcnt vmcnt(0)" ::: "memory");
        }
    }
    __syncthreads();
}

typedef const unsigned char __attribute__((address_space(4)))* kaptr_t;
__device__ __forceinline__ kaptr_t kargs() { kaptr_t ka = (kaptr_t)__builtin_amdgcn_kernarg_segment_ptr(); asm volatile("" : "+s"(ka)); return ka; }
__device__ __forceinline__ const float* ka_in(kaptr_t ka, int i) { return *(const float* const __attribute__((address_space(4)))*)(ka + 8 * i); }
__device__ __forceinline__ float* ka_out(kaptr_t ka) { return *(float* const __attribute__((address_space(4)))*)(ka + 184); }
__device__ __forceinline__ unsigned char* ka_ws(kaptr_t ka) { return *(unsigned char* const __attribute__((address_space(4)))*)(ka + 192); }

__device__ __forceinline__ float sum16(const float* p) {
    const f32x4 a = *(const f32x4*)p, b = *(const f32x4*)(p + 4), c = *(const f32x4*)(p + 8), d = *(const f32x4*)(p + 12);
    return (((a.x + a.y) + (a.z + a.w)) + ((b.x + b.y) + (b.z + b.w))) + (((c.x + c.y) + (c.z + c.w)) + ((d.x + d.y) + (d.z + d.w)));
}
__device__ __forceinline__ void merge16(unsigned (&a)[16], const unsigned (&b)[16]) {
#pragma unroll
    for (int i = 0; i < 16; ++i) a[i] = max(a[i], b[15 - i]);
#pragma unroll
    for (int ls = 3; ls >= 0; --ls)
#pragma unroll
        for (int i = 0; i < 16; ++i) {
            const int st = 1 << ls;
            if ((i & st) == 0) { const unsigned hi = max(a[i], a[i + st]), lo = min(a[i], a[i + st]); a[i] = hi; a[i + st] = lo; }
        }
}
__device__ __forceinline__ void sort16(unsigned (&a)[16]) {
#pragma unroll
    for (int lp = 0; lp < 4; ++lp)
#pragma unroll
        for (int lk = lp; lk >= 0; --lk)
#pragma unroll
            for (int i = 0; i < 16; ++i) {
                const int p = 1 << lp, k = 1 << lk, r = k % p, l = i + k;
                if (l < 16 && i >= r && ((i - r) % (2 * k)) < k && (i / (2 * p)) == (l / (2 * p))) { const unsigned hi = max(a[i], a[l]), lo = min(a[i], a[l]); a[i] = hi; a[l] = lo; }
            }
}
struct Ctx {
    LAS unsigned char* lds;
    int tid, lane, wid, G, bid;
};
__device__ __forceinline__ Ctx fresh_ctx(LAS unsigned char* lds, int wave_s) {
    Ctx C; C.lds = lds;
    int tid = (wave_s << 6) | (int)__builtin_amdgcn_mbcnt_hi(~0u, __builtin_amdgcn_mbcnt_lo(~0u, 0u)); asm volatile("" : "+v"(tid));
    int bid = blockIdx.x; asm volatile("" : "+s"(bid));
    C.tid = tid; C.lane = tid & 63; C.wid = wave_s; C.G = gridDim.x; C.bid = bid;
    return C;
}

template <class MapF>
__device__ __forceinline__ void transpose_item(const float* W, int K, int N, bf16_t* WT, MapF map, LAS float* scr, int item, int lane, const float* krow_scale = nullptr) {
    const int nblk = (N + 31) / 32, kb = item / nblk, nb = item % nblk, k0 = 64 * kb, n0 = 32 * nb;
    const int n4 = lane & 7, kr = lane >> 3, nl = n0 + 4 * n4;
    f32x4 tv[8];
#pragma unroll
    for (int i = 0; i < 8; ++i) { const int kk = 8 * i + kr; tv[i] = (nl < N) ? *(const f32x4*)(W + (size_t)(k0 + kk) * N + nl) : (f32x4){0.f, 0.f, 0.f, 0.f}; if (krow_scale) tv[i] = tv[i] * krow_scale[k0 + kk]; }
#pragma unroll
    for (int i = 0; i < 8; ++i) { const int kk = 8 * i + kr; LAS float* d = scr + kk * 33 + 4 * n4; d[0] = tv[i].x; d[1] = tv[i].y; d[2] = tv[i].z; d[3] = tv[i].w; }
    lds_wait();
    const int c = lane & 7;
#pragma unroll
    for (int j = 0; j < 4; ++j) {
        const int n = (lane >> 3) + 8 * j; const LAS float* s = scr + (8 * c) * 33 + n;
        u32x4 o; o.x = pk2(s[0 * 33], s[1 * 33]); o.y = pk2(s[2 * 33], s[3 * 33]); o.z = pk2(s[4 * 33], s[5 * 33]); o.w = pk2(s[6 * 33], s[7 * 33]);
        if (n0 + n < N) *(u32x4*)(WT + (size_t)map(n0 + n) * K + k0 + 8 * c) = o;
    }
    lds_wait();
}
struct MapId { int off; __device__ __forceinline__ int operator()(int n) const { return n + off; } };
struct MapWin { __device__ __forceinline__ int operator()(int n) const { return n < 2560 ? n : (n < 2576 ? 8704 + (n - 2560) : n - 16); } };

__device__ __forceinline__ void rms_row_load(f32x4 (&v)[4], const float* xrow, int lane) {
    const f32x4* xr = (const f32x4*)xrow + lane;
#pragma unroll
    for (int j = 0; j < 4; ++j) v[j] = xr[64 * j];
}
__device__ __forceinline__ void rms_row_finish(const f32x4 (&v)[4], const float* gain, bf16_t* orow, int lane) {
    const f32x4* gr = (const f32x4*)gain + lane; float s = 0.f;
#pragma unroll
    for (int j = 0; j < 4; ++j) s += (v[j].x * v[j].x + v[j].y * v[j].y) + (v[j].z * v[j].z + v[j].w * v[j].w);
    const float rstd = rsqrtf(wave_sum64(s) * (1.f / 1024.f) + EPS);
    u32x2* o8 = (u32x2*)orow + lane;
#pragma unroll
    for (int j = 0; j < 4; ++j) { const f32x4 g = gr[64 * j]; u32x2 w; w.x = pk2(v[j].x * rstd * g.x, v[j].y * rstd * g.y); w.y = pk2(v[j].z * rstd * g.z, v[j].w * rstd * g.w); o8[64 * j] = w; }
}
__device__ __forceinline__ void cvt_row_bf16(const float* src, bf16_t* dst, int lane, bool tril, size_t ebase) {
#pragma unroll
    for (int j = 0; j < 2; ++j) {
        const int e = j * 512 + lane * 8;
        f32x4 a = *(const f32x4*)(src + e), b = *(const f32x4*)(src + e + 4);
        if (tril) { const int t = (int)(((ebase + e) >> 7) & 127), s0 = (int)((ebase + e) & 127);
            a.x = (s0 + 0 <= t) ? a.x : 0.f; a.y = (s0 + 1 <= t) ? a.y : 0.f; a.z = (s0 + 2 <= t) ? a.z : 0.f; a.w = (s0 + 3 <= t) ? a.w : 0.f;
            b.x = (s0 + 4 <= t) ? b.x : 0.f; b.y = (s0 + 5 <= t) ? b.y : 0.f; b.z = (s0 + 6 <= t) ? b.z : 0.f; b.w = (s0 + 7 <= t) ? b.w : 0.f; }
        u32x4 o; o.x = pk2(a.x, a.y); o.y = pk2(a.z, a.w); o.z = pk2(b.x, b.y); o.w = pk2(b.z, b.w);
        *(u32x4*)(dst + e) = o;
    }
}

__device__ __forceinline__ void fp8_row_load(f32x4 (&v)[4], const float* src, int lane) {
    const f32x4* p = (const f32x4*)(src + lane * 16);
#pragma unroll
    for (int j = 0; j < 4; ++j) v[j] = p[j];
}
__device__ __forceinline__ void fp8_row_finish(const f32x4 (&v_)[4], unsigned char* dst, float* inv_scale, int lane, const float* col_scale) {
    f32x4 v[4];
#pragma unroll
    for (int j = 0; j < 4; ++j) { v[j] = v_[j]; if (col_scale) v[j] = v[j] * *(const f32x4*)(col_scale + lane * 16 + 4 * j); }
    float m = 0.f;
#pragma unroll
    for (int j = 0; j < 4; ++j) m = fmaxf(m, fmaxf(fmaxf(fabsf(v[j].x), fabsf(v[j].y)), fmaxf(fabsf(v[j].z), fabsf(v[j].w))));
#pragma unroll
    for (int o = 1; o < 64; o <<= 1) m = fmaxf(m, __shfl_xor(m, o));
    const float sc = m > 0.f ? 440.f / m : 1.f;
    u32x4 w;
#pragma unroll
    for (int j = 0; j < 4; ++j) { int t = 0; t = __builtin_amdgcn_cvt_pk_fp8_f32(v[j].x * sc, v[j].y * sc, t, false); t = __builtin_amdgcn_cvt_pk_fp8_f32(v[j].z * sc, v[j].w * sc, t, true); w[j] = (unsigned)t; }
    *(u32x4*)(dst + (size_t)(lane >> 3) * (16384 * 128) + (lane & 7) * 16) = w;
    if (lane == 0) *inv_scale = m > 0.f ? m / 440.f : 1.f;
}
__device__ __forceinline__ void p0_prep(const Ctx& C) {
    LAS float* scr = (LAS float*)(C.lds + C.wid * 8448);
    const int gw = C.bid * 8 + C.wid, NGW = C.G * 8, lane = C.lane;
    const kaptr_t ka = kargs();
    unsigned char* ws = ka_ws(ka);
    bf16_t* WINKV = (bf16_t*)(ws + WS_WINKV);
    constexpr int I_IN = 16 * 273, I_KV = 16 * 64, I_BR = 16 * 32, I_O = 16 * 32, I_Q = 16 * 64;
    constexpr int NTR = I_IN + I_KV + 3 * I_BR + I_O + I_Q;
    for (int it = gw; it < NTR; it += NGW) {
        int r = it;
        if (r < I_IN) { transpose_item(ka_in(ka, I_W_IN), 1024, IN_DIM, WINKV, MapWin{}, scr, r, lane); continue; } r -= I_IN;
        if (r < I_KV) { transpose_item(ka_in(ka, I_W_MEM_KV), 1024, 2048, WINKV, MapId{8960}, scr, r, lane); continue; } r -= I_KV;
        if (r < 3 * I_BR) { const int n = r / I_BR; transpose_item(ka_in(ka, I_W_BRANCH) + (size_t)n * 1024 * 1024, 1024, 1024, (bf16_t*)(ws + WS_WB), MapId{n * 1024}, scr, r % I_BR, lane); continue; } r -= 3 * I_BR;
        if (r < I_O) { transpose_item(ka_in(ka, I_W_OUT), 1024, 1024, (bf16_t*)(ws + WS_WO), MapId{0}, scr, r, lane); continue; } r -= I_O;
        transpose_item(ka_in(ka, I_W_PEER_Q), 1024, 2048, (bf16_t*)(ws + WS_WQ), MapId{0}, scr, r, lane, ka_in(ka, I_LN_FFN));
    }
    for (int it = gw; it < 240; it += NGW) { u32x4 z = {0u, 0u, 0u, 0u}; u32x4* d = (u32x4*)(WINKV + (size_t)(8720 + it) * 1024); d[lane] = z; d[64 + lane] = z; }
    bf16_t* H = (bf16_t*)(ws + WS_H);
    {
        const float* X = ka_in(ka, I_X); const float* MEMP = ka_in(ka, I_MEM); const float* g0 = ka_in(ka, I_LN_MIX); const float* g1 = ka_in(ka, I_LN_MEM);
        f32x4 cur[4], nxt[4];
        if (gw < T_ALL + 4096) rms_row_load(cur, gw < T_ALL ? X + (size_t)gw * 1024 : MEMP + (size_t)(gw - T_ALL) * 1024, lane);
        for (int it = gw; it < T_ALL + 4096; it += NGW) {
            const int nit = it + NGW;
            if (nit < T_ALL + 4096) rms_row_load(nxt, nit < T_ALL ? X + (size_t)nit * 1024 : MEMP + (size_t)(nit - T_ALL) * 1024, lane);
            rms_row_finish(cur, it < T_ALL ? g0 : g1, H + (size_t)it * 1024, lane);
#pragma unroll
            for (int j = 0; j < 4; ++j) cur[j] = nxt[j];
        }
    }
    {
        const float* PUf = ka_in(ka, I_PEER_U); const float* PVf = ka_in(ka, I_PEER_V);
        f32x4 cur[4], nxt[4];
        if (gw < 32768) fp8_row_load(cur, gw < 16384 ? PUf + (size_t)gw * 1024 : PVf + (size_t)(gw - 16384) * 1024, lane);
        for (int it = gw; it < 32768; it += NGW) {
            const int nit = it + NGW;
            if (nit < 32768) fp8_row_load(nxt, nit < 16384 ? PUf + (size_t)nit * 1024 : PVf + (size_t)(nit - 16384) * 1024, lane);
            if (it < 16384) fp8_row_finish(cur, ws + WS_PU + (size_t)it * 128, (float*)(ws + WS_SU) + it, lane, ka_in(ka, I_LN_FFN));
            else fp8_row_finish(cur, ws + WS_PV + (size_t)(it - 16384) * 128, (float*)(ws + WS_SV) + (it - 16384), lane, nullptr);
#pragma unroll
            for (int j = 0; j < 4; ++j) cur[j] = nxt[j];
        }
    }
    for (int it = gw; it < 256 + 128; it += NGW) {
        int r = it;
        if (r < 256) {
            const float* src = ka_in(ka, I_PEER_KEYS) + (size_t)r * 1024; bf16_t* kt = (bf16_t*)(ws + WS_KEYS);
#pragma unroll
            for (int j = 0; j < 2; ++j) {
                const int e = j * 512 + lane * 8, E = r * 1024 + e, k = (E >> 7) & 127, d = E & 127;
                const f32x4 a = *(const f32x4*)(src + e), b = *(const f32x4*)(src + e + 4);
                u32x4 o; o.x = pk2(a.x, a.y); o.y = pk2(a.z, a.w); o.z = pk2(b.x, b.y); o.w = pk2(b.z, b.w);
                *(u32x4*)(kt + (size_t)(E >> 14) * 16384 + (((k >> 4) * 4 + (d >> 5)) * 16 + (k & 15)) * 32 + (d & 31)) = o;
            }
            continue; } r -= 256;
        {
            const float* src = ka_in(ka, I_W_SPATIAL) + (size_t)r * 1024; bf16_t* wt = (bf16_t*)(ws + WS_WSP);
#pragma unroll
            for (int j = 0; j < 2; ++j) {
                const int e = j * 512 + lane * 8, E = r * 1024 + e, t = (E >> 7) & 127, s0 = E & 127;
                f32x4 a = *(const f32x4*)(src + e), b = *(const f32x4*)(src + e + 4);
                a.x = (s0 + 0 <= t) ? a.x : 0.f; a.y = (s0 + 1 <= t) ? a.y : 0.f; a.z = (s0 + 2 <= t) ? a.z : 0.f; a.w = (s0 + 3 <= t) ? a.w : 0.f;
                b.x = (s0 + 4 <= t) ? b.x : 0.f; b.y = (s0 + 5 <= t) ? b.y : 0.f; b.z = (s0 + 6 <= t) ? b.z : 0.f; b.w = (s0 + 7 <= t) ? b.w : 0.f;
                u32x4 o; o.x = pk2(a.x, a.y); o.y = pk2(a.z, a.w); o.z = pk2(b.x, b.y); o.w = pk2(b.z, b.w);
                *(u32x4*)(wt + (size_t)(E >> 14) * 16384 + (((t >> 4) * 4 + (s0 >> 5)) * 16 + (t & 15)) * 32 + (s0 & 31)) = o;
            }
        }
    }
    if (C.bid == 0) for (int i = C.tid; i < 4096; i += NTHR) ((unsigned*)(ws + WS_CTL))[i] = 0u;
}

struct SchedInProj {
    int slab, G, c;
    __device__ __forceinline__ bool next(int i, pg8::Unit& u) const {
        const int L = i * G + c; if (L >= 2304) return false;
        const int wgid = (L % 8) * 288 + L / 8;
        if (wgid < 2240) { const int gid = wgid / 280, r = wgid % 280; u.pm = slab * 64 + gid * 8 + (r % 8); u.pn = r / 8; }
        else { const int r = wgid - 2240; u.pm = 128 + slab * 8 + (r % 8); u.pn = 35 + r / 8; }
        return true;
    }
    __device__ __forceinline__ void a_ready(const pg8::Unit&) const {}
    __device__ __forceinline__ void done(const pg8::Unit&) const {}
};
__device__ __forceinline__ f32x4 sigmoid4_of(f32x4 t) {
    f32x4 e; e.x = __builtin_amdgcn_exp2f(t.x); e.y = __builtin_amdgcn_exp2f(t.y); e.z = __builtin_amdgcn_exp2f(t.z); e.w = __builtin_amdgcn_exp2f(t.w);
    const f32x4 d = e + 1.0f;
    f32x4 r; r.x = __builtin_amdgcn_rcpf(d.x); r.y = __builtin_amdgcn_rcpf(d.y); r.z = __builtin_amdgcn_rcpf(d.z); r.w = __builtin_amdgcn_rcpf(d.w);
    return r;
}
template <int mode>
__device__ __forceinline__ f32x4 act4(f32x4 v) {
    f32x4 r;
    if (mode == 0) r = v;
    else if (mode == 1) r = v * sigmoid4_of(v * (-1.4426950409f));
    else if (mode == 2) { const f32x4 y = v * ((v * v) * (0.044715f * -2.3022081914f) + (-2.3022081914f)); r = v * sigmoid4_of(y); }
    else if (mode == 3) r = sigmoid4_of(v * (-1.4426950409f));
    else r = v * 0.0625f;
    return r;
}
struct EpiInProj {
    static constexpr bool PERM = true, AFTER_DRAIN = false, WANTS_SCRATCH = false, MUT_ACC = false;
    unsigned char* ws; bf16_t* GV; const float* dt_bias; int tok0;
    template <int MODE>
    __device__ __forceinline__ void store_tile(const f32x4 (&acc)[2][2][4][2], bf16_t* rowp_run, int ld, int rbase, bool is_v, int pn, int wc, int fq) const {
        float* const VSS = (float*)(ws + WS_VSS);
#pragma unroll
        for (int ai = 0; ai < 2; ++ai)
#pragma unroll
            for (int m = 0; m < 4; ++m) {
                const int gt = rbase + ai * 128 + m * 16;
                asm volatile("" : "+v"(rowp_run));
                bf16_t* rowp = rowp_run; float ss = 0.f;
                rowp_run += (size_t)((m == 3) ? 80 : 16) * ld;
#pragma unroll
                for (int bj = 0; bj < 2; ++bj) {
                    const f32x4 v0 = act4<MODE>(acc[ai][bj][m][0]), v1 = act4<MODE>(acc[ai][bj][m][1]);
                    if (MODE == 2 && is_v) { const f32x4 q2 = v0 * v0 + v1 * v1; ss += (q2.x + q2.y) + (q2.z + q2.w); }
                    u32x4 w; w.x = pk2(v0.x, v0.y); w.y = pk2(v0.z, v0.w); w.z = pk2(v1.x, v1.y); w.w = pk2(v1.z, v1.w);
                    *(u32x4*)(rowp + bj * 128) = w;
                    __builtin_amdgcn_sched_barrier(0);
                }
                if (MODE == 2 && is_v) { ss += __shfl_xor(ss, 16); ss += __shfl_xor(ss, 32); if (fq == 0) VSS[(size_t)gt * 16 + (pn - 14) * 4 + wc] = ss; }
                __builtin_amdgcn_sched_barrier(0);
            }
    }
    __device__ __forceinline__ void operator()(const f32x4 (&acc)[2][2][4][2], const pg8::Unit& u, int wr, int wc, int fr, int fq) const {
        bf16_t* const YB = (bf16_t*)(ws + WS_SLAB + SL_YB); bf16_t* const XBC = (bf16_t*)(ws + WS_SLAB + SL_XBC); bf16_t* const SG = (bf16_t*)(ws + WS_SLAB + SL_SG);
        bf16_t* const KB = (bf16_t*)(ws + WS_KB); bf16_t* const VT = (bf16_t*)(ws + WS_VT); float* const DT = (float*)(ws + WS_DT); float* const VSS = (float*)(ws + WS_VSS);
        const int pn = u.pn;
        const int rbase = u.pm * 256 + wr * 64 + fr;
        const int cl = wc * 32 + 8 * fq;
        if (pn < 34) {
            bf16_t* dst; int ld, cofs, mode;
            if (pn < 4)       { dst = YB;                         ld = 1024; cofs = pn * 256;        mode = 1; }
            else if (pn < 10) { dst = XBC;                        ld = 1536; cofs = (pn - 4) * 256;  mode = 0; }
            else if (pn < 14) { dst = YB + (size_t)TS * 1024;     ld = 1024; cofs = (pn - 10) * 256; mode = 2; }
            else if (pn < 18) { dst = GV;                         ld = 1024; cofs = (pn - 14) * 256; mode = 2; }
            else if (pn < 22) { dst = YB + (size_t)2 * TS * 1024; ld = 1024; cofs = (pn - 18) * 256; mode = 4; }
            else              { dst = SG; ld = 0; cofs = 0; mode = 3; }
            const bool is_v = (pn >= 14 && pn < 18);
            if (pn >= 22) {
                unsigned char* gt8 = (unsigned char*)SG + (size_t)((u.pm - tok0 / 256) * 12 + (pn - 22)) * 65536 + (wr * 4 + wc) * 8192 + (fr + 16 * fq) * 8;
#pragma unroll
                for (int ai = 0; ai < 2; ++ai)
#pragma unroll
                    for (int m = 0; m < 4; ++m)
#pragma unroll
                        for (int bj = 0; bj < 2; ++bj) {
                            const f32x4 v0 = acc[ai][bj][m][0], v1 = acc[ai][bj][m][1];
                            f32x4 s0 = sigmoid4_of(v0 * (-1.4426950409f)) * 255.f + 0.5f, s1 = sigmoid4_of(v1 * (-1.4426950409f)) * 255.f + 0.5f;
                            s0.x = fmaxf(s0.x, 1.f); s0.y = fmaxf(s0.y, 1.f); s0.z = fmaxf(s0.z, 1.f); s0.w = fmaxf(s0.w, 1.f); s1.x = fmaxf(s1.x, 1.f); s1.y = fmaxf(s1.y, 1.f); s1.z = fmaxf(s1.z, 1.f); s1.w = fmaxf(s1.w, 1.f);
                            const unsigned b8[8] = {(unsigned)s0.x, (unsigned)s0.y, (unsigned)s0.z, (unsigned)s0.w, (unsigned)s1.x, (unsigned)s1.y, (unsigned)s1.z, (unsigned)s1.w};
                            u32x2 w; w.x = b8[0] | (b8[1] << 8) | (b8[2] << 16) | (b8[3] << 24); w.y = b8[4] | (b8[5] << 8) | (b8[6] << 16) | (b8[7] << 24);
                            *(u32x2*)(gt8 + (ai * 8 + m * 2 + bj) * 512) = w;
                            __builtin_amdgcn_sched_barrier(0);
                        }
                return;
            }
            bf16_t* rowp0 = dst + (size_t)(rbase - tok0) * ld + cofs + cl;
            switch (mode) {
                case 0: store_tile<0>(acc, rowp0, ld, rbase, false, pn, wc, fq); break;
                case 1: store_tile<1>(acc, rowp0, ld, rbase, false, pn, wc, fq); break;
                case 2: store_tile<2>(acc, rowp0, ld, rbase, is_v, pn, wc, fq); break;
                default: store_tile<4>(acc, rowp0, ld, rbase, false, pn, wc, fq); break;
            }
        } else if (pn == 34) {
            if (wc == 0 && fq < 2) {
                const f32x4 b0 = *(const f32x4*)(dt_bias + 8 * fq), b1 = *(const f32x4*)(dt_bias + 8 * fq + 4);
#pragma unroll
                for (int ai = 0; ai < 2; ++ai)
#pragma unroll
                    for (int m = 0; m < 4; ++m) {
                        const int gt = rbase + ai * 128 + m * 16;
                        f32x4 v0 = acc[ai][0][m][0] + b0, v1 = acc[ai][0][m][1] + b1;
#pragma unroll
                        for (int j = 0; j < 4; ++j) { v0[j] = fmaxf(v0[j], 0.f) + __logf(1.f + __expf(-fabsf(v0[j]))); v1[j] = fmaxf(v1[j], 0.f) + __logf(1.f + __expf(-fabsf(v1[j]))); }
                        *(f32x4*)(DT + (size_t)gt * 16 + 8 * fq) = v0; *(f32x4*)(DT + (size_t)gt * 16 + 8 * fq + 4) = v1;
                        __builtin_amdgcn_sched_barrier(0);
                    }
            }
        } else {
            const int pk = pn - 35;
#pragma unroll
            for (int ai = 0; ai < 2; ++ai)
#pragma unroll
                for (int m = 0; m < 4; ++m) {
                    const int mrow = rbase + ai * 128 + m * 16 - T_ALL;
#pragma unroll
                    for (int bj = 0; bj < 2; ++bj) {
                        const f32x4 v0 = acc[ai][bj][m][0], v1 = acc[ai][bj][m][1];
                        if (pk < 4) {
                            u32x4 w; w.x = pk2(v0.x, v0.y); w.y = pk2(v0.z, v0.w); w.z = pk2(v1.x, v1.y); w.w = pk2(v1.z, v1.w);
                            *(u32x4*)(KB + (size_t)mrow * 1024 + pk * 256 + bj * 128 + cl) = w;
                        } else {
                            u32x4 w; w.x = pk2(v0.x, v0.y); w.y = pk2(v0.z, v0.w); w.z = pk2(v1.x, v1.y); w.w = pk2(v1.z, v1.w);
                            *(u32x4*)(VT + (size_t)((((u.pm - T_ALL / 256) * 4 + (pk - 4)) * 2 + bj) * 32768) + (mrow & 255) * 128 + cl) = w;
                        }
                    }
                    __builtin_amdgcn_sched_barrier(0);
                }
        }
    }
};

struct P2Ptrs {
    bf16_t *YB, *XBC, *GV, *KB, *VT, *WSP; float *DT, *VSS, *SSS;
    bf16_t *YD, *ST; float* CD;
    const float *conv_w, *conv_b, *a_log, *d_skip, *ssd_norm, *gmlp_norm, *b_spatial;
    int tok0, slab;
};

constexpr int RP = 272;
__device__ __forceinline__ void conv_w8(const float* conv_w, const float* conv_b, int ch, float (&w)[4][8], float (&bb)[8]) {
#pragma unroll
    for (int k = 0; k < 4; ++k) { const f32x4 a = *(const f32x4*)(conv_w + k * 1536 + ch), b = *(const f32x4*)(conv_w + k * 1536 + ch + 4);
        w[k][0] = a.x; w[k][1] = a.y; w[k][2] = a.z; w[k][3] = a.w; w[k][4] = b.x; w[k][5] = b.y; w[k][6] = b.z; w[k][7] = b.w; }
    const f32x4 a = *(const f32x4*)(conv_b + ch), b = *(const f32x4*)(conv_b + ch + 4); bb[0] = a.x; bb[1] = a.y; bb[2] = a.z; bb[3] = a.w; bb[4] = b.x; bb[5] = b.y; bb[6] = b.z; bb[7] = b.w;
}
__device__ __forceinline__ void unpack8(const u32x4 raw, float (&x)[8]) {
    x[0] = bf_lo(raw.x); x[1] = bf_hi(raw.x); x[2] = bf_lo(raw.y); x[3] = bf_hi(raw.y); x[4] = bf_lo(raw.z); x[5] = bf_hi(raw.z); x[6] = bf_lo(raw.w); x[7] = bf_hi(raw.w);
}
template <int NR>
__device__ __forceinline__ void conv_load(u32x4 (&raw)[NR + 3], const bf16_t* xsrc  , int r0, bool at_seq_start) {
#pragma unroll
    for (int q = 0; q < NR + 3; ++q) { raw[q] = (u32x4){0u, 0u, 0u, 0u}; if (!at_seq_start || r0 + q - 3 >= 0) raw[q] = *(const u32x4*)(xsrc + (q - 3) * 1536); }
}
template <int NR, class F>
__device__ __forceinline__ void conv_compute(const u32x4 (&raw)[NR + 3], const float (&w)[4][8], const float (&bb)[8], F&& emit) {
    float xm[3][8];
    unpack8(raw[0], xm[0]); unpack8(raw[1], xm[1]); unpack8(raw[2], xm[2]);
#pragma unroll
    for (int rr = 0; rr < NR; ++rr) {
        float cur[8], o[8]; unpack8(raw[rr + 3], cur);
#pragma unroll
        for (int j = 0; j < 8; ++j) { const float v = bb[j] + w[0][j] * xm[0][j] + w[1][j] * xm[1][j] + w[2][j] * xm[2][j] + w[3][j] * cur[j]; o[j] = silu_f(v);
            xm[0][j] = xm[1][j]; xm[1][j] = xm[2][j]; xm[2][j] = cur[j]; }
        emit(rr, o);
    }
}
template <int NR, class F>
__device__ __forceinline__ void conv_rows(const bf16_t* xsrc, int r0, bool at_seq_start, const float (&w)[4][8], const float (&bb)[8], F&& emit) {
    u32x4 raw[NR + 3]; conv_load<NR>(raw, xsrc, r0, at_seq_start); conv_compute<NR>(raw, w, bb, emit);
}
__device__ __forceinline__ float dt_scan(const float* DT, size_t tok, int h, float a_h, LAS float* dtv, LAS float* acs, int lane) {
    const float d0 = DT[(tok + 2 * lane) * 16 + h], d1 = DT[(tok + 2 * lane + 1) * 16 + h];
    const float s0 = d0 * a_h, s1 = s0 + d1 * a_h;
    float inc = s1;
#pragma unroll
    for (int o = 1; o < 64; o <<= 1) { const float t = __shfl_up(inc, o); if (lane >= o) inc += t; }
    const float exc = inc - s1;
    if (dtv) { dtv[2 * lane] = d0; dtv[2 * lane + 1] = d1; }
    acs[2 * lane] = exc + s0; acs[2 * lane + 1] = inc;
    return __shfl(inc, 63);
}
__device__ __forceinline__ void ssd_a_item(const Ctx& C, const P2Ptrs& P, int idx) {
    LAS unsigned char* L = C.lds;
    constexpr int O_C = 0, O_B = 34816, O_BT = 69632, O_XT = 104448, O_XW = 121856, O_DT = 139264, O_ACS = 143360, O_CW = 147456;
    constexpr int XSP = 144;
    const int tid = C.tid, lane = C.lane, wid = C.wid, fr = lane & 15, fq = lane >> 4;
    const int bl = idx >> 5, c = (idx >> 1) & 15, g = idx & 1;
    const int lt0 = bl * SEQ + c * 128;
    const bool seq_start = (c == 0);
    LAS float* dtv = (LAS float*)(L + O_DT); LAS float* acs = (LAS float*)(L + O_ACS);
    const int bcc = tid & 31, bseg = tid >> 5, br0 = bseg * 8;
    const int bch = (bcc < 16) ? 1024 + g * 128 + bcc * 8 : 1280 + g * 128 + (bcc - 16) * 8;
    u32x4 braw[11]; conv_load<8>(braw, P.XBC + (size_t)(lt0 + br0) * 1536 + bch, br0, seq_start);
    float bw[4][8], bbb[8]; conv_w8(P.conv_w, P.conv_b, bch, bw, bbb);
    {
        float cwv[5];
#pragma unroll
        for (int k = 0; k < 5; ++k) cwv[k] = (k < 4) ? P.conv_w[k * 1536 + g * 512 + tid] : P.conv_b[g * 512 + tid];
#pragma unroll
        for (int k = 0; k < 5; ++k) ((LAS float*)(L + O_CW))[k * 512 + tid] = cwv[k];
    }
    {
        const int h = g * 8 + wid;
        const float tot = dt_scan(P.DT, (size_t)(P.tok0 + lt0), h, -__expf(P.a_log[h]), dtv + wid * 128, acs + wid * 128, lane);
        if (lane == 0) P.CD[(bl * 16 + c) * 16 + h] = __expf(tot);
    }
    {
        const int cc = bcc, r0 = br0;
        const int rm = (cc < 16 ? O_B : O_C) + (cc & 15) * 16, tr = O_BT + (cc & 15) * 8 * RP;
        conv_compute<8>(braw, bw, bbb, [&](int rr, const float (&o)[8]) {
            const int r = r0 + rr;
            u32x4 pk; pk.x = pk2(o[0], o[1]); pk.y = pk2(o[2], o[3]); pk.z = pk2(o[4], o[5]); pk.w = pk2(o[6], o[7]);
            *(LAS u32x4*)(L + rm + r * RP) = pk;
            if (cc < 16) {
                *(LAS unsigned short*)(L + tr + 0 * RP + r * 2) = (unsigned short)(pk.x & 0xffffu); *(LAS unsigned short*)(L + tr + 1 * RP + r * 2) = (unsigned short)(pk.x >> 16);
                *(LAS unsigned short*)(L + tr + 2 * RP + r * 2) = (unsigned short)(pk.y & 0xffffu); *(LAS unsigned short*)(L + tr + 3 * RP + r * 2) = (unsigned short)(pk.y >> 16);
                *(LAS unsigned short*)(L + tr + 4 * RP + r * 2) = (unsigned short)(pk.z & 0xffffu); *(LAS unsigned short*)(L + tr + 5 * RP + r * 2) = (unsigned short)(pk.z >> 16);
                *(LAS unsigned short*)(L + tr + 6 * RP + r * 2) = (unsigned short)(pk.w & 0xffffu); *(LAS unsigned short*)(L + tr + 7 * RP + r * 2) = (unsigned short)(pk.w >> 16);
            }
        });
    }
    __syncthreads();
    const int l0 = 16 * wid, fb = fr * RP + fq * 16, fbw = fb + l0 * RP, l = l0 + fr;
    f32x4 cb[8];
    {
        bf16x8 cf[4];
#pragma unroll
        for (int ks = 0; ks < 4; ++ks) cf[ks] = *(const LAS bf16x8*)(L + O_C + fbw + ks * 64);
#pragma unroll
        for (int j = 0; j < 8; ++j) {
            cb[j] = (f32x4){0.f, 0.f, 0.f, 0.f};
#pragma unroll
            for (int ks = 0; ks < 4; ++ks) { const bf16x8 bf = *(const LAS bf16x8*)(L + O_B + fb + j * 16 * RP + ks * 64); cb[j] = mfma16(bf, cf[ks], cb[j]); }
        }
    }
    __syncthreads();
    const int xcc = tid & 7, xseg = tid >> 3, xr0 = xseg * 2;
    u32x4 xraw[5];
    conv_load<2>(xraw, P.XBC + (size_t)(lt0 + xr0) * 1536 + (g * 8) * 64 + xcc * 8, xr0, seq_start);
    for (int hh = 0; hh < 8; ++hh) {
        const int h = g * 8 + hh;
        const float d_h = P.d_skip[h];
        LAS float* acsh = acs + hh * 128; LAS float* dth = dtv + hh * 128;
        {
            float w[4][8], bb[8];
#pragma unroll
            for (int k = 0; k < 4; ++k) { const f32x4 a4 = *(const LAS f32x4*)(L + O_CW + (k * 512 + hh * 64 + xcc * 8) * 4), b4 = *(const LAS f32x4*)(L + O_CW + (k * 512 + hh * 64 + xcc * 8 + 4) * 4);
                w[k][0] = a4.x; w[k][1] = a4.y; w[k][2] = a4.z; w[k][3] = a4.w; w[k][4] = b4.x; w[k][5] = b4.y; w[k][6] = b4.z; w[k][7] = b4.w; }
            { const f32x4 a4 = *(const LAS f32x4*)(L + O_CW + (4 * 512 + hh * 64 + xcc * 8) * 4), b4 = *(const LAS f32x4*)(L + O_CW + (4 * 512 + hh * 64 + xcc * 8 + 4) * 4);
                bb[0] = a4.x; bb[1] = a4.y; bb[2] = a4.z; bb[3] = a4.w; bb[4] = b4.x; bb[5] = b4.y; bb[6] = b4.z; bb[7] = b4.w; }
            const float acs_last = acsh[127];
            const int cc = xcc, r0 = xr0;
            conv_compute<2>(xraw, w, bb, [&](int rr, const float (&o)[8]) {
                const int r = r0 + rr;
                u32x4 pk; pk.x = pk2(o[0], o[1]); pk.y = pk2(o[2], o[3]); pk.z = pk2(o[4], o[5]); pk.w = pk2(o[6], o[7]);
                *(LAS u32x4*)(L + O_B + r * XSP + cc * 16) = pk;
                const float dtr = dth[r], wd = dtr * __expf(acs_last - acsh[r]);
#pragma unroll
                for (int j = 0; j < 8; ++j) {
                    *(LAS unsigned short*)(L + O_XT + (cc * 8 + j) * RP + r * 2) = (unsigned short)(pk2(o[j] * dtr, 0.f) & 0xffffu);
                    *(LAS unsigned short*)(L + O_XW + (cc * 8 + j) * RP + r * 2) = (unsigned short)(pk2(o[j] * wd, 0.f) & 0xffffu);
                }
            });
            if (hh + 1 < 8) conv_load<2>(xraw, P.XBC + (size_t)(lt0 + xr0) * 1536 + (h + 1) * 64 + xcc * 8, xr0, seq_start);
        }
        {
            const float al = acsh[l];
#pragma unroll
            for (int j = 0; j < 8; ++j) {
                const f32x4 as = *(const LAS f32x4*)(L + O_ACS + (hh * 128 + 16 * j + 4 * fq) * 4);
                float mv[4];
#pragma unroll
                for (int r = 0; r < 4; ++r) { const int sidx = 16 * j + 4 * fq + r; mv[r] = (sidx <= l) ? cb[j][r] * __expf(al - as[r]) : 0.f; }
                u32x2 wv; wv.x = pk2(mv[0], mv[1]); wv.y = pk2(mv[2], mv[3]);
                *(LAS u32x2*)(L + O_C + l * RP + fq * 8 + j * 32) = wv;
            }
        }
        __syncthreads();
        {
            bf16x8 mf[4];
#pragma unroll
            for (int ks = 0; ks < 4; ++ks) mf[ks] = *(const LAS bf16x8*)(L + O_C + fbw + ks * 64);
            bf16_t* yblk = P.YD + (size_t)((((lt0 + l0) >> 4) * 16 + h) * 2) * 512 + lane * 8;
            u32x2 yo4[4];
#pragma unroll
            for (int jj = 0; jj < 4; ++jj) {
                f32x4 yd = {0.f, 0.f, 0.f, 0.f};
#pragma unroll
                for (int ks = 0; ks < 4; ++ks) { const bf16x8 xf = *(const LAS bf16x8*)(L + O_XT + fb + jj * 16 * RP + ks * 64); yd = mfma16(xf, mf[ks], yd); }
                const u32x2 xs4 = *(const LAS u32x2*)(L + O_B + l * XSP + fq * 8 + jj * 32);
                yo4[jj].x = pk2(yd[0] + d_h * bf_lo(xs4.x), yd[1] + d_h * bf_hi(xs4.x)); yo4[jj].y = pk2(yd[2] + d_h * bf_lo(xs4.y), yd[3] + d_h * bf_hi(xs4.y));
            }
            *(u32x4*)yblk = (u32x4){yo4[0].x, yo4[0].y, yo4[1].x, yo4[1].y}; *(u32x4*)(yblk + 512) = (u32x4){yo4[2].x, yo4[2].y, yo4[3].x, yo4[3].y};
        }
        {
            const int pt = wid & 3, nh = wid >> 2;
            bf16x8 xw[4];
#pragma unroll
            for (int ks = 0; ks < 4; ++ks) xw[ks] = *(const LAS bf16x8*)(L + O_XW + fb + pt * 16 * RP + ks * 64);
            bf16_t* sp = P.ST + (size_t)((bl * 16 + c) * 16 + h) * 8192 + pt * 2048 + fr * 32 + 4 * fq;
#pragma unroll
            for (int jj = 0; jj < 4; ++jj) {
                f32x4 st = {0.f, 0.f, 0.f, 0.f};
#pragma unroll
                for (int ks = 0; ks < 4; ++ks) { const bf16x8 bt = *(const LAS bf16x8*)(L + O_BT + fb + (nh * 4 + jj) * 16 * RP + ks * 64); st = mfma16(bt, xw[ks], st); }
                u32x2 o; o.x = pk2(st[0], st[1]); o.y = pk2(st[2], st[3]);
                *(u32x2*)(sp + ((nh * 4 + jj) >> 1) * 512 + ((nh * 4 + jj) & 1) * 16) = o;
            }
        }
        __syncthreads();
    }
}
__device__ __forceinline__ void ssd_scan_item(const Ctx& C, const P2Ptrs& P, int idx) {
    const int bh = idx >> 2, part = idx & 3, bl = bh >> 4, h = bh & 15;
    const size_t e0 = (size_t)part * 2048 + C.tid * 4;
    u32x2 v[16]; float dec[16];
#pragma unroll
    for (int c = 0; c < 16; ++c) { v[c] = *(const u32x2*)(P.ST + (size_t)((bl * 16 + c) * 16 + h) * 8192 + e0); dec[c] = P.CD[(bl * 16 + c) * 16 + h]; }
    float run[4] = {0.f, 0.f, 0.f, 0.f};
#pragma unroll
    for (int c = 0; c < 16; ++c) {
        u32x2 o; o.x = pk2(run[0], run[1]); o.y = pk2(run[2], run[3]);
        *(u32x2*)(P.ST + (size_t)((bl * 16 + c) * 16 + h) * 8192 + e0) = o;
        run[0] = run[0] * dec[c] + bf_lo(v[c].x); run[1] = run[1] * dec[c] + bf_hi(v[c].x); run[2] = run[2] * dec[c] + bf_lo(v[c].y); run[3] = run[3] * dec[c] + bf_hi(v[c].y);
    }
}
__device__ __forceinline__ void ssd_c_item(const Ctx& C, const P2Ptrs& P, int idx) {
    LAS unsigned char* L = C.lds;
    constexpr int O_C = 0, O_ACS = 34816;
    const int tid = C.tid, lane = C.lane, wid = C.wid, fr = lane & 15, fq = lane >> 4;
    const int bl = idx >> 5, c = (idx >> 1) & 15, g = idx & 1;
    const int lt0 = bl * SEQ + c * 128;
    LAS float* acs = (LAS float*)(L + O_ACS);
    {
        const int cc = tid & 15, seg = tid >> 4, r0 = seg * 4;
        const int ch = 1280 + g * 128 + cc * 8;
        u32x4 craw[7]; conv_load<4>(craw, P.XBC + (size_t)(lt0 + r0) * 1536 + ch, r0, c == 0);
        float w[4][8], bb[8]; conv_w8(P.conv_w, P.conv_b, ch, w, bb);
        { const int h = g * 8 + wid; (void)dt_scan(P.DT, (size_t)(P.tok0 + lt0), h, -__expf(P.a_log[h]), (LAS float*)nullptr, acs + wid * 128, lane); }
        conv_compute<4>(craw, w, bb, [&](int rr, const float (&o)[8]) {
            u32x4 pk; pk.x = pk2(o[0], o[1]); pk.y = pk2(o[2], o[3]); pk.z = pk2(o[4], o[5]); pk.w = pk2(o[6], o[7]);
            *(LAS u32x4*)(L + O_C + (r0 + rr) * RP + cc * 16) = pk;
        });
    }
    __syncthreads();
    const int l0 = 16 * wid, l = l0 + fr;
    bf16x8 cf[4];
#pragma unroll
    for (int ks = 0; ks < 4; ++ks) cf[ks] = *(const LAS bf16x8*)(L + O_C + (l0 + fr) * RP + fq * 16 + ks * 64);
    bf16_t* ZS = P.YB;
    float ssg = 0.f;
    constexpr int O_ST = 38912;
    u32x4 stA, stB;
#define PC_LD(HH) do { const bf16_t* sp_ = P.ST + (size_t)((bl * 16 + c) * 16 + g * 8 + (HH)) * 8192 + tid * 16; stA = *(const u32x4*)sp_; stB = *(const u32x4*)(sp_ + 8); } while (0)
#define PC_ST(HH) do { *(LAS u32x4*)(L + O_ST + ((HH) & 1) * 16384 + tid * 32) = stA; *(LAS u32x4*)(L + O_ST + ((HH) & 1) * 16384 + tid * 32 + 16) = stB; } while (0)
    PC_LD(0); PC_ST(0);
    __syncthreads();
#pragma unroll 1
    for (int hh = 0; hh < 8; ++hh) {
        const int h = g * 8 + hh;
        if (hh + 1 < 8) PC_LD(hh + 1);
        const float el = __expf(acs[hh * 128 + l]);
        const LAS unsigned char* sp = L + O_ST + (hh & 1) * 16384 + fr * 64 + fq * 16;
        bf16_t* zrow = ZS + (size_t)(lt0 + l) * 1024 + h * 64 + 4 * fq;
        const bf16_t* yblk = P.YD + (size_t)((((lt0 + l0) >> 4) * 16 + h) * 2) * 512 + lane * 8;
        const u32x4 ydv0 = *(const u32x4*)yblk, ydv1 = *(const u32x4*)(yblk + 512);
        const float* nwp = P.ssd_norm + h * 64 + 4 * fq;
        float ss = 0.f;
#pragma unroll
        for (int jj = 0; jj < 4; ++jj) {
            f32x4 yo = {0.f, 0.f, 0.f, 0.f};
#pragma unroll
            for (int ks = 0; ks < 4; ++ks) { const bf16x8 sf = *(const LAS bf16x8*)(sp + jj * 4096 + ks * 1024); yo = mfma16(sf, cf[ks], yo); }
            const u32x4 ydv = (jj < 2) ? ydv0 : ydv1; const u32x2 yd4 = (jj & 1) ? (u32x2){ydv.z, ydv.w} : (u32x2){ydv.x, ydv.y}, zs4 = *(const u32x2*)(zrow + 16 * jj);
            const f32x4 nw = *(const f32x4*)(nwp + 16 * jj);
            float v[4];
            v[0] = (bf_lo(yd4.x) + el * yo[0]) * bf_lo(zs4.x); v[1] = (bf_hi(yd4.x) + el * yo[1]) * bf_hi(zs4.x);
            v[2] = (bf_lo(yd4.y) + el * yo[2]) * bf_lo(zs4.y); v[3] = (bf_hi(yd4.y) + el * yo[3]) * bf_hi(zs4.y);
            ss += (v[0] * v[0] + v[1] * v[1]) + (v[2] * v[2] + v[3] * v[3]);
            u32x2 o; o.x = pk2(v[0] * nw.x, v[1] * nw.y); o.y = pk2(v[2] * nw.z, v[3] * nw.w);
            *(u32x2*)(zrow + 16 * jj) = o;
        }
        ssg += ss;
        if (hh + 1 < 8) PC_ST(hh + 1);
        __syncthreads();
    }
#undef PC_LD
#undef PC_ST
    ssg += __shfl_xor(ssg, 16); ssg += __shfl_xor(ssg, 32);
    if (fq == 0) P.SSS[(size_t)(P.tok0 + lt0 + l) * 2 + g] = ssg;
}

__device__ __forceinline__ void gmlp_item(const Ctx& C, const P2Ptrs& P, int idx) {
    LAS unsigned char* L = C.lds;
    const int tid = C.tid, lane = C.lane, wid = C.wid, fr = lane & 15, fq = lane >> 4;
    const int bl = idx >> 7, c = (idx >> 3) & 15, g = idx & 7;
    const int lt0 = bl * SEQ + c * 128;
    bf16_t* GU = P.YB + (size_t)TS * 1024;
    const int s = tid >> 2, qd = tid & 3;
    u32x4 raw[4];
#pragma unroll
    for (int k = 0; k < 4; ++k) raw[k] = *(const u32x4*)(P.GV + (size_t)(lt0 + s) * 1024 + g * 128 + k * 32 + qd * 8);
    const float ssq = sum16(P.VSS + (size_t)(P.tok0 + lt0 + s) * 16);
    const int t0 = 16 * wid, nks = (t0 + 15) / 32 + 1, t = t0 + fr;
    bf16x8 wf[4];
#pragma unroll
    for (int ks = 0; ks < 4; ++ks) { wf[ks] = (bf16x8){0, 0, 0, 0, 0, 0, 0, 0}; if (ks < nks) wf[ks] = *(const bf16x8*)(P.WSP + (size_t)g * 16384 + ((wid * 4 + ks) * 16 + fr) * 32 + fq * 8); }
    bf16_t* gp0 = GU + (size_t)(lt0 + t) * 1024 + g * 128 + 8 * fq;
    u32x4 gu[4];
#pragma unroll
    for (int j = 0; j < 4; ++j) gu[j] = *(const u32x4*)(gp0 + 32 * j);
    const float bias = P.b_spatial[g * 128 + t];
    {
        const float rstd = rsqrtf(ssq * (1.f / 1024.f) + EPS);
#pragma unroll
        for (int k = 0; k < 4; ++k) {
            const int ch0 = k * 32 + qd * 8;
            const f32x4 n0 = *(const f32x4*)(P.gmlp_norm + g * 128 + ch0), n1 = *(const f32x4*)(P.gmlp_norm + g * 128 + ch0 + 4);
            float v[8]; v[0] = bf_lo(raw[k].x) * n0.x; v[1] = bf_hi(raw[k].x) * n0.y; v[2] = bf_lo(raw[k].y) * n0.z; v[3] = bf_hi(raw[k].y) * n0.w;
            v[4] = bf_lo(raw[k].z) * n1.x; v[5] = bf_hi(raw[k].z) * n1.y; v[6] = bf_lo(raw[k].w) * n1.z; v[7] = bf_hi(raw[k].w) * n1.w;
#pragma unroll
            for (int j = 0; j < 8; ++j) *(LAS unsigned short*)(L + (32 * k + 16 * (j >> 2) + 4 * qd + (j & 3)) * RP + s * 2) = (unsigned short)(pk2(v[j] * rstd, 0.f) & 0xffffu);
        }
    }
    __syncthreads();
    const int fb = fr * RP + fq * 16;
    f32x4 acc[8];
#pragma unroll
    for (int j = 0; j < 8; ++j) acc[j] = (f32x4){0.f, 0.f, 0.f, 0.f};
#pragma unroll
    for (int ks = 0; ks < 4; ++ks) {
        if (ks < nks) {
#pragma unroll
            for (int j = 0; j < 8; ++j) { const bf16x8 vf = *(const LAS bf16x8*)(L + fb + j * 16 * RP + ks * 64); acc[j] = mfma16(vf, wf[ks], acc[j]); }
        }
    }
#pragma unroll
    for (int j = 0; j < 4; ++j) {
        u32x4 o; o.x = pk2(bf_lo(gu[j].x) * (acc[2 * j][0] + bias), bf_hi(gu[j].x) * (acc[2 * j][1] + bias)); o.y = pk2(bf_lo(gu[j].y) * (acc[2 * j][2] + bias), bf_hi(gu[j].y) * (acc[2 * j][3] + bias));
        o.z = pk2(bf_lo(gu[j].z) * (acc[2 * j + 1][0] + bias), bf_hi(gu[j].z) * (acc[2 * j + 1][1] + bias)); o.w = pk2(bf_lo(gu[j].w) * (acc[2 * j + 1][2] + bias), bf_hi(gu[j].w) * (acc[2 * j + 1][3] + bias));
        *(u32x4*)(gp0 + 32 * j) = o;
    }
}

__device__ __forceinline__ void xattn_item(const Ctx& C, const P2Ptrs& P, int idx) {
    LAS unsigned char* L = C.lds;
    constexpr int VP = 288, O_A = 0, O_B = 73728;
    const int tid = C.tid, lane = C.lane, wid = C.wid, fr = lane & 15, fq = lane >> 4;
    const int bl = idx >> 5, h = (idx >> 3) & 3, qt = idx & 7;
    const int b = P.slab * 8 + bl;
    const int lt = bl * SEQ + qt * 256 + 32 * wid + fr;
    bf16_t* QX = P.YB + (size_t)2 * TS * 1024;
    bf16_t* qrow = QX + (size_t)lt * 1024 + h * 256;
    const int srow = tid >> 4, sc16 = tid & 15;
    const int fb = fr * RP + fq * 16;
    const int trb = (4 * fq + ((lane & 15) >> 2)) * VP + (lane & 3) * 8;
    u32x4 stg[8];
    const bf16_t* kg = P.KB + (size_t)(b * 256 + srow) * 1024 + h * 256 + sc16 * 8;
    const bf16_t* vg = P.VT + ((size_t)((b * 4 + h) * 2) * 256 + srow) * 128 + sc16 * 8;
#define XA_LOADK(half) do { unsigned ko_ = (half) * 256u; _Pragma("unroll") for (int q = 0; q < 8; ++q) { stg[q] = *(const u32x4*)((const unsigned char*)kg + ko_); ko_ += 32u * 2048u; asm volatile("" : "+v"(ko_)); } } while (0)
#define XA_LOADV(half) do { unsigned vo_ = (half) * 65536u; _Pragma("unroll") for (int q = 0; q < 8; ++q) { stg[q] = *(const u32x4*)((const unsigned char*)vg + vo_); vo_ += 32u * 256u; asm volatile("" : "+v"(vo_)); } } while (0)
#define XA_STOREK(buf) do { _Pragma("unroll") for (int q = 0; q < 8; ++q) *(LAS u32x4*)(L + (buf) + (srow + 32 * q) * RP + sc16 * 16) = stg[q]; } while (0)
#define XA_STOREV(buf) do { _Pragma("unroll") for (int q = 0; q < 8; ++q) *(LAS u32x4*)(L + (buf) + (srow + 32 * q) * VP + sc16 * 16) = stg[q]; } while (0)
#define XA_QK(buf, half) do { _Pragma("unroll") for (int j = 0; j < 16; ++j) { _Pragma("unroll") for (int ks = 0; ks < 4; ++ks) { const bf16x8 kf = *(const LAS bf16x8*)(L + (buf) + fb + j * 16 * RP + ks * 64); \
        s0[j] = mfma16(kf, qf[0][ks], s0[j]); s1[j] = mfma16(kf, qf[1][ks], s1[j]); } if ((j & 1) == 1) __builtin_amdgcn_sched_barrier(0); } } while (0)
    XA_LOADK(0);
    bf16x8 qf[2][4];
#define XA_LOADQ(half) do { _Pragma("unroll") for (int rb = 0; rb < 2; ++rb) { _Pragma("unroll") for (int ks = 0; ks < 4; ++ks) qf[rb][ks] = *(const bf16x8*)(qrow + rb * 16 * 1024 + (half) * 128 + ks * 32 + fq * 8); } } while (0)
    XA_LOADQ(0);
    f32x4 s0[16], s1[16];
#pragma unroll
    for (int j = 0; j < 16; ++j) { s0[j] = (f32x4){0.f, 0.f, 0.f, 0.f}; s1[j] = (f32x4){0.f, 0.f, 0.f, 0.f}; }
    XA_STOREK(O_A);
    __syncthreads();
    XA_LOADK(1);
    XA_QK(O_A, 0);
    XA_LOADQ(1);
    XA_STOREK(O_B);
    __syncthreads();
    XA_QK(O_B, 1);
    u32x2 p0r[16], p1r[16]; float inv0, inv1;
#define XA_SOFTMAX(S, PR, INV) do { float mx = -3.0e38f; _Pragma("unroll") for (int j = 0; j < 16; ++j) mx = fmaxf(fmaxf(fmaxf(S[j][0], S[j][1]), fmaxf(S[j][2], S[j][3])), mx); \
        mx = fmaxf(mx, __shfl_xor(mx, 16)); mx = fmaxf(mx, __shfl_xor(mx, 32)); float sum = 0.f; \
        _Pragma("unroll") for (int j = 0; j < 16; ++j) { const float e0 = __expf(S[j][0] - mx), e1 = __expf(S[j][1] - mx), e2 = __expf(S[j][2] - mx), e3 = __expf(S[j][3] - mx); sum += (e0 + e1) + (e2 + e3); PR[j].x = pk2(e0, e1); PR[j].y = pk2(e2, e3); } \
        sum += __shfl_xor(sum, 16); sum += __shfl_xor(sum, 32); INV = 1.f / sum; } while (0)
    __builtin_amdgcn_sched_barrier(0);
    XA_SOFTMAX(s0, p0r, inv0);
    __builtin_amdgcn_sched_barrier(0);
    XA_LOADV(0);
    XA_SOFTMAX(s1, p1r, inv1);
    __builtin_amdgcn_sched_barrier(0);
    XA_STOREV(O_A);
    __syncthreads();
    XA_LOADV(1);
#define XA_PV(buf, dh) do { _Pragma("unroll") for (int jd = 0; jd < 8; ++jd) { f32x4 o0 = {0.f, 0.f, 0.f, 0.f}, o1 = {0.f, 0.f, 0.f, 0.f}; \
        _Pragma("unroll") for (int ks = 0; ks < 8; ++ks) { const s16x4 vlo = __builtin_amdgcn_ds_read_tr16_b64_v4i16((LAS s16x4*)(L + (buf) + trb + ks * 32 * VP + jd * 32)), vhi = __builtin_amdgcn_ds_read_tr16_b64_v4i16((LAS s16x4*)(L + (buf) + trb + (ks * 32 + 16) * VP + jd * 32)); \
            const s16x8 v8 = {vlo.x, vlo.y, vlo.z, vlo.w, vhi.x, vhi.y, vhi.z, vhi.w}; const bf16x8 vf = __builtin_bit_cast(bf16x8, v8); \
            const u32x4 a0 = {p0r[2 * ks].x, p0r[2 * ks].y, p0r[2 * ks + 1].x, p0r[2 * ks + 1].y}, a1 = {p1r[2 * ks].x, p1r[2 * ks].y, p1r[2 * ks + 1].x, p1r[2 * ks + 1].y}; \
            o0 = mfma16(vf, __builtin_bit_cast(bf16x8, a0), o0); o1 = mfma16(vf, __builtin_bit_cast(bf16x8, a1), o1); } \
        u32x2 w0, w1; w0.x = pk2(o0[0] * inv0, o0[1] * inv0); w0.y = pk2(o0[2] * inv0, o0[3] * inv0); w1.x = pk2(o1[0] * inv1, o1[1] * inv1); w1.y = pk2(o1[2] * inv1, o1[3] * inv1); \
        *(u32x2*)(qrow + (dh) * 128 + 16 * jd + 4 * fq) = w0; *(u32x2*)(qrow + 16 * 1024 + (dh) * 128 + 16 * jd + 4 * fq) = w1; __builtin_amdgcn_sched_barrier(0); } } while (0)
    XA_PV(O_A, 0);
    XA_STOREV(O_B);
    __syncthreads();
    XA_PV(O_B, 1);
#undef XA_LOADK
#undef XA_LOADQ
#undef XA_LOADV
#undef XA_STOREK
#undef XA_STOREV
#undef XA_QK
#undef XA_SOFTMAX
#undef XA_PV
}

__device__ __forceinline__ void p2_mixers(const Ctx& C, const P2Ptrs& P, unsigned* queue) {
    LAS int* slot = (LAS int*)(C.lds + LDS_BYTES - 16);
    for (;;) {
        __syncthreads();
        if (C.tid == 0) *slot = (int)atomicAdd(queue, 1u);
        __syncthreads();
        const int item = *slot;
        if (item >= 256 + 256 + 1024) break;
        Ctx Ci = C; { int t_ = C.tid; asm volatile("" : "+v"(t_)); Ci.tid = t_; Ci.lane = t_ & 63; }
        if (item < 768) { const int k = item / 3, r = item - 3 * k; if (r == 0) ssd_a_item(Ci, P, k); else if (r == 1) xattn_item(Ci, P, k); else gmlp_item(Ci, P, k); }
        else gmlp_item(Ci, P, 256 + (item - 768));
    }
}
__device__ __forceinline__ void p2_scan(const Ctx& C, const P2Ptrs& P) { for (int it = C.bid; it < 512; it += C.G) ssd_scan_item(C, P, it); }
__device__ __forceinline__ void p2_pass_c(const Ctx& C, const P2Ptrs& P) { for (int it = C.bid; it < 256; it += C.G) { ssd_c_item(C, P, it); __syncthreads(); } }

struct SchedBranch {
    int G, c;
    __device__ __forceinline__ bool next(int i, pg8::Unit& u) const {
        const int tile = i / 3, n = i - 3 * tile; const int L = tile * G + c; if (L >= 256) return false;
        const int wgid = (L % 8) * 32 + L / 8;
        u.pm = n * 64 + (wgid >> 2); u.pn = n * 4 + (wgid & 3); return true;
    }
    __device__ __forceinline__ void a_ready(const pg8::Unit&) const {}
    __device__ __forceinline__ void done(const pg8::Unit&) const {}
};
struct EpiBranch {
    static constexpr bool PERM = true, AFTER_DRAIN = false, WANTS_SCRATCH = false, MUT_ACC = true;
    unsigned char* ws; int tok0; int noop;
    __device__ __forceinline__ void operator()(f32x4 (&acc)[2][2][4][2], const pg8::Unit& u, int wr, int wc, int fr, int fq) const {
        const int n = u.pn >> 2, pn = u.pn & 3, pm = u.pm & 63;
        if (noop == 1) { asm volatile("" :: "v"(acc[0][0][0][0][0]), "v"(acc[1][1][3][1][3])); return; }
        const unsigned char* const SG = ws + WS_SLAB + SL_SG; unsigned char* const MB = ws + WS_H + (size_t)tok0 * 2048; const float* const SSS = (const float*)(ws + WS_SSS) + (size_t)tok0 * 2;
        const unsigned lg = (unsigned)(fr + 16 * fq) * 8u;
        const unsigned lm = (unsigned)(fr * 1024 + 8 * fq) * 2u;
        const unsigned ls = (unsigned)fr * 8u;
        const unsigned char* const rg = SG + (size_t)((pm * 12 + n * 4 + pn) * 65536 + (wr * 4 + wc) * 8192);
        unsigned char* const rm = MB + (size_t)((pm * 256 + wr * 64) * 1024 + pn * 256 + wc * 32) * 2;
        const unsigned char* const rs_ = (const unsigned char*)SSS + (size_t)(pm * 256 + wr * 64) * 8;
#define EB_OFF(k) ((k) * 512)
#define EB_CVT4(w) (f32x4){(float)((w) & 0xffu), (float)(((w) >> 8) & 0xffu), (float)(((w) >> 16) & 0xffu), (float)((w) >> 24)}
#define EB_RCP4(w) (f32x4){__builtin_amdgcn_rcpf((float)((w) & 0xffu)), __builtin_amdgcn_rcpf((float)(((w) >> 8) & 0xffu)), __builtin_amdgcn_rcpf((float)(((w) >> 16) & 0xffu)), __builtin_amdgcn_rcpf((float)((w) >> 24))}
        if (n == 2) {
            u32x2 g[16];
#pragma unroll
            for (int k = 0; k < 16; ++k) g[k] = *(const u32x2*)(rg + (EB_OFF(k)) + lg);
#pragma unroll
            for (int k = 0; k < 16; ++k) {
                const int ai = k >> 3, m = (k >> 1) & 3, bj = k & 1;
                const f32x4 v0 = (acc[ai][bj][m][0] * (1.f / 255.f)) * EB_CVT4(g[k].x), v1 = (acc[ai][bj][m][1] * (1.f / 255.f)) * EB_CVT4(g[k].y);
                u32x4 w; w.x = pk2(v0.x, v0.y); w.y = pk2(v0.z, v0.w); w.z = pk2(v1.x, v1.y); w.w = pk2(v1.z, v1.w);
                *(u32x4*)(rm + ((ai * 128 + m * 16) * 1024 + bj * 128) * 2 + lm) = w;
                if ((k & 3) == 3) __builtin_amdgcn_sched_barrier(0);
            }
        }
        {
            constexpr int EB_RING = 4;
            u32x2 g[EB_RING][2], h[EB_RING][2], sq[EB_RING];
            const int hoff = (n < 2) ? 4 * 65536 : 0;
#define EB_LOADB(b, p) do { if (n < 2) { _Pragma("unroll") for (int j = 0; j < 2; ++j) { g[p][j] = *(const u32x2*)(rg + (EB_OFF((b) * 2 + j)) + lg); h[p][j] = *(const u32x2*)(rg + (hoff + EB_OFF((b) * 2 + j)) + lg); } \
            sq[p] = *(const u32x2*)(rs_ + ((((b) >> 2) * 128 + ((b) & 3) * 16) * 8) + ls); } \
            else { _Pragma("unroll") for (int j = 0; j < 2; ++j) { g[p][j] = (u32x2){0x01010101u, 0x01010101u}; h[p][j] = (u32x2){0x01010101u, 0x01010101u}; } sq[p] = (u32x2){0x3f800000u, 0x3f800000u}; } } while (0)
#pragma unroll
            for (int b = 0; b < EB_RING; ++b) EB_LOADB(b, b);
#pragma unroll
            for (int b = 0; b < 8; ++b) {
                const int p = b % EB_RING;
                const unsigned sqx = sq[p].x, sqy = sq[p].y;
                const float rsn = rsqrtf((__builtin_bit_cast(float, sqx) + __builtin_bit_cast(float, sqy)) * (1.f / 1024.f) + EPS);
                const float rs = (n == 0) ? rsn : (n == 1) ? 1.f : 0.f;
#pragma unroll
                for (int j = 0; j < 2; ++j) {
                    const int k = b * 2 + j, ai = k >> 3, m = (k >> 1) & 3, bj = k & 1;
                    const f32x4 r0 = EB_CVT4(g[p][j].x) * EB_RCP4(h[p][j].x), r1 = EB_CVT4(g[p][j].y) * EB_RCP4(h[p][j].y);
                    acc[ai][bj][m][0] = (acc[ai][bj][m][0] * rs) * r0;
                    acc[ai][bj][m][1] = (acc[ai][bj][m][1] * rs) * r1;
                }
                if (b + EB_RING < 8) EB_LOADB(b + EB_RING, p);
                __builtin_amdgcn_sched_barrier(0);
            }
#undef EB_LOADB
        }
#undef EB_OFF
#undef EB_CVT4
#undef EB_RCP4
    }
};
struct SchedTile256 {
    int G, c;
    __device__ __forceinline__ bool next(int i, pg8::Unit& u) const {
        const int L = i * G + c; if (L >= 256) return false;
        const int wgid = (L % 8) * 32 + L / 8; u.pm = wgid >> 2; u.pn = wgid & 3; return true;
    }
    __device__ __forceinline__ void a_ready(const pg8::Unit&) const {}
    __device__ __forceinline__ void done(const pg8::Unit&) const {}
};
struct EpiOut {
    static constexpr bool PERM = true, AFTER_DRAIN = false, WANTS_SCRATCH = false, MUT_ACC = false;
    const float* X; float* X2; unsigned char* ws; const float* ln_ffn; int tok0;
    __device__ __forceinline__ void operator()(const f32x4 (&acc)[2][2][4][2], const pg8::Unit& u, int wr, int wc, int fr, int fq) const {
        float* const XSS = (float*)(ws + WS_XSS);
        const int rbase = tok0 + u.pm * 256 + wr * 64 + fr;
        const int cbase = u.pn * 256 + wc * 32 + 8 * fq;
#pragma unroll
        for (int pr = 0; pr < 4; ++pr) {
            f32x4 xr[2][2][2];
#pragma unroll
            for (int q = 0; q < 2; ++q) { const int k = pr * 2 + q, ai = k >> 2, m = k & 3; const size_t off = (size_t)(rbase + ai * 128 + m * 16) * 1024 + cbase;
#pragma unroll
                for (int bj = 0; bj < 2; ++bj) { xr[q][bj][0] = *(const f32x4*)(X + off + bj * 128); xr[q][bj][1] = *(const f32x4*)(X + off + bj * 128 + 4); } }
#pragma unroll
            for (int q = 0; q < 2; ++q) { const int k = pr * 2 + q, ai = k >> 2, m = k & 3; const int gt = rbase + ai * 128 + m * 16; const size_t off = (size_t)gt * 1024 + cbase; float ss = 0.f;
#pragma unroll
                for (int bj = 0; bj < 2; ++bj) {
                    const f32x4 v0 = acc[ai][bj][m][0] + xr[q][bj][0], v1 = acc[ai][bj][m][1] + xr[q][bj][1];
                    { u32x4 wx; wx.x = pk2(v0.x, v0.y); wx.y = pk2(v0.z, v0.w); wx.z = pk2(v1.x, v1.y); wx.w = pk2(v1.z, v1.w); *(u32x4*)((bf16_t*)X2 + off + bj * 128) = wx; }
                    ss += (v0.x * v0.x + v0.y * v0.y) + (v0.z * v0.z + v0.w * v0.w) + (v1.x * v1.x + v1.y * v1.y) + (v1.z * v1.z + v1.w * v1.w);
                }
                ss += __shfl_xor(ss, 16); ss += __shfl_xor(ss, 32); if (fq == 0) XSS[(size_t)gt * 16 + u.pn * 4 + wc] = ss; }
            __builtin_amdgcn_sched_barrier(0);
        }
    }
};

struct SchedStatic {
    int nM, nN, nwg, G, c;
    __device__ __forceinline__ bool next(int i, pg8::Unit& u) const {
        const int L = i * G + c; if (L >= nwg) return false;
        int wgid = L; { const int q = nwg / 8, r = nwg % 8, xcd = wgid % 8, off = wgid / 8; wgid = (xcd < r ? xcd * (q + 1) : r * (q + 1) + (xcd - r) * q) + off; }
        const int nig = 8 * nN, gid = wgid / nig, fm = gid * 8, gsz = (nM - fm) < 8 ? (nM - fm) : 8;
        u.pm = fm + ((wgid % nig) % gsz); u.pn = (wgid % nig) / gsz; return true;
    }
    __device__ __forceinline__ void a_ready(const pg8::Unit&) const {}
    __device__ __forceinline__ void done(const pg8::Unit&) const {}
};
struct EpiQ {
    static constexpr bool PERM = true, AFTER_DRAIN = false, WANTS_SCRATCH = true, MUT_ACC = false;
    unsigned char* ws;
    __device__ __forceinline__ void operator()(const f32x4 (&acc)[2][2][4][2], const pg8::Unit& u, int wr, int wc, int fr, int fq, bf16x8 (&sa)[4][2], bf16x8 (&sb0)[2][2], bf16x8 (&sb1)[2][2]) const {
        bf16_t* const Q2 = (bf16_t*)(ws + WS_Q2); const float* const XSS = (const float*)(ws + WS_XSS);
        const int rbase = u.pm * 256 + wr * 64 + fr;
        const int cbase = u.pn * 256 + wc * 32 + 8 * fq;
#define EQ_SLOT(i) ((i) < 8 ? sa[(i) >> 1][(i) & 1] : ((i) < 12 ? sb0[((i) - 8) >> 1][(i) & 1] : sb1[((i) - 12) >> 1][(i) & 1]))
#pragma unroll
        for (int ai = 0; ai < 2; ++ai) {
#pragma unroll
            for (int i = 0; i < 16; ++i) EQ_SLOT(i) = *(const bf16x8*)(XSS + (size_t)(rbase + ai * 128 + (i >> 2) * 16) * 16 + (i & 3) * 4);
#pragma unroll
            for (int m = 0; m < 4; ++m) {
                const int gt = rbase + ai * 128 + m * 16;
                const f32x4 a = __builtin_bit_cast(f32x4, EQ_SLOT(4 * m)), b = __builtin_bit_cast(f32x4, EQ_SLOT(4 * m + 1)), c = __builtin_bit_cast(f32x4, EQ_SLOT(4 * m + 2)), d = __builtin_bit_cast(f32x4, EQ_SLOT(4 * m + 3));
                const float ssq = (((a.x + a.y) + (a.z + a.w)) + ((b.x + b.y) + (b.z + b.w))) + (((c.x + c.y) + (c.z + c.w)) + ((d.x + d.y) + (d.z + d.w)));
                const float rs = rsqrtf(ssq * (1.f / 1024.f) + EPS);
#pragma unroll
                for (int bj = 0; bj < 2; ++bj) {
                    const f32x4 v0 = acc[ai][bj][m][0] * rs, v1 = acc[ai][bj][m][1] * rs;
                    u32x4 w; w.x = pk2(v0.x, v0.y); w.y = pk2(v0.z, v0.w); w.z = pk2(v1.x, v1.y); w.w = pk2(v1.z, v1.w);
                    *(u32x4*)(Q2 + (size_t)((((gt >> 4) * 8 + u.pn) * 2 + bj) * 2048 + wc * 512 + fr * 32 + fq * 8)) = w;
                }
            }
            __builtin_amdgcn_sched_barrier(0);
        }
#undef EQ_SLOT
    }
};

struct P67Ptrs { const bf16_t *Q2, *KEYS, *XB; const unsigned char *PU, *PV; const float *SU, *SV; unsigned short* EID; float* GATE; const float* XSS; float* X2; const float* ln_final; float *PD; bf16_t* PW; float* SS3; unsigned* q; };

__device__ __forceinline__ void p67_tile(const Ctx& C, const P67Ptrs& P, int tile) {
    LAS unsigned char* L = C.lds;
    const int tid = C.tid, lane = C.lane, wid = C.wid, fr = lane & 15, fq = lane >> 4;
    const int gt0 = tile * 128;
    constexpr int O_SC = 0, O_MG = 0, O_FK = 16384, O_WL = 135168, O_EL = 139264;
#ifndef REP_P6
#define REP_P6 1
#endif
#ifndef REP_U
#define REP_U 1
#endif
#ifndef REP_V
#define REP_V 1
#endif
    const int sci = wid >> 2, sctq = wid & 3;
    bf16x8 qf[2][4], kfa[4], kfb[4];
#define P6_LOADQ(H) do { _Pragma("unroll") for (int tt_ = 0; tt_ < 2; ++tt_) { _Pragma("unroll") for (int ks = 0; ks < 4; ++ks) \
        qf[tt_][ks] = *(const bf16x8*)(P.Q2 + (size_t)((((tile * 8 + 2 * sctq + tt_) * 8 + (H)) * 2 + sci) * 2048 + ks * 512 + fr * 32 + fq * 8)); } } while (0)
#define P6_LOADK(DST, H, JT) do { _Pragma("unroll") for (int ks = 0; ks < 4; ++ks) DST[ks] = *(const bf16x8*)(P.KEYS + (size_t)((H) * 2 + sci) * 16384 + (((JT) * 4 + ks) * 16 + fr) * 32 + fq * 8); } while (0)
#define P6_MMA(KF, JT) do { _Pragma("unroll") for (int tt_ = 0; tt_ < 2; ++tt_) { f32x4 a_ = {0.f, 0.f, 0.f, 0.f}; \
        _Pragma("unroll") for (int ks = 0; ks < 4; ++ks) a_ = mfma16(KF[ks], qf[tt_][ks], a_); \
        *(LAS f32x4*)(L + O_SC + ((sci * 128 + 32 * sctq + 16 * tt_ + fr) * 132 + 16 * (JT) + 4 * fq) * 4) = a_; } } while (0)
    u32x4 pe[2] = {{0u, 0u, 0u, 0u}, {0u, 0u, 0u, 0u}}; f32x4 pg[4] = {{0.f, 0.f, 0.f, 0.f}, {0.f, 0.f, 0.f, 0.f}, {0.f, 0.f, 0.f, 0.f}, {0.f, 0.f, 0.f, 0.f}};
#define P6_STORE_RES(H) do { unsigned short* ep_ = P.EID + (size_t)(gt0 + tid) * 128 + (H) * 16; float* gp_ = P.GATE + (size_t)(gt0 + tid) * 128 + (H) * 16; \
        *(u32x4*)ep_ = pe[0]; *(u32x4*)(ep_ + 8) = pe[1]; *(f32x4*)gp_ = pg[0]; *(f32x4*)(gp_ + 4) = pg[1]; *(f32x4*)(gp_ + 8) = pg[2]; *(f32x4*)(gp_ + 12) = pg[3]; } while (0)
    P6_LOADQ(0); P6_LOADK(kfa, 0, 0);
    for (int h6 = 0; h6 < 8 * REP_P6; ++h6) {
        const int h = h6 & 7;
        {
#pragma unroll
            for (int jt = 0; jt < 8; jt += 2) {
                P6_LOADK(kfb, h, jt + 1);
                P6_MMA(kfa, jt);
                __builtin_amdgcn_sched_barrier(0);
                if (jt + 2 < 8) P6_LOADK(kfa, h, jt + 2);
                P6_MMA(kfb, jt + 1);
                __builtin_amdgcn_sched_barrier(0);
            }
            if (tid < 128 && h6 > 0) P6_STORE_RES((h6 - 1) & 7);
            const int hn = (h6 + 1) & 7;
            if (h6 + 1 < 8 * REP_P6) { P6_LOADQ(hn); P6_LOADK(kfa, hn, 0); }
        }
        __syncthreads();
        const int tt = tid & 127, ii = (tid >> 7) & 1, hf = tid >> 8;
        unsigned list[16];
        {
            const LAS unsigned char* row = L + O_SC + ((ii * 128 + tt) * 132 + hf * 64) * 4;
#pragma unroll
            for (int e4 = 0; e4 < 4; ++e4) {
                const f32x4 v = *(const LAS f32x4*)(row + e4 * 16);
#pragma unroll
                for (int q = 0; q < 4; ++q) list[e4 * 4 + q] = (ord_key(v[q]) & ~127u) | (unsigned)(127 - (hf * 64 + e4 * 4 + q));
            }
            sort16(list);
#pragma unroll 1
            for (int gq = 1; gq < 4; ++gq) {
                unsigned grp[16];
#pragma unroll
                for (int e4 = 0; e4 < 4; ++e4) {
                    const f32x4 v = *(const LAS f32x4*)(row + (gq * 4 + e4) * 16);
#pragma unroll
                    for (int q = 0; q < 4; ++q) grp[e4 * 4 + q] = (ord_key(v[q]) & ~127u) | (unsigned)(127 - (hf * 64 + gq * 16 + e4 * 4 + q));
                }
                sort16(grp);
                merge16(list, grp);
            }
        }
        __syncthreads();
        if (hf == 1) {
#pragma unroll
            for (int j = 0; j < 16; ++j) *(LAS unsigned*)(L + O_MG + (j * 256 + (tid & 255)) * 4) = list[j];
        }
        __syncthreads();
        if (hf == 0) {
            unsigned other[16];
#pragma unroll
            for (int j = 0; j < 16; ++j) other[j] = *(const LAS unsigned*)(L + O_MG + (j * 256 + tid) * 4);
            merge16(list, other);
#pragma unroll
            for (int j = 0; j < 16; ++j) *(LAS unsigned*)(L + O_FK + ((ii * 16 + j) * 128 + tt) * 4) = list[j];
        }
        __syncthreads();
        unsigned cl[16];
        if (tid < 256) {
            const int tk = tid & 127, role = tid >> 7;
            float v1[16], v2[16];
#pragma unroll
            for (int a = 0; a < 16; ++a) { v1[a] = unord_key(*(const LAS unsigned*)(L + O_FK + ((0 * 16 + a) * 128 + tk) * 4) & ~127u); v2[a] = unord_key(*(const LAS unsigned*)(L + O_FK + ((1 * 16 + a) * 128 + tk) * 4) & ~127u); }
#define P6_KEY(a, b) ((ord_key(v1[a] + v2[b]) & ~255u) | (unsigned)(255 - ((a) * 16 + (b))))
            if (role == 0) {
                unsigned lb[16];
#pragma unroll
                for (int b = 0; b < 16; ++b) cl[b] = P6_KEY(0, b);
#pragma unroll
                for (int b = 0; b < 8; ++b) lb[b] = P6_KEY(1, b);
#pragma unroll
                for (int b = 0; b < 5; ++b) lb[8 + b] = P6_KEY(2, b);
#pragma unroll
                for (int b = 0; b < 3; ++b) lb[13 + b] = P6_KEY(3, b);
                sort16(lb);
                merge16(cl, lb);
                ins16(cl, P6_KEY(3, 3));
            } else {
                cl[0] = P6_KEY(4, 0); cl[1] = P6_KEY(4, 1); cl[2] = P6_KEY(4, 2); cl[3] = P6_KEY(5, 0); cl[4] = P6_KEY(5, 1); cl[5] = P6_KEY(6, 0); cl[6] = P6_KEY(6, 1); cl[7] = P6_KEY(7, 0);
                cl[8] = P6_KEY(7, 1); cl[9] = P6_KEY(8, 0); cl[10] = P6_KEY(9, 0); cl[11] = P6_KEY(10, 0); cl[12] = P6_KEY(11, 0); cl[13] = P6_KEY(12, 0); cl[14] = P6_KEY(13, 0); cl[15] = P6_KEY(14, 0);
                sort16(cl);
                ins16(cl, P6_KEY(15, 0));
#pragma unroll
                for (int j = 0; j < 16; ++j) *(LAS unsigned*)(L + O_MG + (j * 128 + tk) * 4) = cl[j];
            }
        }
        __syncthreads();
        if (tid < 128) {
            unsigned other[16];
#pragma unroll
            for (int j = 0; j < 16; ++j) other[j] = *(const LAS unsigned*)(L + O_MG + (j * 128 + tid) * 4);
            merge16(cl, other);
            float val[16]; int eid[16]; float mx = -3.0e38f;
#pragma unroll
            for (int j = 0; j < 16; ++j) {
                const int pos = 255 - (int)(cl[j] & 255u), a = pos >> 4, b = pos & 15;
                const unsigned ka = *(const LAS unsigned*)(L + O_FK + ((0 * 16 + a) * 128 + tid) * 4), kb = *(const LAS unsigned*)(L + O_FK + ((1 * 16 + b) * 128 + tid) * 4);
                val[j] = unord_key(ka & ~127u) + unord_key(kb & ~127u);
                eid[j] = (127 - (int)(ka & 127u)) * 128 + (127 - (int)(kb & 127u));
                mx = fmaxf(mx, val[j]);
            }
            float sum = 0.f;
#pragma unroll
            for (int j = 0; j < 16; ++j) { val[j] = __expf(val[j] - mx); sum += val[j]; }
            const float inv = 1.f / sum;
#pragma unroll
            for (int j = 0; j < 16; j += 8) pe[j >> 3] = (u32x4){(unsigned)eid[j] | ((unsigned)eid[j + 1] << 16), (unsigned)eid[j + 2] | ((unsigned)eid[j + 3] << 16), (unsigned)eid[j + 4] | ((unsigned)eid[j + 5] << 16), (unsigned)eid[j + 6] | ((unsigned)eid[j + 7] << 16)};
#pragma unroll
            for (int j = 0; j < 16; j += 4) pg[j >> 2] = (f32x4){val[j] * inv, val[j + 1] * inv, val[j + 2] * inv, val[j + 3] * inv};
        }
        __syncthreads();
    }
    if (tid < 128) P6_STORE_RES(7);
#undef P6_STORE_RES
}

#undef P6_LOADK
#undef P6_LOADQ
#undef P6_MMA
template <class F>
__device__ __forceinline__ void sliced_items(const Ctx& C, unsigned* q8, F&& item) {
    LAS int* slot = (LAS int*)(C.lds + LDS_BYTES - 16);
    const int x0 = (int)(xb_xcc_id() & 7u);
    for (int k = 0; k < 8; ++k) {
        const int x = (x0 + k) & 7;
        for (;;) {
            __syncthreads();
            if (C.tid == 0) *slot = (int)atomicAdd(q8 + x * 16, 1u);
            __syncthreads();
            const int it = *slot;
            if (it >= 128) break;
            item(x, it);
        }
    }
}
__device__ __forceinline__ void peer_u_item(const Ctx& C, const P67Ptrs& P, int x, int tile) {
    LAS unsigned char* L = C.lds;
    const int tid = C.tid, lane = C.lane, wid = C.wid, g8 = lane >> 3, s8 = lane & 7;
    const int gt0 = tile * 256;
    {
        const u32x4* src = (const u32x4*)(P.EID + (size_t)gt0 * 128);
#pragma unroll
        for (int i = 0; i < 8; ++i) *(LAS u32x4*)(L + (size_t)(tid + i * NTHR) * 16) = src[tid + i * NTHR];
    }
    __syncthreads();
    const int c0 = 128 * x + 16 * s8;
    for (int batch = 0; batch < 4; ++batch) {
        const int t = 32 * wid + 8 * batch + g8, gt = gt0 + t;
        f2v xf[8];
        { const bf16_t* x2h = (const bf16_t*)P.X2; const u32x4 a = *(const u32x4*)(x2h + (size_t)gt * 1024 + c0), b = *(const u32x4*)(x2h + (size_t)gt * 1024 + c0 + 8);
          xf[0] = (f2v){bf_lo(a.x), bf_hi(a.x)}; xf[1] = (f2v){bf_lo(a.y), bf_hi(a.y)}; xf[2] = (f2v){bf_lo(a.z), bf_hi(a.z)}; xf[3] = (f2v){bf_lo(a.w), bf_hi(a.w)};
          xf[4] = (f2v){bf_lo(b.x), bf_hi(b.x)}; xf[5] = (f2v){bf_lo(b.y), bf_hi(b.y)}; xf[6] = (f2v){bf_lo(b.z), bf_hi(b.z)}; xf[7] = (f2v){bf_lo(b.w), bf_hi(b.w)}; }
        unsigned* pd = (unsigned*)P.PD + ((size_t)x * T_ALL + gt) * 64 + s8;
        float plo = 0.f;
#pragma unroll 2
        for (int p8 = 0; p8 < 16; ++p8) {
            const u32x4 ew = *(const LAS u32x4*)(L + (t * 128 + 8 * p8) * 2);
            const unsigned e[8] = {ew.x & 0xffffu, ew.x >> 16, ew.y & 0xffffu, ew.y >> 16, ew.z & 0xffffu, ew.z >> 16, ew.w & 0xffffu, ew.w >> 16};
            u32x4 q[8];
#pragma unroll
            for (int k = 0; k < 8; ++k) q[k] = *(const u32x4*)(P.PU + (size_t)x * (16384 * 128) + (size_t)e[k] * 128 + 16 * s8);
            float d[8];
#pragma unroll
            for (int k = 0; k < 8; ++k) { f2v a2 = {0.f, 0.f};
#pragma unroll
                for (int j = 0; j < 4; ++j) { a2 = __builtin_amdgcn_cvt_pk_f32_fp8((int)q[k][j], false) * xf[2 * j] + a2; a2 = __builtin_amdgcn_cvt_pk_f32_fp8((int)q[k][j], true) * xf[2 * j + 1] + a2; }
                d[k] = a2.x + a2.y; }
            float r4[4], r2[2];
#pragma unroll
            for (int i = 0; i < 4; ++i) { const float keep = (s8 & 4) ? d[i + 4] : d[i], send = (s8 & 4) ? d[i] : d[i + 4]; r4[i] = keep + __shfl_xor(send, 4); }
#pragma unroll
            for (int i = 0; i < 2; ++i) { const float keep = (s8 & 2) ? r4[i + 2] : r4[i], send = (s8 & 2) ? r4[i] : r4[i + 2]; r2[i] = keep + __shfl_xor(send, 2); }
            { const float keep = (s8 & 1) ? r2[1] : r2[0], send = (s8 & 1) ? r2[0] : r2[1]; const float tot = keep + __shfl_xor(send, 1);
              if (p8 & 1) pd[8 * (p8 >> 1)] = pk2(plo, tot); else plo = tot; }
        }
    }
}
__device__ __forceinline__ void peer_w_phase(const Ctx& C, const P67Ptrs& P) {
    const int gw = C.bid * 8 + C.wid, NGW = C.G * 8, lane = C.lane;
    const int p0 = 16 * (lane >> 3) + (lane & 7), p1 = p0 + 8;
    const unsigned* PDw = (const unsigned*)P.PD;
    for (int g0 = gw; g0 < T_ALL; g0 += 4 * NGW) {
        f32x4 xs[4][4]; unsigned w[4][8]; int e0[4], e1[4]; float ga0[4], ga1[4];
#pragma unroll
        for (int u = 0; u < 4; ++u) {
            const int gt = (g0 + u * NGW < T_ALL) ? g0 + u * NGW : g0;
            const float* xp = P.XSS + (size_t)gt * 16;
            xs[u][0] = *(const f32x4*)xp; xs[u][1] = *(const f32x4*)(xp + 4); xs[u][2] = *(const f32x4*)(xp + 8); xs[u][3] = *(const f32x4*)(xp + 12);
#pragma unroll
            for (int x = 0; x < 8; ++x) w[u][x] = PDw[((size_t)x * T_ALL + gt) * 64 + lane];
            e0[u] = P.EID[(size_t)gt * 128 + p0]; e1[u] = P.EID[(size_t)gt * 128 + p1];
            ga0[u] = P.GATE[(size_t)gt * 128 + p0]; ga1[u] = P.GATE[(size_t)gt * 128 + p1];
        }
        float sv0[4], sv1[4], su0[4], su1[4];
#pragma unroll
        for (int u = 0; u < 4; ++u) { sv0[u] = P.SV[e0[u]]; sv1[u] = P.SV[e1[u]]; su0[u] = P.SU[e0[u]]; su1[u] = P.SU[e1[u]]; }
#pragma unroll
        for (int u = 0; u < 4; ++u) {
            if (g0 + u * NGW < T_ALL) {
                const int gt = g0 + u * NGW;
                const f32x4 a = xs[u][0], b = xs[u][1], c = xs[u][2], d = xs[u][3];
                const float ssq = (((a.x + a.y) + (a.z + a.w)) + ((b.x + b.y) + (b.z + b.w))) + (((c.x + c.y) + (c.z + c.w)) + ((d.x + d.y) + (d.z + d.w)));
                const float rstd = rsqrtf(ssq * (1.f / 1024.f) + EPS);
                float s0 = 0.f, s1 = 0.f;
#pragma unroll
                for (int x = 0; x < 8; ++x) { s0 += bf_lo(w[u][x]); s1 += bf_hi(w[u][x]); }
                const size_t i0 = (size_t)gt * 128 + p0, i1 = (size_t)gt * 128 + p1;
                P.PW[i0] = (bf16_t)(pk2(ga0[u] * sv0[u] * gelu_f(s0 * su0[u] * rstd), 0.f) & 0xffffu);
                P.PW[i1] = (bf16_t)(pk2(ga1[u] * sv1[u] * gelu_f(s1 * su1[u] * rstd), 0.f) & 0xffffu);
            }
        }
    }
}
__device__ __forceinline__ void peer_v_item(const Ctx& C, const P67Ptrs& P, int x, int tile) {
    LAS unsigned char* L = C.lds;
    const int tid = C.tid, lane = C.lane, wid = C.wid, g8 = lane >> 3, s8 = lane & 7;
    const int gt0 = tile * 256;
    {
        const u32x4* se = (const u32x4*)(P.EID + (size_t)gt0 * 128); const u32x4* sw = (const u32x4*)(P.PW + (size_t)gt0 * 128);
#pragma unroll
        for (int i = 0; i < 8; ++i) { *(LAS u32x4*)(L + (size_t)(tid + i * NTHR) * 16) = se[tid + i * NTHR]; *(LAS u32x4*)(L + 65536 + (size_t)(tid + i * NTHR) * 16) = sw[tid + i * NTHR]; }
    }
    __syncthreads();
    const int c0 = 128 * x + 16 * s8;
    for (int batch = 0; batch < 4; ++batch) {
        const int t = 32 * wid + 8 * batch + g8, gt = gt0 + t;
        f2v acc[8];
#pragma unroll
        for (int j = 0; j < 8; ++j) acc[j] = (f2v){0.f, 0.f};
#pragma unroll 2
        for (int p8 = 0; p8 < 16; ++p8) {
            const u32x4 ew = *(const LAS u32x4*)(L + (t * 128 + 8 * p8) * 2), ww = *(const LAS u32x4*)(L + 65536 + (t * 128 + 8 * p8) * 2);
            const unsigned e[8] = {ew.x & 0xffffu, ew.x >> 16, ew.y & 0xffffu, ew.y >> 16, ew.z & 0xffffu, ew.z >> 16, ew.w & 0xffffu, ew.w >> 16};
            const float w[8] = {bf_lo(ww.x), bf_hi(ww.x), bf_lo(ww.y), bf_hi(ww.y), bf_lo(ww.z), bf_hi(ww.z), bf_lo(ww.w), bf_hi(ww.w)};
            u32x4 q[8];
#pragma unroll
            for (int k = 0; k < 8; ++k) q[k] = *(const u32x4*)(P.PV + (size_t)x * (16384 * 128) + (size_t)e[k] * 128 + 16 * s8);
#pragma unroll
            for (int k = 0; k < 8; ++k) { const f2v w2 = {w[k], w[k]};
#pragma unroll
                for (int j = 0; j < 4; ++j) { acc[2 * j] = __builtin_amdgcn_cvt_pk_f32_fp8((int)q[k][j], false) * w2 + acc[2 * j]; acc[2 * j + 1] = __builtin_amdgcn_cvt_pk_f32_fp8((int)q[k][j], true) * w2 + acc[2 * j + 1]; } }
        }
        const bf16_t* xi = (const bf16_t*)P.X2 + (size_t)gt * 1024 + c0; bf16_t* so = (bf16_t*)P.XB + (size_t)gt * 1024 + c0; float ss = 0.f;
        const u32x4 xa = *(const u32x4*)xi, xb = *(const u32x4*)(xi + 8);
        const unsigned xw[8] = {xa.x, xa.y, xa.z, xa.w, xb.x, xb.y, xb.z, xb.w};
        unsigned ow[8];
#pragma unroll
        for (int i = 0; i < 8; ++i) { const float s0 = bf_lo(xw[i]) + acc[i].x, s1 = bf_hi(xw[i]) + acc[i].y; ss += s0 * s0 + s1 * s1; ow[i] = pk2(s0, s1); }
        *(u32x4*)so = (u32x4){ow[0], ow[1], ow[2], ow[3]}; *(u32x4*)(so + 8) = (u32x4){ow[4], ow[5], ow[6], ow[7]};
        ss += __shfl_xor(ss, 1); ss += __shfl_xor(ss, 2); ss += __shfl_xor(ss, 4);
        if (s8 == 0) P.SS3[(size_t)gt * 8 + x] = ss;
    }
}
__device__ __forceinline__ void peer_final_phase(const Ctx& C, const P67Ptrs& P) {
    const int gw = C.bid * 8 + C.wid, NGW = C.G * 8, lane = C.lane;
    const f32x4* gr = (const f32x4*)P.ln_final;
    for (int g0 = gw; g0 < T_ALL; g0 += 2 * NGW) {
        const int gtA = g0, gtB = (g0 + NGW < T_ALL) ? g0 + NGW : g0;
        const f32x4 saA = *(const f32x4*)(P.SS3 + (size_t)gtA * 8), sbA = *(const f32x4*)(P.SS3 + (size_t)gtA * 8 + 4), saB = *(const f32x4*)(P.SS3 + (size_t)gtB * 8), sbB = *(const f32x4*)(P.SS3 + (size_t)gtB * 8 + 4);
        const bf16_t* srcA = P.XB + (size_t)gtA * 1024 + lane * 4; const bf16_t* srcB = P.XB + (size_t)gtB * 1024 + lane * 4;
        f32x4* rowA = (f32x4*)(P.X2 + (size_t)gtA * 1024); f32x4* rowB = (f32x4*)(P.X2 + (size_t)gtB * 1024);
        u32x2 vA[4], vB[4];
#pragma unroll
        for (int j = 0; j < 4; ++j) { vA[j] = *(const u32x2*)(srcA + 256 * j); vB[j] = *(const u32x2*)(srcB + 256 * j); }
        const float rA = rsqrtf((((saA.x + saA.y) + (saA.z + saA.w)) + ((sbA.x + sbA.y) + (sbA.z + sbA.w))) * (1.f / 1024.f) + EPS);
        const float rB = rsqrtf((((saB.x + saB.y) + (saB.z + saB.w)) + ((sbB.x + sbB.y) + (sbB.z + sbB.w))) * (1.f / 1024.f) + EPS);
#pragma unroll
        for (int j = 0; j < 4; ++j) { const f32x4 g = gr[lane + 64 * j]; rowA[lane + 64 * j] = (f32x4){bf_lo(vA[j].x) * rA * g.x, bf_hi(vA[j].x) * rA * g.y, bf_lo(vA[j].y) * rA * g.z, bf_hi(vA[j].y) * rA * g.w}; }
        if (g0 + NGW < T_ALL) {
#pragma unroll
            for (int j = 0; j < 4; ++j) { const f32x4 g = gr[lane + 64 * j]; rowB[lane + 64 * j] = (f32x4){bf_lo(vB[j].x) * rB * g.x, bf_hi(vB[j].x) * rB * g.y, bf_lo(vB[j].y) * rB * g.z, bf_hi(vB[j].y) * rB * g.w}; }
        }
    }
}

#ifndef MK_MULTI
#define MK_MULTI 0
#endif
constexpr int NSEG = 18;

__global__ void __launch_bounds__(NTHR, 2) fwd_megakernel(Params prm) {
    extern __shared__ __attribute__((aligned(16))) unsigned char lds_raw[];
    LAS unsigned char* const lds = (LAS unsigned char*)lds_raw;
    const int wv = __builtin_amdgcn_readfirstlane((int)(threadIdx.x >> 6));
    const int lo = prm.seg_lo, hi = prm.seg_hi;
#if MK_MULTI
#define GSYNC(k) do {} while (0)
#else
    cg::grid_group grid = cg::this_grid();
    volatile LAS unsigned* xb_st = (volatile LAS unsigned*)(lds + LDS_BYTES - 32);
    if (threadIdx.x == 0) { xb_st[0] = 0u; xb_st[1] = 0u; }
    __syncthreads();
    (void)xcd_barrier_post((unsigned)wv, (unsigned*)(prm.ws + WS_BAR), xb_st);
#define XBAR_NOW() XcdBarrier{(unsigned)wv, (unsigned*)(ka_ws(kargs()) + WS_BAR), xb_xcc_id(), (volatile LAS unsigned*)((LAS unsigned char*)lds_raw + LDS_BYTES - 32)}
#define GSYNC(k) do { if (lo <= (k) && (k) + 1 < hi) { const XcdBarrier xb_ = XBAR_NOW(); xcd_barrier(xb_); } } while (0)
    if (lo < -1000) { asm volatile("s_waitcnt vmcnt(0)" ::: "memory"); __builtin_amdgcn_fence(__ATOMIC_RELEASE, FSCOPE); grid.sync(); __builtin_amdgcn_fence(__ATOMIC_ACQUIRE, FSCOPE); }
#endif
#ifndef SEGMASK
#define SEGMASK 0x3ffff
#endif
#ifndef REP_G1
#define REP_G1 1
#endif
#ifndef STAG1
#define STAG1 0
#endif
#ifndef REP_G3
#define REP_G3 1
#endif
#ifndef REP_NOOP
#define REP_NOOP 0
#endif
#ifndef REP_G4
#define REP_G4 1
#endif
#ifndef REP_G5
#define REP_G5 1
#endif
#ifndef REP_P0
#define REP_P0 1
#endif
#define SEG(k) if (((SEGMASK >> (k)) & 1) && lo <= (k) && (k) < hi)

    SEG(0) { const Ctx C = fresh_ctx(lds, wv); for (int rep = 0; rep < REP_P0; ++rep) { p0_prep(C); __syncthreads(); } }
    GSYNC(0);
#define MAKE_P2PTRS() const Ctx C = fresh_ctx(lds, wv); const kaptr_t ka = kargs(); unsigned char* ws = ka_ws(ka); unsigned char* sl = ws + WS_SLAB; \
                P2Ptrs P{(bf16_t*)(sl + SL_YB), (bf16_t*)(sl + SL_XBC), (bf16_t*)(ka_out(ka) + (size_t)TS * 1024), (bf16_t*)(ws + WS_KB), (bf16_t*)(ws + WS_VT), (bf16_t*)(ws + WS_WSP), \
                         (float*)(ws + WS_DT), (float*)(ws + WS_VSS), (float*)(ws + WS_SSS), \
                         (bf16_t*)(ws + WS_H) + (size_t)slab * TS * 1024, (bf16_t*)(ka_out(ka) + (size_t)TS * 1024) + (size_t)TS * 1024, (float*)(ws + WS_CTL + 8192), \
                         ka_in(ka, I_CONV_W), ka_in(ka, I_CONV_B), ka_in(ka, I_A_LOG), ka_in(ka, I_D_SKIP), ka_in(ka, I_SSD_NORM), ka_in(ka, I_GMLP_NORM), ka_in(ka, I_B_SPATIAL), slab * TS, slab}
    {
        constexpr int slab = 0;
        const int sb = 1 + 5 * slab;
        SEG(sb) {
            if (slab > 0) {
                const Ctx C = fresh_ctx(lds, wv); const kaptr_t ka = kargs(); unsigned char* ws = ka_ws(ka);
                const int ps = slab - 1;
                pg8::Gemm g{(bf16_t*)(ws + WS_H) + (size_t)ps * TS * 1024, (bf16_t*)(ws + WS_WO), 0, 0, 1024};
                SchedTile256 S{C.G, C.bid};
                EpiOut E{ka_in(ka, I_X), ka_out(ka), ws, ka_in(ka, I_LN_FFN), ps * TS};
                for (int rep = 0; rep < REP_G4; ++rep) pg8::gemm_phase<EpiOut, SchedTile256>(C.lds, g, S, E, nullptr, wv);
            }
            if (slab < 2) {
                const Ctx C = fresh_ctx(lds, wv); const kaptr_t ka = kargs(); unsigned char* ws = ka_ws(ka);
                pg8::Gemm g{(bf16_t*)(ws + WS_H), (bf16_t*)(ws + WS_WINKV), 0, 0, 1024};
                SchedInProj S{slab, C.G, C.bid};
                EpiInProj E{ws, (bf16_t*)(ka_out(ka) + (size_t)TS * 1024), ka_in(ka, I_DT_BIAS), slab * TS};
                for (int sl_ = 0; sl_ < STAG1 * ((C.bid >> 5) & 1); ++sl_) __builtin_amdgcn_s_sleep(127);
                for (int rep = 0; rep < REP_G1; ++rep) pg8::gemm_phase<EpiInProj, SchedInProj>(C.lds, g, S, E, nullptr, wv);
            }
        }
        GSYNC(sb);
        if (slab < 2) {
            SEG(sb + 1) { MAKE_P2PTRS(); p2_mixers(C, P, (unsigned*)(ws + WS_CTL) + slab); }
            GSYNC(sb + 1);
            SEG(sb + 2) { MAKE_P2PTRS(); p2_scan(C, P); }
            GSYNC(sb + 2);
            SEG(sb + 3) { MAKE_P2PTRS(); p2_pass_c(C, P); }
            GSYNC(sb + 3);
            SEG(sb + 4) {
                const Ctx C = fresh_ctx(lds, wv); const kaptr_t ka = kargs(); unsigned char* ws = ka_ws(ka); unsigned char* sl = ws + WS_SLAB;
                pg8::Gemm g{(bf16_t*)(sl + SL_YB), (bf16_t*)(ws + WS_WB), 0, 0, 1024};
                SchedBranch S{C.G, C.bid};
                EpiBranch E{ws, slab * TS, 0};
#ifndef STAG3
#define STAG3 0
#endif
                for (int sl_ = 0; sl_ < STAG3 * ((C.bid >> 3) & 3); ++sl_) __builtin_amdgcn_s_sleep(127);
                for (int rep = 0; rep < REP_G3; ++rep) { E.noop = (rep > 0) ? REP_NOOP : 0; pg8::gemm_phase<EpiBranch, SchedBranch>(C.lds, g, S, E, nullptr, wv); }
            }
            GSYNC(sb + 4);
        }
    }
    {
        constexpr int slab = 1;
        const int sb = 1 + 5 * slab;
        SEG(sb) {
            if (slab > 0) {
                const Ctx C = fresh_ctx(lds, wv); const kaptr_t ka = kargs(); unsigned char* ws = ka_ws(ka);
                const int ps = slab - 1;
                pg8::Gemm g{(bf16_t*)(ws + WS_H) + (size_t)ps * TS * 1024, (bf16_t*)(ws + WS_WO), 0, 0, 1024};
                SchedTile256 S{C.G, C.bid};
                EpiOut E{ka_in(ka, I_X), ka_out(ka), ws, ka_in(ka, I_LN_FFN), ps * TS};
                for (int rep = 0; rep < REP_G4; ++rep) pg8::gemm_phase<EpiOut, SchedTile256>(C.lds, g, S, E, nullptr, wv);
            }
            if (slab < 2) {
                const Ctx C = fresh_ctx(lds, wv); const kaptr_t ka = kargs(); unsigned char* ws = ka_ws(ka);
                pg8::Gemm g{(bf16_t*)(ws + WS_H), (bf16_t*)(ws + WS_WINKV), 0, 0, 1024};
                SchedInProj S{slab, C.G, C.bid};
                EpiInProj E{ws, (bf16_t*)(ka_out(ka) + (size_t)TS * 1024), ka_in(ka, I_DT_BIAS), slab * TS};
                for (int sl_ = 0; sl_ < STAG1 * ((C.bid >> 5) & 1); ++sl_) __builtin_amdgcn_s_sleep(127);
                for (int rep = 0; rep < REP_G1; ++rep) pg8::gemm_phase<EpiInProj, SchedInProj>(C.lds, g, S, E, nullptr, wv);
            }
        }
        GSYNC(sb);
        if (slab < 2) {
            SEG(sb + 1) { MAKE_P2PTRS(); p2_mixers(C, P, (unsigned*)(ws + WS_CTL) + slab); }
            GSYNC(sb + 1);
            SEG(sb + 2) { MAKE_P2PTRS(); p2_scan(C, P); }
            GSYNC(sb + 2);
            SEG(sb + 3) { MAKE_P2PTRS(); p2_pass_c(C, P); }
            GSYNC(sb + 3);
            SEG(sb + 4) {
                const Ctx C = fresh_ctx(lds, wv); const kaptr_t ka = kargs(); unsigned char* ws = ka_ws(ka); unsigned char* sl = ws + WS_SLAB;
                pg8::Gemm g{(bf16_t*)(sl + SL_YB), (bf16_t*)(ws + WS_WB), 0, 0, 1024};
                SchedBranch S{C.G, C.bid};
                EpiBranch E{ws, slab * TS, 0};
#ifndef STAG3
#define STAG3 0
#endif
                for (int sl_ = 0; sl_ < STAG3 * ((C.bid >> 3) & 3); ++sl_) __builtin_amdgcn_s_sleep(127);
                for (int rep = 0; rep < REP_G3; ++rep) { E.noop = (rep > 0) ? REP_NOOP : 0; pg8::gemm_phase<EpiBranch, SchedBranch>(C.lds, g, S, E, nullptr, wv); }
            }
            GSYNC(sb + 4);
        }
    }
    {
        constexpr int slab = 2;
        const int sb = 1 + 5 * slab;
        SEG(sb) {
            if (slab > 0) {
                const Ctx C = fresh_ctx(lds, wv); const kaptr_t ka = kargs(); unsigned char* ws = ka_ws(ka);
                const int ps = slab - 1;
                pg8::Gemm g{(bf16_t*)(ws + WS_H) + (size_t)ps * TS * 1024, (bf16_t*)(ws + WS_WO), 0, 0, 1024};
                SchedTile256 S{C.G, C.bid};
                EpiOut E{ka_in(ka, I_X), ka_out(ka), ws, ka_in(ka, I_LN_FFN), ps * TS};
                for (int rep = 0; rep < REP_G4; ++rep) pg8::gemm_phase<EpiOut, SchedTile256>(C.lds, g, S, E, nullptr, wv);
            }
            if (slab < 2) {
                const Ctx C = fresh_ctx(lds, wv); const kaptr_t ka = kargs(); unsigned char* ws = ka_ws(ka);
                pg8::Gemm g{(bf16_t*)(ws + WS_H), (bf16_t*)(ws + WS_WINKV), 0, 0, 1024};
                SchedInProj S{slab, C.G, C.bid};
                EpiInProj E{ws, (bf16_t*)(ka_out(ka) + (size_t)TS * 1024), ka_in(ka, I_DT_BIAS), slab * TS};
                for (int sl_ = 0; sl_ < STAG1 * ((C.bid >> 5) & 1); ++sl_) __builtin_amdgcn_s_sleep(127);
                for (int rep = 0; rep < REP_G1; ++rep) pg8::gemm_phase<EpiInProj, SchedInProj>(C.lds, g, S, E, nullptr, wv);
            }
        }
        GSYNC(sb);
        if (slab < 2) {
            SEG(sb + 1) { MAKE_P2PTRS(); p2_mixers(C, P, (unsigned*)(ws + WS_CTL) + slab); }
            GSYNC(sb + 1);
            SEG(sb + 2) { MAKE_P2PTRS(); p2_scan(C, P); }
            GSYNC(sb + 2);
            SEG(sb + 3) { MAKE_P2PTRS(); p2_pass_c(C, P); }
            GSYNC(sb + 3);
            SEG(sb + 4) {
                const Ctx C = fresh_ctx(lds, wv); const kaptr_t ka = kargs(); unsigned char* ws = ka_ws(ka); unsigned char* sl = ws + WS_SLAB;
                pg8::Gemm g{(bf16_t*)(sl + SL_YB), (bf16_t*)(ws + WS_WB), 0, 0, 1024};
                SchedBranch S{C.G, C.bid};
                EpiBranch E{ws, slab * TS, 0};
#ifndef STAG3
#define STAG3 0
#endif
                for (int sl_ = 0; sl_ < STAG3 * ((C.bid >> 3) & 3); ++sl_) __builtin_amdgcn_s_sleep(127);
                for (int rep = 0; rep < REP_G3; ++rep) { E.noop = (rep > 0) ? REP_NOOP : 0; pg8::gemm_phase<EpiBranch, SchedBranch>(C.lds, g, S, E, nullptr, wv); }
            }
            GSYNC(sb + 4);
        }
    }
    SEG(12) {
        const Ctx C = fresh_ctx(lds, wv); const kaptr_t ka = kargs(); unsigned char* ws = ka_ws(ka);
        pg8::Gemm g{(bf16_t*)ka_out(ka), (bf16_t*)(ws + WS_WQ), 0, 0, 1024};
        SchedStatic S{128, 8, 1024, C.G, C.bid};
        EpiQ E{ws};
        for (int rep = 0; rep < REP_G5; ++rep) pg8::gemm_phase<EpiQ, SchedStatic>(C.lds, g, S, E, nullptr, wv);
    }
    GSYNC(12);
#define MAKE_P67() const Ctx C = fresh_ctx(lds, wv); const kaptr_t ka = kargs(); unsigned char* ws = ka_ws(ka); \
        P67Ptrs P{(bf16_t*)(ws + WS_Q2), (bf16_t*)(ws + WS_KEYS), (bf16_t*)(ws + WS_XB), ws + WS_PU, ws + WS_PV, (float*)(ws + WS_SU), (float*)(ws + WS_SV), \
                  (unsigned short*)(ws + WS_EID), (float*)(ws + WS_GATE), (float*)(ws + WS_XSS), ka_out(ka), ka_in(ka, I_LN_FINAL), (float*)(ws + WS_PD), (bf16_t*)(ws + WS_PW), (float*)(ws + WS_SS3), (unsigned*)(ws + WS_CTL)}
    SEG(13) { MAKE_P67(); for (int tile = C.bid; tile < 256; tile += C.G) { p67_tile(C, P, tile); __syncthreads(); } }
    GSYNC(13);
    SEG(14) { MAKE_P67(); sliced_items(C, P.q + 128, [&](int x, int it) { peer_u_item(C, P, x, it); }); }
    GSYNC(14);
    SEG(15) { MAKE_P67(); peer_w_phase(C, P); }
    GSYNC(15);
    SEG(16) { MAKE_P67(); sliced_items(C, P.q + 256, [&](int x, int it) { peer_v_item(C, P, x, it); }); }
    GSYNC(16);
    SEG(17) { MAKE_P67(); peer_final_phase(C, P); }
#ifdef DBG_STOP
    {
        asm volatile("s_waitcnt vmcnt(0)" ::: "memory"); __builtin_amdgcn_fence(__ATOMIC_RELEASE, FSCOPE); asm volatile("s_waitcnt vmcnt(0)" ::: "memory");
        grid.sync(); __builtin_amdgcn_fence(__ATOMIC_ACQUIRE, FSCOPE); asm volatile("s_waitcnt vmcnt(0)" ::: "memory");
        const kaptr_t ka = kargs(); unsigned char* ws = ka_ws(ka); float* out = ka_out(ka); unsigned char* sl = ws + WS_SLAB;
        const size_t n = (size_t)TS * 1024;
        const bf16_t* YB = (const bf16_t*)(sl + SL_YB); const bf16_t* XBC = (const bf16_t*)(sl + SL_XBC); const bf16_t* SG = (const bf16_t*)(sl + SL_SG);
        const bf16_t* KB = (const bf16_t*)(ws + WS_KB); const bf16_t* VT = (const bf16_t*)(ws + WS_VT); const bf16_t* MB = (const bf16_t*)(ws + WS_H); const bf16_t* XB = (const bf16_t*)(ws + WS_XB);
        const float* DT = (const float*)(ws + WS_DT); const float* VSS = (const float*)(ws + WS_VSS); const float* SSS = (const float*)(ws + WS_SSS); const float* XSS = (const float*)(ws + WS_XSS);
        float cnt_val = 0.f;
#ifdef CNT_TEST
        { const unsigned* q = (const unsigned*)(ws + WS_CTL) + 64; int bad = 0; for (int k = 0; k < 1664; ++k) bad += (q[k] != 1u) ? 1 : 0; cnt_val = 1.f + (float)bad; }
#endif
        for (size_t i = (size_t)blockIdx.x * NTHR + threadIdx.x; i < n; i += (size_t)gridDim.x * NTHR) {
            float v = 0.f;
#define BFV(p, idx) __uint_as_float(((unsigned)(p)[idx]) << 16)
#ifndef DUMPMASK
#define DUMPMASK 7
#endif
#ifdef XCOPY
            if (DUMPMASK & 16) v += BFV(XBC, i);
#endif
            if (DUMPMASK & 32) v += BFV(VT, i % ((size_t)2048 * 1024));
            if (DUMPMASK & 64) v += BFV(KB, i % ((size_t)2048 * 1024));
            if (DBG_STOP <= 3) { if (DUMPMASK & 1) v += BFV(YB, i); if (DUMPMASK & 2) v += BFV(YB, i + n); if (DUMPMASK & 4) v += BFV(YB, i + 2 * n); }
            if (DBG_STOP <= 2 && !(DUMPMASK & 8)) { v += BFV(XBC, i) + BFV(XBC, i + n / 2) + BFV(SG, i) + BFV(SG, i + n) + BFV(SG, i + 2 * n) + BFV(KB, i % ((size_t)2048 * 1024)) + BFV(VT, i % ((size_t)2048 * 1024))
                                     + DT[i % ((size_t)TS * 16)] + 1e-3f * VSS[i % ((size_t)TS * 16)]; }
            if (DBG_STOP == 2 && !(DUMPMASK & 8)) v += 1e-3f * SSS[i % ((size_t)TS * 16)];
            if (DBG_STOP == 3) v += BFV(MB, i);
            if (DBG_STOP >= 4) v = out[i] + BFV(XB, i) + 1e-3f * XSS[i % ((size_t)TS * 16)];
#ifdef CNT_TEST
            v = cnt_val; out[i + n] = v;
#endif
            out[i] = v;
        }
    }
#endif
}

extern "C" void kernel_launch(void* const* d_in, const int* in_sizes, int n_in, void* d_out, int out_size, void* d_ws, size_t ws_size, hipStream_t stream) {
    static int grid_blocks = 0;
    if (grid_blocks == 0) {
        if (n_in != 23 || out_size != T_ALL * DM || ws_size < WS_END) { fprintf(stderr, "kernel_launch: unexpected problem (n_in %d out %d ws %zu, need %zu)\n", n_in, out_size, ws_size, (size_t)WS_END); grid_blocks = -1; return; }
        int dev = 0, cus = 0, per_cu = 0;
        (void)hipGetDevice(&dev);
        (void)hipDeviceGetAttribute(&cus, hipDeviceAttributeMultiprocessorCount, dev);
        (void)hipFuncSetAttribute((const void*)fwd_megakernel, hipFuncAttributeMaxDynamicSharedMemorySize, LDS_BYTES);
        (void)hipOccupancyMaxActiveBlocksPerMultiprocessor(&per_cu, fwd_megakernel, NTHR, LDS_BYTES);
        if (per_cu < 1) { fprintf(stderr, "kernel_launch: occupancy query says 0 blocks per CU\n"); per_cu = 1; }
        grid_blocks = cus;
    }
    if (grid_blocks < 0) return;
    (void)hipMemsetAsync((unsigned char*)d_ws + WS_BAR, 0, 16384, stream);
    Params p{};
    for (int i = 0; i < 23; ++i) p.in[i] = (const float*)d_in[i];
    p.out = (float*)d_out; p.ws = (unsigned char*)d_ws;
#if MK_MULTI
    for (int s = 0; s < NSEG; ++s) { p.seg_lo = s; p.seg_hi = s + 1; hipLaunchKernelGGL(fwd_megakernel, dim3(grid_blocks), dim3(NTHR), LDS_BYTES, stream, p); }
#else
#ifdef DBG_STOP
    p.seg_lo = 0; p.seg_hi = DBG_STOP + 1;
#else
    p.seg_lo = 0; p.seg_hi = NSEG;
#endif
    void* args[] = {&p};
    hipError_t e = hipLaunchCooperativeKernel((void*)fwd_megakernel, dim3(grid_blocks), dim3(NTHR), args, LDS_BYTES, stream);
    if (e != hipSuccess) fprintf(stderr, "cooperative launch failed: %s (grid %d)\n", hipGetErrorString(e), grid_blocks);
#endif
}
```
